# Optimizing an MI355X kernel written in HIP

```python
import math
import jax, jax.numpy as jnp
from jax import lax
import numpy as np

D_MODEL = 1024
BATCH = 4
SEQ = 4096
DEPTH = 2

MIX_WIDTH = D_MODEL
GDN_HEADS = 4
GDN_HEAD_DIM = 128
GDN_WIDTH = GDN_HEADS * GDN_HEAD_DIM
GDN_CONV = 4
GDN_CHUNK = 64
NSA_HEADS = 8
NSA_KV_HEADS = 2
NSA_HEAD_DIM = 64
NSA_WIDTH = NSA_HEADS * NSA_HEAD_DIM
NSA_KV_WIDTH = NSA_KV_HEADS * NSA_HEAD_DIM
CMP_LEN = 32
CMP_STRIDE = 16
CMP_HIDDEN = 2 * NSA_HEAD_DIM
SEL_BLOCK = 64
N_SELECT = 16
WINDOW = 512
Q_BLOCK = 128
ROPE_THETA = 500000.0
ROT_DIM = NSA_HEAD_DIM // 4
D_FF = 2816
N_ADA = 9
NORM_EPS = 1e-6
IN_SIZES = (3 * GDN_WIDTH, GDN_WIDTH, GDN_HEADS, GDN_HEADS,
            NSA_WIDTH, NSA_KV_WIDTH, NSA_KV_WIDTH, NSA_KV_WIDTH,
            NSA_KV_WIDTH, NSA_KV_WIDTH, NSA_KV_WIDTH, 3 * NSA_HEADS)
IN_WIDTH = sum(IN_SIZES)

kernel_name = "hybrid_gdn_nsa_macaron_adaln"


def rms_norm(x, g):
    xf = x.astype(jnp.float32)
    y = xf * lax.rsqrt(jnp.mean(xf * xf, axis=-1, keepdims=True) + NORM_EPS)
    return (y * g.astype(jnp.float32)).astype(x.dtype)


def l2_norm(x):
    xf = x.astype(jnp.float32)
    return xf * lax.rsqrt(jnp.sum(xf * xf, axis=-1, keepdims=True) + NORM_EPS)


def modulate(h, shift, scale):
    return h * (1.0 + scale[:, None, :]) + shift[:, None, :]


def swiglu(h, w_in, w_out):
    gate, up = jnp.split(h @ w_in, 2, axis=-1)
    return (jax.nn.silu(gate) * up) @ w_out


def split_cols(x, sizes):
    offs = [int(o) for o in np.cumsum(sizes)[:-1]]
    return jnp.split(x, offs, axis=-1)


def masked_softmax(s, mask):
    s = jnp.where(mask, s.astype(jnp.float32), -jnp.inf)
    m = jnp.max(s, axis=-1, keepdims=True)
    m = jnp.where(jnp.isfinite(m), m, 0.0)
    p = jnp.exp(s - m)
    return p / jnp.maximum(jnp.sum(p, axis=-1, keepdims=True), 1e-30)


def partial_rope(x, cos, sin):
    half = ROT_DIM // 2
    xf = x[..., :ROT_DIM].astype(jnp.float32)
    x1, x2 = xf[..., :half], xf[..., half:]
    rot = jnp.concatenate([x1 * cos - x2 * sin, x2 * cos + x1 * sin], axis=-1).astype(x.dtype)
    return jnp.concatenate([rot, x[..., ROT_DIM:]], axis=-1)


def causal_dwconv(x, w):
    k = w.shape[0]
    return lax.conv_general_dilated(
        x, w[:, None, :].astype(x.dtype), window_strides=(1,), padding=[(k - 1, 0)],
        dimension_numbers=("NWC", "WIO", "NWC"), feature_group_count=x.shape[-1])


def chunk_gated_delta_rule(q, k, v, g, beta):
    B, T, H, Dk = q.shape
    Dv = v.shape[-1]
    C = GDN_CHUNK
    N = T // C

    def chunks(t):
        t = t.astype(jnp.float32).reshape((B, N, C, H) + t.shape[3:])
        return jnp.moveaxis(t, (1, 3), (0, 2))

    qc, kc, vc, bc = chunks(q), chunks(k), chunks(v), chunks(beta)
    gc = jnp.cumsum(chunks(g), axis=-1)
    causal = jnp.tril(jnp.ones((C, C), dtype=bool))
    strict = jnp.tril(jnp.ones((C, C), dtype=bool), -1)
    decay = jnp.exp(jnp.where(causal, gc[..., :, None] - gc[..., None, :], -jnp.inf))
    kb = kc * bc[..., None]
    lower = jnp.where(strict, jnp.einsum("nbhcd,nbhsd->nbhcs", kb, kc) * decay, 0.0)
    rhs = jnp.concatenate([vc * bc[..., None], kb * jnp.exp(gc)[..., None]], axis=-1)
    sol = lax.linalg.triangular_solve(lower, rhs, left_side=True, lower=True, unit_diagonal=True)
    u, w = sol[..., :Dv], sol[..., Dv:]

    def step(S, xs):
        q_i, k_i, u_i, w_i, g_i, d_i = xs
        v_new = u_i - jnp.einsum("bhcd,bhdv->bhcv", w_i, S)
        attn = jnp.einsum("bhcd,bhsd->bhcs", q_i, k_i) * d_i
        o = (jnp.einsum("bhcd,bhdv->bhcv", q_i * jnp.exp(g_i)[..., None], S)
             + jnp.einsum("bhcs,bhsv->bhcv", attn, v_new))
        g_last = g_i[..., -1:]
        S = (S * jnp.exp(g_last)[..., None]
             + jnp.einsum("bhcd,bhcv->bhdv", k_i * jnp.exp(g_last - g_i)[..., None], v_new))
        return S, o

    S0 = jnp.zeros((B, H, Dk, Dv), jnp.float32)
    _, o = lax.scan(step, S0, (qc, kc, u, w, gc, decay))
    return jnp.moveaxis(o, (0, 2), (1, 3)).reshape(B, T, H, Dv)


def gated_deltanet(qkv, z, b_raw, a_raw, conv_w, a_log, dt_bias, norm_g):
    B, T, _ = qkv.shape
    qkv = jax.nn.silu(causal_dwconv(qkv, conv_w))
    q, k, v = jnp.split(qkv, 3, axis=-1)
    hd = (B, T, GDN_HEADS, GDN_HEAD_DIM)
    q = l2_norm(q.reshape(hd)) * (GDN_HEAD_DIM ** -0.5)
    k = l2_norm(k.reshape(hd))
    v = v.reshape(hd)
    beta = jax.nn.sigmoid(b_raw.astype(jnp.float32))
    g = -jnp.exp(a_log.astype(jnp.float32)) * jax.nn.softplus(a_raw.astype(jnp.float32) + dt_bias.astype(jnp.float32))
    o = chunk_gated_delta_rule(q, k, v, g, beta)
    o = rms_norm(o, norm_g) * jax.nn.silu(z.reshape(hd).astype(jnp.float32))
    return o.reshape(B, T, GDN_WIDTH).astype(qkv.dtype)


def native_sparse_attention(q, kc, vc, ks, vs, kw, vw, gate_raw, cos, sin,
                            pe_k, w1_k, w2_k, pe_v, w1_v, w2_v, out_norm_g):
    B, T, _ = q.shape
    Hq, G, dh = NSA_HEADS, NSA_KV_HEADS, NSA_HEAD_DIM
    R = Hq // G
    scale = dh ** -0.5
    q = partial_rope(q.reshape(B, T, Hq, dh), cos, sin).reshape(B, T, G, R, dh)
    heads = lambda t: t.reshape(B, T, G, dh)
    kc = partial_rope(heads(kc), cos, sin)
    ks = partial_rope(heads(ks), cos, sin)
    kw = partial_rope(heads(kw), cos, sin)
    vc, vs, vw = heads(vc), heads(vs), heads(vw)

    n_cmp = (T - CMP_LEN) // CMP_STRIDE + 1
    cmp_idx = np.arange(n_cmp)[:, None] * CMP_STRIDE + np.arange(CMP_LEN)[None, :]

    def compress(t, pe, w1, w2):
        blk = t[:, cmp_idx] + pe[:, None, :]
        blk = jnp.moveaxis(blk, 3, 2).reshape(B, n_cmp, G, CMP_LEN * dh)
        return jax.nn.silu(blk @ w1) @ w2

    k_cmp = compress(kc, pe_k, w1_k, w2_k)
    v_cmp = compress(vc, pe_v, w1_v, w2_v)
    cmp_end = jnp.asarray(cmp_idx[:, -1])

    n_blk = T // SEL_BLOCK
    n_sel = min(N_SELECT, n_blk)
    sel_start = np.arange(n_blk) * SEL_BLOCK
    overlap = jnp.asarray(((cmp_idx[:, :1] < sel_start[None, :] + SEL_BLOCK)
                           & (cmp_idx[:, -1:] >= sel_start[None, :])).astype(np.float32))
    blk_ids = jnp.arange(n_blk)
    ks_t = jnp.moveaxis(ks, 2, 1)
    vs_t = jnp.moveaxis(vs, 2, 1)
    b_ix = jnp.arange(B)[:, None, None, None]
    g_ix = jnp.arange(G)[None, :, None, None]
    kw_pad = jnp.pad(kw, ((0, 0), (WINDOW, 0), (0, 0), (0, 0)))
    vw_pad = jnp.pad(vw, ((0, 0), (WINDOW, 0), (0, 0), (0, 0)))
    gates = jax.nn.sigmoid(gate_raw.astype(jnp.float32)).reshape(B, T, G, R, 3)

    def one_block(i):
        s = i * Q_BLOCK
        t = s + jnp.arange(Q_BLOCK)
        qb = lax.dynamic_slice_in_dim(q, s, Q_BLOCK, axis=1)
        gb = lax.dynamic_slice_in_dim(gates, s, Q_BLOCK, axis=1)
        sc = jnp.einsum("bqgrd,bngd->bgrqn", qb, k_cmp) * scale
        p_cmp = masked_softmax(sc, cmp_end[None, :] <= t[:, None])
        o_cmp = jnp.einsum("bgrqn,bngd->bqgrd", p_cmp.astype(v_cmp.dtype), v_cmp)
        imp = jnp.einsum("bgrqn,nj->bgqj", p_cmp, overlap)
        cur = t[:, None] // SEL_BLOCK
        forced = (blk_ids == 0) | (blk_ids == cur) | (blk_ids == cur - 1)
        valid = blk_ids * SEL_BLOCK <= t[:, None]
        imp = jnp.where(forced, jnp.inf, jnp.where(valid, imp, -jnp.inf))
        _, top = lax.top_k(imp, n_sel)
        tok = (top[..., None] * SEL_BLOCK + jnp.arange(SEL_BLOCK)).reshape(B, G, Q_BLOCK, n_sel * SEL_BLOCK)
        k_sel = ks_t[b_ix, g_ix, tok]
        v_sel = vs_t[b_ix, g_ix, tok]
        ss = jnp.einsum("bqgrd,bgqld->bgrql", qb, k_sel) * scale
        p_sel = masked_softmax(ss, (tok <= t[:, None])[:, :, None])
        o_sel = jnp.einsum("bgrql,bgqld->bqgrd", p_sel.astype(v_sel.dtype), v_sel)
        k_win = lax.dynamic_slice_in_dim(kw_pad, s, WINDOW + Q_BLOCK, axis=1)
        v_win = lax.dynamic_slice_in_dim(vw_pad, s, WINDOW + Q_BLOCK, axis=1)
        kp = s - WINDOW + jnp.arange(WINDOW + Q_BLOCK)
        win_mask = (kp[None, :] <= t[:, None]) & (kp[None, :] > t[:, None] - WINDOW) & (kp[None, :] >= 0)
        sw = jnp.einsum("bqgrd,bkgd->bgrqk", qb, k_win) * scale
        p_win = masked_softmax(sw, win_mask)
        o_win = jnp.einsum("bgrqk,bkgd->bqgrd", p_win.astype(v_win.dtype), v_win)
        o = gb[..., 0:1] * o_cmp + gb[..., 1:2] * o_sel + gb[..., 2:3] * o_win
        o = rms_norm(o, out_norm_g)
        return o.reshape(B, Q_BLOCK, NSA_WIDTH)

    out = lax.map(one_block, jnp.arange(T // Q_BLOCK))
    return jnp.moveaxis(out, 0, 1).reshape(B, T, NSA_WIDTH).astype(q.dtype)


def token_mix(h, w_in, conv_w, a_log, dt_bias, gdn_norm_g, pe_k, w1_k, w2_k,
              pe_v, w1_v, w2_v, nsa_norm_g, w_out, cos, sin):
    (qkv, z, b_raw, a_raw, q_n, kc, vc, ks, vs, kw, vw, g_raw) = split_cols(h @ w_in, IN_SIZES)
    y_gdn = gated_deltanet(qkv, z, b_raw, a_raw, conv_w, a_log, dt_bias, gdn_norm_g)
    y_nsa = native_sparse_attention(q_n, kc, vc, ks, vs, kw, vw, g_raw, cos, sin,
                                    pe_k, w1_k, w2_k, pe_v, w1_v, w2_v, nsa_norm_g)
    return jnp.concatenate([y_gdn, y_nsa.astype(y_gdn.dtype)], axis=-1) @ w_out


def setup_inputs(seed: int = 0) -> dict:
    key = jax.random.key(seed)
    ks = jax.random.split(key, 24)
    nrm = lambda k, shape, s: jax.random.normal(k, shape, jnp.float32) * s
    x = nrm(ks[0], (BATCH, SEQ, D_MODEL), 1.0)
    c = nrm(ks[1], (BATCH, D_MODEL), 1.0)
    positions = (jax.random.randint(ks[2], (BATCH, 1), 0, SEQ, dtype=jnp.int32)
                 + jnp.arange(SEQ, dtype=jnp.int32)[None, :])
    ada_w = nrm(ks[3], (DEPTH, D_MODEL, N_ADA * D_MODEL), 0.5 * D_MODEL ** -0.5)
    ada_b = nrm(ks[4], (DEPTH, N_ADA * D_MODEL), 0.02)
    norm_g = 1.0 + nrm(ks[5], (DEPTH, 3, D_MODEL), 0.02)
    ffn_w_in = nrm(ks[6], (DEPTH, 2, D_MODEL, 2 * D_FF), D_MODEL ** -0.5)
    ffn_w_out = nrm(ks[7], (DEPTH, 2, D_FF, D_MODEL), D_FF ** -0.5)
    mix_w_in = nrm(ks[8], (DEPTH, D_MODEL, IN_WIDTH), D_MODEL ** -0.5)
    gdn_conv_w = nrm(ks[9], (DEPTH, GDN_CONV, 3 * GDN_WIDTH), GDN_CONV ** -0.5)
    gdn_a_log = jnp.log(jax.random.uniform(ks[10], (DEPTH, GDN_HEADS), jnp.float32, 1.0, 16.0))
    dt = jnp.exp(jax.random.uniform(ks[11], (DEPTH, GDN_HEADS), jnp.float32, math.log(1e-3), math.log(1e-1)))
    gdn_dt_bias = dt + jnp.log(-jnp.expm1(-dt))
    gdn_norm_g = 1.0 + nrm(ks[12], (DEPTH, GDN_HEAD_DIM), 0.02)
    cmp_pe_k = nrm(ks[13], (DEPTH, CMP_LEN, NSA_HEAD_DIM), 0.1)
    cmp_w1_k = nrm(ks[14], (DEPTH, CMP_LEN * NSA_HEAD_DIM, CMP_HIDDEN), (CMP_LEN * NSA_HEAD_DIM) ** -0.5)
    cmp_w2_k = nrm(ks[15], (DEPTH, CMP_HIDDEN, NSA_HEAD_DIM), CMP_HIDDEN ** -0.5)
    cmp_pe_v = nrm(ks[16], (DEPTH, CMP_LEN, NSA_HEAD_DIM), 0.1)
    cmp_w1_v = nrm(ks[17], (DEPTH, CMP_LEN * NSA_HEAD_DIM, CMP_HIDDEN), (CMP_LEN * NSA_HEAD_DIM) ** -0.5)
    cmp_w2_v = nrm(ks[18], (DEPTH, CMP_HIDDEN, NSA_HEAD_DIM), CMP_HIDDEN ** -0.5)
    nsa_norm_g = 1.0 + nrm(ks[19], (DEPTH, NSA_HEAD_DIM), 0.02)
    mix_w_out = nrm(ks[20], (DEPTH, MIX_WIDTH, D_MODEL), MIX_WIDTH ** -0.5)
    final_norm_g = 1.0 + nrm(ks[21], (D_MODEL,), 0.02)
    return {"x": x, "c": c, "positions": positions, "ada_w": ada_w, "ada_b": ada_b,
            "norm_g": norm_g, "ffn_w_in": ffn_w_in, "ffn_w_out": ffn_w_out,
            "mix_w_in": mix_w_in, "gdn_conv_w": gdn_conv_w, "gdn_a_log": gdn_a_log,
            "gdn_dt_bias": gdn_dt_bias, "gdn_norm_g": gdn_norm_g,
            "cmp_pe_k": cmp_pe_k, "cmp_w1_k": cmp_w1_k, "cmp_w2_k": cmp_w2_k,
            "cmp_pe_v": cmp_pe_v, "cmp_w1_v": cmp_w1_v, "cmp_w2_v": cmp_w2_v,
            "nsa_norm_g": nsa_norm_g, "mix_w_out": mix_w_out, "final_norm_g": final_norm_g}


def reference(x, c, positions, ada_w, ada_b, norm_g, ffn_w_in, ffn_w_out, mix_w_in,
              gdn_conv_w, gdn_a_log, gdn_dt_bias, gdn_norm_g, cmp_pe_k, cmp_w1_k, cmp_w2_k,
              cmp_pe_v, cmp_w1_v, cmp_w2_v, nsa_norm_g, mix_w_out, final_norm_g):
    B, T, D = x.shape
    half = ROT_DIM // 2
    inv_freq = jnp.power(ROPE_THETA, -jnp.arange(half, dtype=jnp.float32) * (2.0 / ROT_DIM))
    ang = positions.astype(jnp.float32)[..., None] * inv_freq
    cos = jnp.cos(ang)[:, :, None, :]
    sin = jnp.sin(ang)[:, :, None, :]
    cond = jax.nn.silu(c.astype(jnp.float32))
    for l in range(DEPTH):
        mod = (cond @ ada_w[l].astype(jnp.float32) + ada_b[l].astype(jnp.float32)).reshape(B, 3, 3, D).astype(x.dtype)
        h = modulate(rms_norm(x, norm_g[l, 0]), mod[:, 0, 0], mod[:, 0, 1])
        x = x + 0.5 * mod[:, 0, 2][:, None, :] * swiglu(h, ffn_w_in[l, 0], ffn_w_out[l, 0])
        h = modulate(rms_norm(x, norm_g[l, 1]), mod[:, 1, 0], mod[:, 1, 1])
        y = token_mix(h, mix_w_in[l], gdn_conv_w[l], gdn_a_log[l], gdn_dt_bias[l], gdn_norm_g[l],
                      cmp_pe_k[l], cmp_w1_k[l], cmp_w2_k[l], cmp_pe_v[l], cmp_w1_v[l], cmp_w2_v[l],
                      nsa_norm_g[l], mix_w_out[l], cos, sin)
        x = x + mod[:, 1, 2][:, None, :] * y.astype(x.dtype)
        h = modulate(rms_norm(x, norm_g[l, 2]), mod[:, 2, 0], mod[:, 2, 1])
        x = x + 0.5 * mod[:, 2, 2][:, None, :] * swiglu(h, ffn_w_in[l, 1], ffn_w_out[l, 1])
    return rms_norm(x, final_norm_g)
```

```cpp
#include <hip/hip_runtime.h>
#include <cstdio>
#include <cstdint>

constexpr int NB = 4, NT = 4096, DM = 1024, MR = NB * NT, FF = 2816, NIN = 3360, NINP = 3584, DEPTH = 2;
constexpr int GH = 4, GD = 128, GW = 512;
constexpr int NH = 8, NG = 2, HD = 64;
constexpr int NCMP = 255, NBLK = 64, NSEL = 16, WIN = 512;
constexpr float EPS = 1e-6f;
constexpr size_t MiB = 1u << 20;
constexpr size_t WS_CTL = 0, WS_MOD = 1 * MiB, WS_WT1 = 4 * MiB, WS_WT2 = 48 * MiB, WS_WTIN = 70 * MiB, WS_WTOUT = 84 * MiB, WS_W1C = 88 * MiB,
                 WS_HN = 90 * MiB, WS_ACT = 122 * MiB, WS_C16 = 122 * MiB, WS_OG32 = 122 * MiB, WS_Z16 = 170 * MiB, WS_KV16 = 186 * MiB,
                 WS_QN32 = 210 * MiB, WS_KC32 = 242 * MiB, WS_AB32 = 250 * MiB, WS_GR32 = 251 * MiB, WS_GQ = 253 * MiB, WS_GK = 269 * MiB, WS_GV = 285 * MiB,
                 WS_GG = 301 * MiB, WS_GB = 301 * MiB + 512 * 1024, WS_KCMP = 302 * MiB, WS_VCMP = 302 * MiB + 512 * 1024, WS_SEL = 303 * MiB, WS_OACC = 304 * MiB, WS_END = 336 * MiB;

typedef unsigned short f16_t;
typedef _Float16 h2_t __attribute__((ext_vector_type(2)));
typedef float f32x2_t __attribute__((ext_vector_type(2)));
typedef float f32x4_t __attribute__((ext_vector_type(4)));
typedef unsigned u32x4_t __attribute__((ext_vector_type(4)));
typedef unsigned u32x2_t __attribute__((ext_vector_type(2)));
__device__ __forceinline__ unsigned pkh(float lo, float hi) { f32x2_t v = {lo, hi}; h2_t h = __builtin_convertvector(v, h2_t); return __builtin_bit_cast(unsigned, h); }
__device__ __forceinline__ float h2f(f16_t u) { return (float)__builtin_bit_cast(_Float16, u); }
__device__ __forceinline__ f16_t f2h(float f) { return __builtin_bit_cast(f16_t, (_Float16)f); }
__device__ __forceinline__ float hlo(unsigned u) { return h2f((f16_t)(u & 0xffffu)); }
__device__ __forceinline__ float hhi(unsigned u) { return h2f((f16_t)(u >> 16)); }
__device__ __forceinline__ float siluf(float x) { return x / (1.f + __expf(-x)); }
__device__ __forceinline__ float sigmf(float x) { return 1.f / (1.f + __expf(-x)); }
__device__ __forceinline__ float wave_sum(float v) {
#pragma unroll
    for (int o = 1; o < 64; o <<= 1) v += __shfl_xor(v, o);
    return v;
}
__device__ __forceinline__ float wave_max(float v) {
#pragma unroll
    for (int o = 1; o < 64; o <<= 1) v = fmaxf(v, __shfl_xor(v, o));
    return v;
}

namespace pg8 {
#define PG8_LAS __attribute__((address_space(3)))
typedef unsigned short bf16_t;
typedef _Float16 bf16x8 __attribute__((ext_vector_type(8)));
typedef float f32x4 __attribute__((ext_vector_type(4)));
typedef unsigned u32x4 __attribute__((ext_vector_type(4)));
constexpr int BM = 256, BK = 64, HALF = 128, HTB = HALF * BK * 2  , STAGE_BYTES = 8 * HTB, NXCD = 8, WGM = 8;

__host__ __device__ __forceinline__ int lds_byte(int r, int c) { const int st = (r >> 4) * 2 + (c >> 5), rr = r & 15, cc = c & 31, ob = rr * 64 + cc * 2; return st * 1024 + (ob ^ (((ob >> 9) & 1) << 5)); }
__host__ __device__ __forceinline__ void stage_rc(int b, int& R, int& C) { const int st = b / 1024, sb = b % 1024, swz = sb ^ (((sb >> 9) & 1) << 5); R = (st >> 1) * 16 + swz / 64; C = (st & 1) * 32 + (swz % 64) / 2; }
__host__ __device__ __forceinline__ int perm32(int rho) { const int n = rho >> 4, i = rho & 15; return 8 * (i >> 2) + 4 * n + (i & 3); }

struct Unit { int pm, pn; };
struct Gemm { const bf16_t* A; const bf16_t* Bt; int M, N, K, pad; };

struct StaticOrder {
    int nM, nN, nwg, G, c;
    __host__ __device__ void init(int M, int N, int G_, int c_) { nM = M / BM; nN = N / BM; nwg = nM * nN; G = G_; c = c_; }
    __host__ __device__ bool next(int i, Unit& u) const {
        const long L = (long)i * G + c; if (L >= nwg) return false;
        int wgid = (int)L; { const int q = nwg / NXCD, r = nwg % NXCD, xcd = wgid % NXCD, off = wgid / NXCD; wgid = (xcd < r ? xcd * (q + 1) : r * (q + 1) + (xcd - r) * q) + off; }
        const int nig = WGM * nN, gid = wgid / nig, fm = gid * WGM, gsz = (nM - fm) < WGM ? (nM - fm) : WGM;
        u.pm = fm + ((wgid % nig) % gsz); u.pn = (wgid % nig) / gsz; return true;
    }
    __device__ __forceinline__ void a_ready(const Unit&) const {}
    __device__ __forceinline__ void done(const Unit&) const {}
};


template <class Epi, class Sched, bool ALIGN_EPI = false, bool SP2 = false>
__device__ __forceinline__ void gemm_phase(PG8_LAS unsigned char* lds, const Gemm g, const Sched& S, const Epi& E) {
    const int tid = threadIdx.x, wid = __builtin_amdgcn_readfirstlane(tid >> 6), lane = tid & 63, wr = wid >> 2, wc = wid & 3, fr = lane & 15, fq = lane >> 4;
    const int K = g.K, nt = K / BK;
    unsigned voffA[2], voffB[2];
#pragma unroll
    for (int i = 0; i < 2; ++i) { int R, C; stage_rc(tid * 16 + i * 8192, R, C); const int Rb = Epi::PERM ? ((R & ~31) + perm32(R & 31)) : R;
        voffA[i] = (unsigned)(R * K + C) * 2u; voffB[i] = (unsigned)(Rb * K + C) * 2u; }
    const size_t kstep = (size_t)(BK * 2);
    const size_t hstep = (size_t)HALF * K * 2;
    const size_t tstep = 2 * hstep;
    const unsigned ldsw = (unsigned)wid * 1024u;
    const int aoff = lds_byte(wr * 64 + fr, fq * 8), boff = lds_byte(wc * 32 + fr, fq * 8);
#define PG8_SA(b, h) (((b) * 2 + (h)) * HTB)
#define PG8_SB(b, h) ((4 + (b) * 2 + (h)) * HTB)
#define PG8_STAGE(bufoff, gbase, voff) do { _Pragma("unroll") for (int _i = 0; _i < 2; ++_i) \
        __builtin_amdgcn_global_load_lds((const unsigned*)((const char*)(gbase) + (voff)[_i]), (PG8_LAS unsigned*)(lds + (bufoff) + ldsw + _i * 8192), 16, 0, 0); } while (0)
#define PG8_LDA(dst, b, h) do { _Pragma("unroll") for (int m = 0; m < 4; ++m) _Pragma("unroll") for (int k = 0; k < 2; ++k) dst[m][k] = *(const PG8_LAS bf16x8*)(lds + PG8_SA(b, h) + aoff + m * 2048 + k * 1024); } while (0)
#define PG8_LDB(dst, b, h) do { _Pragma("unroll") for (int n = 0; n < 2; ++n) _Pragma("unroll") for (int k = 0; k < 2; ++k) dst[n][k] = *(const PG8_LAS bf16x8*)(lds + PG8_SB(b, h) + boff + n * 2048 + k * 1024); } while (0)
#define PG8_MMA(ai, bj, At, Bt) do { __builtin_amdgcn_s_setprio(1); _Pragma("unroll") for (int m = 0; m < 4; ++m) _Pragma("unroll") for (int n = 0; n < 2; ++n) _Pragma("unroll") for (int k = 0; k < 2; ++k) \
        acc[ai][bj][m][n] = __builtin_amdgcn_mfma_f32_16x16x32_f16(Bt[n][k], At[m][k], acc[ai][bj][m][n], 0, 0, 0); __builtin_amdgcn_s_setprio(0); } while (0)
#define PG8_WAIT_V(n) asm volatile("s_waitcnt vmcnt(" #n ")" ::: "memory")
#define PG8_WAIT_L(n) asm volatile("s_waitcnt lgkmcnt(" #n ")" ::: "memory")
#define PG8_BAR __builtin_amdgcn_s_barrier()
#define PG8_SCHED __builtin_amdgcn_sched_barrier(0)
    Unit cur, nxt; int ui = 0;
    if (!S.next(0, cur)) return;
    f32x4 acc[2][2][4][2];
#pragma unroll
    for (int a = 0; a < 2; ++a)
#pragma unroll
        for (int b = 0; b < 2; ++b)
#pragma unroll
            for (int m = 0; m < 4; ++m)
#pragma unroll
                for (int n = 0; n < 2; ++n) acc[a][b][m][n] = (f32x4){0.f, 0.f, 0.f, 0.f};
    bf16x8 At[4][2], B0[2][2], B1[2][2];
    const char* cA = (const char*)g.A + (size_t)cur.pm * tstep; const char* cB = (const char*)g.Bt + (size_t)cur.pn * tstep;
    S.a_ready(cur);
    if constexpr (SP2) {
        PG8_STAGE(PG8_SB(0, 0), cB, voffB); PG8_STAGE(PG8_SB(0, 1), cB + hstep, voffB); PG8_STAGE(PG8_SA(0, 0), cA, voffA); PG8_STAGE(PG8_SA(0, 1), cA + hstep, voffA);
        if (wr == 1) PG8_BAR;
        PG8_WAIT_V(2); PG8_BAR;
        PG8_STAGE(PG8_SB(1, 0), cB + kstep, voffB); PG8_STAGE(PG8_SA(1, 0), cA + kstep, voffA); PG8_STAGE(PG8_SB(1, 1), cB + hstep + kstep, voffB);
        PG8_WAIT_V(6); PG8_BAR;
    } else {
        PG8_STAGE(PG8_SB(0, 0), cB, voffB); PG8_STAGE(PG8_SA(0, 0), cA, voffA); PG8_STAGE(PG8_SB(0, 1), cB + hstep, voffB); PG8_STAGE(PG8_SA(0, 1), cA + hstep, voffA);
        if (wr == 1) PG8_BAR;
        PG8_WAIT_V(4); PG8_BAR;
        PG8_STAGE(PG8_SB(1, 0), cB + kstep, voffB); PG8_STAGE(PG8_SA(1, 0), cA + kstep, voffA); PG8_STAGE(PG8_SB(1, 1), cB + hstep + kstep, voffB);
        PG8_WAIT_V(6); PG8_BAR;
    }
    for (;;) {
        const bool has_next = S.next(ui + 1, nxt);
        const char* nA = has_next ? (const char*)g.A + (size_t)nxt.pm * tstep : cA; const char* nB = has_next ? (const char*)g.Bt + (size_t)nxt.pn * tstep : cB;
        for (int t = 0; t < nt; t += 2) {
            const bool last = (t == nt - 2);
            const char* a1 = cA + (size_t)(t + 1) * kstep;
            const char* a2 = last ? nA : cA + (size_t)(t + 2) * kstep; const char* b2 = last ? nB : cB + (size_t)(t + 2) * kstep;
            const char* a3 = a2 + kstep; const char* b3 = b2 + kstep;
            if (last && has_next) S.a_ready(nxt);
            if constexpr (SP2) {
            PG8_LDB(B0, 0, 0); PG8_LDB(B1, 0, 1); PG8_SCHED; PG8_LDA(At, 0, 0); PG8_STAGE(PG8_SA(1, 1), a1 + hstep, voffA);
            PG8_WAIT_V(8); PG8_WAIT_L(0); PG8_BAR; PG8_MMA(0, 0, At, B0); PG8_MMA(0, 1, At, B1); PG8_BAR; PG8_SCHED;
            PG8_LDA(At, 0, 1); PG8_STAGE(PG8_SB(0, 0), b2, voffB); PG8_STAGE(PG8_SB(0, 1), b2 + hstep, voffB); PG8_STAGE(PG8_SA(0, 0), a2, voffA);
            PG8_WAIT_V(8); PG8_WAIT_L(0); PG8_BAR; PG8_MMA(1, 0, At, B0); PG8_MMA(1, 1, At, B1); PG8_BAR; PG8_SCHED;
            PG8_LDB(B0, 1, 0); PG8_LDB(B1, 1, 1); PG8_SCHED; PG8_LDA(At, 1, 0); PG8_STAGE(PG8_SA(0, 1), a2 + hstep, voffA);
            PG8_WAIT_V(8); PG8_WAIT_L(0); PG8_BAR; PG8_MMA(0, 0, At, B0); PG8_MMA(0, 1, At, B1); PG8_BAR; PG8_SCHED;
            PG8_LDA(At, 1, 1); PG8_STAGE(PG8_SB(1, 0), b3, voffB); PG8_STAGE(PG8_SB(1, 1), b3 + hstep, voffB); PG8_STAGE(PG8_SA(1, 0), a3, voffA);
            PG8_WAIT_V(8); PG8_WAIT_L(0); PG8_BAR; PG8_MMA(1, 0, At, B0); PG8_MMA(1, 1, At, B1); PG8_BAR; PG8_SCHED;
            } else {
            PG8_LDB(B0, 0, 0); PG8_SCHED; PG8_LDA(At, 0, 0); PG8_STAGE(PG8_SA(1, 1), a1 + hstep, voffA);
            PG8_WAIT_L(8); PG8_BAR; PG8_WAIT_L(0); PG8_MMA(0, 0, At, B0); PG8_BAR; PG8_SCHED;
            PG8_LDB(B1, 0, 1); PG8_STAGE(PG8_SB(0, 0), b2, voffB);
            PG8_BAR; PG8_WAIT_L(0); PG8_MMA(0, 1, At, B1); PG8_BAR;
            PG8_LDA(At, 0, 1); PG8_STAGE(PG8_SA(0, 0), a2, voffA);
            PG8_BAR; PG8_WAIT_L(0); PG8_MMA(1, 0, At, B0); PG8_BAR; PG8_SCHED;
            PG8_STAGE(PG8_SB(0, 1), b2 + hstep, voffB);
            PG8_WAIT_V(6); PG8_BAR; PG8_MMA(1, 1, At, B1); PG8_BAR;
            PG8_LDB(B0, 1, 0); PG8_SCHED; PG8_LDA(At, 1, 0); PG8_STAGE(PG8_SA(0, 1), a2 + hstep, voffA);
            PG8_WAIT_L(8); PG8_BAR; PG8_WAIT_L(0); PG8_MMA(0, 0, At, B0); PG8_BAR; PG8_SCHED;
            PG8_LDB(B1, 1, 1); PG8_STAGE(PG8_SB(1, 0), b3, voffB);
            PG8_BAR; PG8_WAIT_L(0); PG8_MMA(0, 1, At, B1); PG8_BAR;
            PG8_LDA(At, 1, 1); PG8_STAGE(PG8_SA(1, 0), a3, voffA);
            PG8_BAR; PG8_WAIT_L(0); PG8_MMA(1, 0, At, B0); PG8_BAR; PG8_SCHED;
            PG8_STAGE(PG8_SB(1, 1), b3 + hstep, voffB);
            PG8_WAIT_V(6); PG8_BAR; PG8_MMA(1, 1, At, B1); PG8_BAR;
            }
        }
        if constexpr (ALIGN_EPI) { if (wr == 0) PG8_BAR; }
        if constexpr (!Epi::AFTER_DRAIN) { E(acc, cur, wr, wc, fr, fq); S.done(cur); }
        if (!has_next) break;
#pragma unroll
        for (int a = 0; a < 2; ++a)
#pragma unroll
            for (int b = 0; b < 2; ++b)
#pragma unroll
                for (int m = 0; m < 4; ++m)
#pragma unroll
                    for (int n = 0; n < 2; ++n) acc[a][b][m][n] = (f32x4){0.f, 0.f, 0.f, 0.f};
        cur = nxt; cA = nA; cB = nB; ++ui;
        if constexpr (ALIGN_EPI) { if (wr == 1) PG8_BAR; }
    }
    PG8_WAIT_V(0);
    if constexpr (!ALIGN_EPI) { if (wr == 0) PG8_BAR; }
    PG8_BAR;
    if constexpr (Epi::AFTER_DRAIN) { E.fused(acc, cur, wr, wc, fr, fq, lds, wid, lane); S.done(cur); }
#undef PG8_SA
#undef PG8_SB
#undef PG8_STAGE
#undef PG8_LDA
#undef PG8_LDB
#undef PG8_MMA
#undef PG8_WAIT_V
#undef PG8_WAIT_L
#undef PG8_BAR
#undef PG8_SCHED
}
}

namespace pg8 {
struct EpiSwiglu {
    static constexpr bool PERM = true, AFTER_DRAIN = false;
    f16_t* O;
    __device__ __forceinline__ void operator()(const f32x4 (&acc)[2][2][4][2], const Unit& u, int wr, int wc, int fr, int fq) const {
        const int row0 = u.pm * BM + wr * 64 + fr, col0 = u.pn * 128 + wc * 32 + 8 * fq;
#pragma unroll
        for (int ai = 0; ai < 2; ++ai)
#pragma unroll
            for (int m = 0; m < 4; ++m) {
                const f32x4 g0 = acc[ai][0][m][0], g1 = acc[ai][0][m][1], u0 = acc[ai][1][m][0], u1 = acc[ai][1][m][1];
                u32x4 w;
                w.x = pkh(siluf(g0[0]) * u0[0], siluf(g0[1]) * u0[1]); w.y = pkh(siluf(g0[2]) * u0[2], siluf(g0[3]) * u0[3]);
                w.z = pkh(siluf(g1[0]) * u1[0], siluf(g1[1]) * u1[1]); w.w = pkh(siluf(g1[2]) * u1[2], siluf(g1[3]) * u1[3]);
                *(u32x4*)(O + (size_t)(row0 + ai * HALF + m * 16) * FF + col0) = w;
            }
    }
};
struct EpiResidual {
    static constexpr bool PERM = false, AFTER_DRAIN = false;
    const float* base; float* out; const float* gate; int gstride; float coef;
    __device__ __forceinline__ void operator()(const f32x4 (&acc)[2][2][4][2], const Unit& u, int wr, int wc, int fr, int fq) const {
        const int row0 = u.pm * BM + wr * 64 + fr, col0 = u.pn * BM + wc * 32 + 4 * fq;
        const float* gp = gate + (size_t)(u.pm / (NT / BM)) * gstride + col0;
        f32x4 gv[2][2];
#pragma unroll
        for (int bj = 0; bj < 2; ++bj)
#pragma unroll
            for (int n = 0; n < 2; ++n) gv[bj][n] = *(const f32x4*)(gp + bj * HALF + n * 16) * coef;
#pragma unroll
        for (int ai = 0; ai < 2; ++ai)
#pragma unroll
            for (int m = 0; m < 4; ++m) { const size_t off = (size_t)(row0 + ai * HALF + m * 16) * DM + col0;
#pragma unroll
                for (int bj = 0; bj < 2; ++bj)
#pragma unroll
                    for (int n = 0; n < 2; ++n) { const f32x4 bs = *(const f32x4*)(base + off + bj * HALF + n * 16);
                        *(f32x4*)(out + off + bj * HALF + n * 16) = bs + gv[bj][n] * acc[ai][bj][m][n]; } }
    }
};
struct EpiInProj {
    static constexpr bool PERM = true, AFTER_DRAIN = false;
    f16_t* C16; f16_t* Z16; float* AB32; float* QN32; float* KC32; f16_t* KV16; float* GR32;
    __device__ __forceinline__ void operator()(const f32x4 (&acc)[2][2][4][2], const Unit& u, int wr, int wc, int fr, int fq) const {
        const int row0 = u.pm * BM + wr * 64 + fr;
#pragma unroll
        for (int bj = 0; bj < 2; ++bj) {
            const int c0 = u.pn * BM + bj * HALF + wc * 32 + 8 * fq;
            int kind; size_t ld; int cc; void* basep;
            if (c0 < 1536)      { kind = 0; basep = C16;  ld = 1536; cc = c0; }
            else if (c0 < 2048) { kind = 0; basep = Z16;  ld = 512;  cc = c0 - 1536; }
            else if (c0 < 2056) { kind = 1; basep = AB32; ld = 8;    cc = 0; }
            else if (c0 < 2568) { kind = 1; basep = QN32; ld = 512;  cc = c0 - 2056; }
            else if (c0 < 2696) { kind = 1; basep = KC32; ld = 128;  cc = c0 - 2568; }
            else if (c0 < 3336) { kind = 0; basep = KV16; ld = 640;  cc = c0 - 2696; }
            else if (c0 < 3360) { kind = 1; basep = GR32; ld = 24;   cc = c0 - 3336; }
            else continue;
#pragma unroll
            for (int ai = 0; ai < 2; ++ai)
#pragma unroll
                for (int m = 0; m < 4; ++m) {
                    const size_t row = (size_t)(row0 + ai * HALF + m * 16);
                    const f32x4 v0 = acc[ai][bj][m][0], v1 = acc[ai][bj][m][1];
                    if (kind == 0) { u32x4 w; w.x = pkh(v0[0], v0[1]); w.y = pkh(v0[2], v0[3]); w.z = pkh(v1[0], v1[1]); w.w = pkh(v1[2], v1[3]);
                        *(u32x4*)((f16_t*)basep + row * ld + cc) = w; }
                    else { float* p = (float*)basep + row * ld + cc; *(f32x4*)p = v0; *(f32x4*)(p + 4) = v1; }
                }
        }
    }
};
}

template <class Epi> __global__ void __launch_bounds__(512, 2) gemm_kernel(pg8::Gemm g, Epi E) {
    extern __shared__ __attribute__((aligned(16))) unsigned char lds[];
    pg8::StaticOrder S; S.init(g.M, g.N, (int)gridDim.x, (int)blockIdx.x);
    pg8::gemm_phase<Epi, pg8::StaticOrder, true, true>((PG8_LAS unsigned char*)lds, g, S, E);
}

__global__ void __launch_bounds__(64) mod_kernel(const float* c, const float* ada_w, const float* ada_b, float* mod) {
    __shared__ float cond[NB * DM];
    for (int i = threadIdx.x; i < NB * DM; i += 64) cond[i] = siluf(c[i]);
    __syncthreads();
    const int col = blockIdx.x * 64 + threadIdx.x;
    const int l = col / 9216, j = col % 9216;
    const float* w = ada_w + (size_t)l * DM * 9216 + j;
    float a0 = 0.f, a1 = 0.f, a2 = 0.f, a3 = 0.f;
#pragma unroll 8
    for (int k = 0; k < DM; ++k) { const float wv = w[(size_t)k * 9216]; a0 += cond[k] * wv; a1 += cond[DM + k] * wv; a2 += cond[2 * DM + k] * wv; a3 += cond[3 * DM + k] * wv; }
    const float bb = ada_b[l * 9216 + j];
    float* o = mod + (size_t)l * NB * 9216 + j;
    o[0] = a0 + bb; o[9216] = a1 + bb; o[2 * 9216] = a2 + bb; o[3 * 9216] = a3 + bb;
}

__global__ void __launch_bounds__(256) wconv_kernel(const float* W, int K, int N, f16_t* WT, int mode) {
    __shared__ float scr_all[4][64 * 33];
    const int lane = threadIdx.x & 63, wave = threadIdx.x >> 6;
    float* scr = scr_all[wave];
    const int nblk = N / 32, nitems = (K / 64) * nblk;
    for (int item = blockIdx.x * 4 + wave; item < nitems; item += gridDim.x * 4) {
        const int kb = item / nblk, nb = item % nblk, k0 = 64 * kb, n0 = 32 * nb;
        int r0 = n0;
        if (mode == 1) { const int half = n0 / FF, jj = n0 % FF; r0 = 256 * (jj / 128) + 128 * half + (jj % 128); }
#pragma unroll 8
        for (int i = 0; i < 32; ++i) { const int kk = 2 * i + (lane >> 5); scr[kk * 33 + (lane & 31)] = W[(size_t)(k0 + kk) * N + n0 + (lane & 31)]; }
        __builtin_amdgcn_wave_barrier();
        const int c = lane & 7;
#pragma unroll
        for (int j = 0; j < 4; ++j) { const int n = (lane >> 3) + 8 * j; const float* s = scr + (8 * c) * 33 + n;
            u32x4_t o; o.x = pkh(s[0 * 33], s[1 * 33]); o.y = pkh(s[2 * 33], s[3 * 33]); o.z = pkh(s[4 * 33], s[5 * 33]); o.w = pkh(s[6 * 33], s[7 * 33]);
            *(u32x4_t*)(WT + (size_t)(r0 + n) * K + k0 + 8 * c) = o; }
        __builtin_amdgcn_wave_barrier();
    }
}

__global__ void __launch_bounds__(256) norm_mod_kernel(const float* x, const float* g, const float* shift, const float* scale, int mstride, f16_t* hn) {
    const int lane = threadIdx.x & 63, m = blockIdx.x * 4 + (threadIdx.x >> 6), b = m / NT;
    const f32x4_t* xr = (const f32x4_t*)(x + (size_t)m * DM) + lane;
    f32x4_t v[4]; float s = 0.f;
#pragma unroll
    for (int j = 0; j < 4; ++j) { v[j] = xr[64 * j]; s += v[j].x * v[j].x + v[j].y * v[j].y + v[j].z * v[j].z + v[j].w * v[j].w; }
    const float rstd = rsqrtf(wave_sum(s) * (1.f / DM) + EPS);
    u32x2_t* o = (u32x2_t*)(hn + (size_t)m * DM) + lane;
#pragma unroll
    for (int j = 0; j < 4; ++j) {
        const f32x4_t gg = ((const f32x4_t*)g)[lane + 64 * j], sh = ((const f32x4_t*)(shift + (size_t)b * mstride))[lane + 64 * j], sc = ((const f32x4_t*)(scale + (size_t)b * mstride))[lane + 64 * j];
        const f32x4_t h = v[j] * rstd * gg * (sc + 1.f) + sh;
        u32x2_t w; w.x = pkh(h.x, h.y); w.y = pkh(h.z, h.w); o[64 * j] = w;
    }
}

__global__ void __launch_bounds__(256) final_norm_kernel(float* x, const float* g) {
    const int lane = threadIdx.x & 63, m = blockIdx.x * 4 + (threadIdx.x >> 6);
    f32x4_t* xr = (f32x4_t*)(x + (size_t)m * DM) + lane;
    f32x4_t v[4]; float s = 0.f;
#pragma unroll
    for (int j = 0; j < 4; ++j) { v[j] = xr[64 * j]; s += v[j].x * v[j].x + v[j].y * v[j].y + v[j].z * v[j].z + v[j].w * v[j].w; }
    const float rstd = rsqrtf(wave_sum(s) * (1.f / DM) + EPS);
#pragma unroll
    for (int j = 0; j < 4; ++j) xr[64 * j] = v[j] * rstd * ((const f32x4_t*)g)[lane + 64 * j];
}

__global__ void __launch_bounds__(256) gdn_prep_kernel(const f16_t* C16, const float* convw, const float* AB32, const float* a_log, const float* dt_bias,
                                                       f16_t* GQ, f16_t* GK, f16_t* GV, float* Gg, float* Gb) {
    const int lane = threadIdx.x & 63, wv = blockIdx.x * 4 + (threadIdx.x >> 6), m = wv / 12, hs = wv % 12, b = m / NT, t = m % NT;
    const int c = hs * 128 + 2 * lane;
    float y0 = 0.f, y1 = 0.f;
#pragma unroll
    for (int i = 0; i < 4; ++i) { const int tt = t - 3 + i; if (tt >= 0) { const unsigned xv = *(const unsigned*)(C16 + (size_t)(m - 3 + i) * 1536 + c);
            y0 += hlo(xv) * convw[i * 1536 + c]; y1 += hhi(xv) * convw[i * 1536 + c + 1]; } }
    y0 = siluf(y0); y1 = siluf(y1);
    const int which = hs >> 2, h = hs & 3;
    if (which < 2) { const float ss = wave_sum(y0 * y0 + y1 * y1); float r = rsqrtf(ss + EPS); if (which == 0) r *= 0.08838834764831845f; y0 *= r; y1 *= r; }
    f16_t* dst = (which == 0 ? GQ : which == 1 ? GK : GV) + ((size_t)(b * GH + h) * NT + t) * GD + 2 * lane;
    *(unsigned*)dst = pkh(y0, y1);
    if (hs == 8 && lane < 4) {
        const float braw = AB32[(size_t)m * 8 + lane], araw = AB32[(size_t)m * 8 + 4 + lane];
        const float xx = araw + dt_bias[lane]; const float sp = (xx > 20.f) ? xx : log1pf(__expf(xx));
        Gg[(size_t)(b * GH + lane) * NT + t] = -__expf(a_log[lane]) * sp;
        Gb[(size_t)(b * GH + lane) * NT + t] = sigmf(braw);
    }
}

__global__ void __launch_bounds__(256) rope_kernel(const int* positions, float* QN32, float* KC32, f16_t* KV16) {
    const int idx = blockIdx.x * 256 + threadIdx.x; if (idx >= MR * 14 * 8) return;
    const int i = idx & 7, slot = (idx >> 3) % 14, m = idx / (14 * 8);
    const float pos = (float)positions[m];
    const float invf = powf(500000.0f, -(float)i * 0.125f);
    const float ang = pos * invf; const float cs = cosf(ang), sn = sinf(ang);
    if (slot < 10) { float* p = (slot < 8) ? (QN32 + (size_t)m * 512 + slot * 64) : (KC32 + (size_t)m * 128 + (slot - 8) * 64);
        const float x1 = p[i], x2 = p[i + 8]; p[i] = x1 * cs - x2 * sn; p[i + 8] = x2 * cs + x1 * sn; }
    else { f16_t* p = KV16 + (size_t)m * 640 + ((slot < 12) ? (128 + (slot - 10) * 64) : (384 + (slot - 12) * 64));
        const float x1 = h2f(p[i]), x2 = h2f(p[i + 8]); p[i] = f2h(x1 * cs - x2 * sn); p[i + 8] = f2h(x2 * cs + x1 * sn); }
}

__global__ void __launch_bounds__(128) compress_kernel(const float* KC32, const f16_t* KV16, const float* pe_k, const float* w1_k, const float* w2_k,
                                                       const float* pe_v, const float* w1_v, const float* w2_v, float* KCMP, float* VCMP) {
    __shared__ float blk[2048]; __shared__ float hid[128];
    int id = blockIdx.x; const int g = id % NG; id /= NG; const int n = id % NCMP; id /= NCMP; const int b = id % NB; const int which = id / NB;
    const float* pe = which ? pe_v : pe_k; const float* w1 = which ? w1_v : w1_k; const float* w2 = which ? w2_v : w2_k;
    for (int k = threadIdx.x; k < 2048; k += 128) { const int l = k >> 6, d = k & 63; const size_t m = (size_t)b * NT + 16 * n + l;
        const float v = which ? h2f(KV16[m * 640 + g * 64 + d]) : KC32[m * 128 + g * 64 + d]; blk[k] = v + pe[k]; }
    __syncthreads();
    float a = 0.f;
#pragma unroll 8
    for (int k = 0; k < 2048; ++k) a += blk[k] * w1[(size_t)k * 128 + threadIdx.x];
    hid[threadIdx.x] = siluf(a);
    __syncthreads();
    if (threadIdx.x < 64) { float o = 0.f;
#pragma unroll 8
        for (int j = 0; j < 128; ++j) o += hid[j] * w2[j * 64 + threadIdx.x];
        (which ? VCMP : KCMP)[((size_t)(b * NG + g) * 256 + n) * 64 + threadIdx.x] = o; }
}

__global__ void __launch_bounds__(256) cmpattn_kernel(const float* QN32, const float* KCMP, const float* VCMP, const float* GR32, float* OACC, unsigned long long* SEL) {
    __shared__ float qs_all[4][4 * 64]; __shared__ float P_all[4][4 * 256]; __shared__ float imp_all[4][64];
    const int lane = threadIdx.x & 63, w = threadIdx.x >> 6; const int id = blockIdx.x * 4 + w;
    const int t = id % NT, g = (id / NT) % NG, b = id / (NT * NG); const size_t m = (size_t)b * NT + t;
    float* qs = qs_all[w]; float* P = P_all[w]; float* imps = imp_all[w];
#pragma unroll
    for (int r = 0; r < 4; ++r) qs[r * 64 + lane] = QN32[m * 512 + (g * 4 + r) * 64 + lane] * 0.125f;
    __builtin_amdgcn_wave_barrier();
    const int nvalid = (t >= 31) ? min((t - 31) / 16 + 1, NCMP) : 0;
    const float* kc = KCMP + (size_t)(b * NG + g) * 256 * 64; const float* vc = VCMP + (size_t)(b * NG + g) * 256 * 64;
    float s[4][4];
#pragma unroll
    for (int i = 0; i < 4; ++i) { const int n = lane + 64 * i;
        if (n < nvalid) { float a0 = 0.f, a1 = 0.f, a2 = 0.f, a3 = 0.f; const float* kp = kc + (size_t)n * 64;
            for (int d = 0; d < 64; ++d) { const float kv = kp[d]; a0 += qs[d] * kv; a1 += qs[64 + d] * kv; a2 += qs[128 + d] * kv; a3 += qs[192 + d] * kv; }
            s[0][i] = a0; s[1][i] = a1; s[2][i] = a2; s[3][i] = a3; }
        else { s[0][i] = s[1][i] = s[2][i] = s[3][i] = -INFINITY; } }
#pragma unroll
    for (int r = 0; r < 4; ++r) {
        float mx = fmaxf(fmaxf(s[r][0], s[r][1]), fmaxf(s[r][2], s[r][3])); mx = wave_max(mx);
        float e[4], sum = 0.f;
#pragma unroll
        for (int i = 0; i < 4; ++i) { e[i] = (lane + 64 * i < nvalid) ? __expf(s[r][i] - mx) : 0.f; sum += e[i]; }
        sum = wave_sum(sum); const float inv = 1.f / fmaxf(sum, 1e-30f);
#pragma unroll
        for (int i = 0; i < 4; ++i) P[r * 256 + lane + 64 * i] = e[i] * inv;
    }
    __builtin_amdgcn_wave_barrier();
    float o0 = 0.f, o1 = 0.f, o2 = 0.f, o3 = 0.f;
    for (int n = 0; n < nvalid; ++n) { const float v = vc[(size_t)n * 64 + lane]; o0 += P[n] * v; o1 += P[256 + n] * v; o2 += P[512 + n] * v; o3 += P[768 + n] * v; }
    { const float* gr = GR32 + m * 24 + (g * 4) * 3; float* oa = OACC + m * 512 + (g * 4) * 64 + lane;
      oa[0] = sigmf(gr[0]) * o0; oa[64] = sigmf(gr[3]) * o1; oa[128] = sigmf(gr[6]) * o2; oa[192] = sigmf(gr[9]) * o3; }
    float imp = 0.f; { const int n0 = max(4 * lane - 1, 0), n1 = min(4 * lane + 3, NCMP - 1);
        for (int n = n0; n <= n1; ++n) imp += P[n] + P[256 + n] + P[512 + n] + P[768 + n]; }
    const int cur = t >> 6; const bool valid = lane <= cur; const bool forced = (lane == 0) || (lane == cur) || (lane == cur - 1);
    const float val = forced ? INFINITY : (valid ? imp : -INFINITY);
    imps[lane] = val;
    __builtin_amdgcn_wave_barrier();
    int rank = 0;
    for (int j = 0; j < 64; ++j) { const float o = imps[j]; rank += (o > val || (o == val && j < lane)) ? 1 : 0; }
    const unsigned long long mask = __ballot((rank < NSEL) && valid);
    if (lane == 0) SEL[(size_t)(b * NG + g) * NT + t] = mask;
}

__device__ __forceinline__ void attn_block(const f16_t* Kb, const f16_t* Vb, int pos0, int lo, int t, int lane, const float* qs, float* pl, float (&mx)[4], float (&ls)[4], float (&o)[4]) {
    const int pos = pos0 + lane; const bool ok = (pos <= t) && (pos >= lo);
    float s[4] = {-INFINITY, -INFINITY, -INFINITY, -INFINITY};
    if (ok) { const u32x4_t* kp = (const u32x4_t*)(Kb + (size_t)pos * 640); float a0 = 0.f, a1 = 0.f, a2 = 0.f, a3 = 0.f;
#pragma unroll
        for (int c8 = 0; c8 < 8; ++c8) { const u32x4_t kv = kp[c8]; const unsigned ku[4] = {kv.x, kv.y, kv.z, kv.w};
#pragma unroll
            for (int e = 0; e < 4; ++e) { const float k0 = hlo(ku[e]), k1 = hhi(ku[e]); const int d = c8 * 8 + e * 2;
                a0 += qs[d] * k0 + qs[d + 1] * k1; a1 += qs[64 + d] * k0 + qs[64 + d + 1] * k1; a2 += qs[128 + d] * k0 + qs[128 + d + 1] * k1; a3 += qs[192 + d] * k0 + qs[192 + d + 1] * k1; } }
        s[0] = a0; s[1] = a1; s[2] = a2; s[3] = a3; }
    float al[4];
#pragma unroll
    for (int r = 0; r < 4; ++r) { const float bm = wave_max(s[r]); const float mn = fmaxf(mx[r], bm);
        al[r] = (mn == -INFINITY) ? 1.f : __expf(mx[r] - mn); const float p = ok ? __expf(s[r] - mn) : 0.f; mx[r] = mn;
        ls[r] = ls[r] * al[r] + wave_sum(p); pl[r * 64 + lane] = p; o[r] *= al[r]; }
    __builtin_amdgcn_wave_barrier();
    const int kmax = min(64, t - pos0 + 1);
    for (int k = 0; k < kmax; ++k) { const float v = h2f(Vb[(size_t)(pos0 + k) * 640 + lane]);
        o[0] += pl[k] * v; o[1] += pl[64 + k] * v; o[2] += pl[128 + k] * v; o[3] += pl[192 + k] * v; }
    __builtin_amdgcn_wave_barrier();
}
__global__ void __launch_bounds__(256) selwin_kernel(const float* QN32, const f16_t* KV16, const float* GR32, const float* OACC, const unsigned long long* SEL, const float* ng, f16_t* Y) {
    __shared__ float qs_all[4][256]; __shared__ float pl_all[4][256];
    const int lane = threadIdx.x & 63, w = threadIdx.x >> 6; const int id = blockIdx.x * 4 + w;
    const int t = id % NT, g = (id / NT) % NG, b = id / (NT * NG); const size_t m = (size_t)b * NT + t;
    float* qs = qs_all[w]; float* pl = pl_all[w];
#pragma unroll
    for (int r = 0; r < 4; ++r) qs[r * 64 + lane] = QN32[m * 512 + (g * 4 + r) * 64 + lane] * 0.125f;
    __builtin_amdgcn_wave_barrier();
    const f16_t* base = KV16 + (size_t)b * NT * 640 + g * 64;
    const f16_t *Ks = base + 128, *Vs = base + 256, *Kw = base + 384, *Vw = base + 512;
    const unsigned long long mask = SEL[(size_t)(b * NG + g) * NT + t];
    float mx[4], ls[4], o[4], osel[4];
#pragma unroll
    for (int r = 0; r < 4; ++r) { mx[r] = -INFINITY; ls[r] = 0.f; o[r] = 0.f; }
    const int cur = t >> 6;
    for (int j = 0; j <= cur; ++j) if ((mask >> j) & 1ull) attn_block(Ks, Vs, 64 * j, 0, t, lane, qs, pl, mx, ls, o);
#pragma unroll
    for (int r = 0; r < 4; ++r) { osel[r] = o[r] / fmaxf(ls[r], 1e-30f); mx[r] = -INFINITY; ls[r] = 0.f; o[r] = 0.f; }
    const int lo = max(t - WIN + 1, 0);
    for (int j = lo >> 6; j <= cur; ++j) attn_block(Kw, Vw, 64 * j, lo, t, lane, qs, pl, mx, ls, o);
#pragma unroll
    for (int r = 0; r < 4; ++r) { const int hq = g * 4 + r; const float* gr = GR32 + m * 24 + hq * 3;
        float v = OACC[m * 512 + hq * 64 + lane] + sigmf(gr[1]) * osel[r] + sigmf(gr[2]) * (o[r] / fmaxf(ls[r], 1e-30f));
        const float ss = wave_sum(v * v); v = v * rsqrtf(ss * (1.f / 64.f) + EPS) * ng[lane];
        Y[m * DM + 512 + hq * 64 + lane] = f2h(v); }
}

__global__ void __launch_bounds__(64) gdn_scan_kernel(const f16_t* GQ, const f16_t* GK, const f16_t* GV, const float* Gg, const float* Gb, float* OG) {
    __shared__ float qs[32][128]; __shared__ float ks[32][128]; __shared__ float ab[2][32];
    const int lane = threadIdx.x, bh = blockIdx.x >> 1, dv = (blockIdx.x & 1) * 64 + lane, b = bh / GH, h = bh % GH;
    float S[128];
#pragma unroll
    for (int i = 0; i < 128; ++i) S[i] = 0.f;
    const f16_t* q = GQ + (size_t)bh * NT * GD; const f16_t* k = GK + (size_t)bh * NT * GD; const f16_t* v = GV + (size_t)bh * NT * GD;
    for (int t0 = 0; t0 < NT; t0 += 32) {
        __syncthreads();
        for (int i = lane; i < 32 * 64; i += 64) { const int tt = i >> 6, c = (i & 63) * 2; const unsigned qv = *(const unsigned*)(q + (size_t)(t0 + tt) * GD + c), kv = *(const unsigned*)(k + (size_t)(t0 + tt) * GD + c);
            qs[tt][c] = hlo(qv); qs[tt][c + 1] = hhi(qv); ks[tt][c] = hlo(kv); ks[tt][c + 1] = hhi(kv); }
        if (lane < 32) { ab[0][lane] = __expf(Gg[(size_t)bh * NT + t0 + lane]); ab[1][lane] = Gb[(size_t)bh * NT + t0 + lane]; }
        __syncthreads();
        for (int tt = 0; tt < 32; ++tt) {
            const float a = ab[0][tt], beta = ab[1][tt]; const float vv = h2f(v[(size_t)(t0 + tt) * GD + dv]);
            float kS = 0.f;
#pragma unroll
            for (int i = 0; i < 128; ++i) kS += ks[tt][i] * S[i];
            const float vn = beta * (vv - a * kS);
            float oo = 0.f;
#pragma unroll
            for (int i = 0; i < 128; ++i) { S[i] = a * S[i] + ks[tt][i] * vn; oo += qs[tt][i] * S[i]; }
            OG[((size_t)b * NT + t0 + tt) * GW + h * GD + dv] = oo;
        }
    }
}

__global__ void __launch_bounds__(256) gdn_out_kernel(const float* OG, const f16_t* Z16, const float* ng, f16_t* Y) {
    const int lane = threadIdx.x & 63, wv = blockIdx.x * 4 + (threadIdx.x >> 6), m = wv >> 2, h = wv & 3;
    const f32x2_t o = *(const f32x2_t*)(OG + (size_t)m * GW + h * GD + 2 * lane);
    const float r = rsqrtf(wave_sum(o.x * o.x + o.y * o.y) * (1.f / GD) + EPS);
    const unsigned z = *(const unsigned*)(Z16 + (size_t)m * GW + h * GD + 2 * lane);
    *(unsigned*)(Y + (size_t)m * DM + h * GD + 2 * lane) = pkh(o.x * r * ng[2 * lane] * siluf(hlo(z)), o.y * r * ng[2 * lane + 1] * siluf(hhi(z)));
}

template <class Epi> static void launch_gemm(const f16_t* A, const f16_t* Bt, int N, int K, const Epi& E, hipStream_t st) {
    static bool once = false;
    if (!once) { (void)hipFuncSetAttribute((const void*)gemm_kernel<Epi>, hipFuncAttributeMaxDynamicSharedMemorySize, pg8::STAGE_BYTES); once = true; }
    pg8::Gemm g{A, Bt, MR, N, K, 0};
    hipLaunchKernelGGL(gemm_kernel<Epi>, dim3(256), dim3(512), pg8::STAGE_BYTES, st, g, E);
}

extern "C" void kernel_launch(void* const* d_in, const int* in_sizes, int n_in, void* d_out, int out_size, void* d_ws, size_t ws_size, hipStream_t stream) {
    if (n_in != 22 || out_size != MR * DM || ws_size < WS_END) { fprintf(stderr, "kernel_launch: unexpected shapes (n_in %d out %d ws %zu)\n", n_in, out_size, ws_size); return; }
    const float* x = (const float*)d_in[0]; const float* c = (const float*)d_in[1]; const int* positions = (const int*)d_in[2];
    const float* ada_w = (const float*)d_in[3]; const float* ada_b = (const float*)d_in[4]; const float* norm_g = (const float*)d_in[5];
    const float* ffn_w_in = (const float*)d_in[6]; const float* ffn_w_out = (const float*)d_in[7]; const float* mix_w_in = (const float*)d_in[8];
    const float* conv_w = (const float*)d_in[9]; const float* a_log = (const float*)d_in[10]; const float* dt_bias = (const float*)d_in[11]; const float* gdn_ng = (const float*)d_in[12];
    const float* pe_k = (const float*)d_in[13]; const float* w1_k = (const float*)d_in[14]; const float* w2_k = (const float*)d_in[15];
    const float* pe_v = (const float*)d_in[16]; const float* w1_v = (const float*)d_in[17]; const float* w2_v = (const float*)d_in[18];
    const float* nsa_ng = (const float*)d_in[19]; const float* mix_w_out = (const float*)d_in[20]; const float* final_g = (const float*)d_in[21];
    float* out = (float*)d_out; unsigned char* ws = (unsigned char*)d_ws;
    float* MOD = (float*)(ws + WS_MOD);
    f16_t* WT1 = (f16_t*)(ws + WS_WT1); f16_t* WT2 = (f16_t*)(ws + WS_WT2); f16_t* WTIN = (f16_t*)(ws + WS_WTIN); f16_t* WTOUT = (f16_t*)(ws + WS_WTOUT);
    f16_t* HN = (f16_t*)(ws + WS_HN); f16_t* ACT = (f16_t*)(ws + WS_ACT); f16_t* C16 = (f16_t*)(ws + WS_C16); float* OG32 = (float*)(ws + WS_OG32);
    f16_t* Z16 = (f16_t*)(ws + WS_Z16); f16_t* KV16 = (f16_t*)(ws + WS_KV16); float* QN32 = (float*)(ws + WS_QN32); float* KC32 = (float*)(ws + WS_KC32);
    float* AB32 = (float*)(ws + WS_AB32); float* GR32 = (float*)(ws + WS_GR32); f16_t* GQ = (f16_t*)(ws + WS_GQ); f16_t* GK = (f16_t*)(ws + WS_GK); f16_t* GV = (f16_t*)(ws + WS_GV);
    float* Gg = (float*)(ws + WS_GG); float* Gb = (float*)(ws + WS_GB); float* KCMP = (float*)(ws + WS_KCMP); float* VCMP = (float*)(ws + WS_VCMP);
    unsigned long long* SEL = (unsigned long long*)(ws + WS_SEL); float* OACC = (float*)(ws + WS_OACC);

    hipLaunchKernelGGL(mod_kernel, dim3(2 * 9216 / 64), dim3(64), 0, stream, c, ada_w, ada_b, MOD);
    (void)hipMemsetAsync(WTIN, 0, (size_t)DEPTH * NINP * DM * 2, stream);
    for (int l = 0; l < DEPTH; ++l) {
        for (int f = 0; f < 2; ++f) {
            hipLaunchKernelGGL(wconv_kernel, dim3(1024), dim3(256), 0, stream, ffn_w_in + (size_t)(l * 2 + f) * DM * 2 * FF, DM, 2 * FF, WT1 + (size_t)(l * 2 + f) * 2 * FF * DM, 1);
            hipLaunchKernelGGL(wconv_kernel, dim3(1024), dim3(256), 0, stream, ffn_w_out + (size_t)(l * 2 + f) * FF * DM, FF, DM, WT2 + (size_t)(l * 2 + f) * DM * FF, 0);
        }
        hipLaunchKernelGGL(wconv_kernel, dim3(1024), dim3(256), 0, stream, mix_w_in + (size_t)l * DM * NIN, DM, NIN, WTIN + (size_t)l * NINP * DM, 0);
        hipLaunchKernelGGL(wconv_kernel, dim3(1024), dim3(256), 0, stream, mix_w_out + (size_t)l * DM * DM, DM, DM, WTOUT + (size_t)l * DM * DM, 0);
    }
    const float* xcur = x;
    for (int l = 0; l < DEPTH; ++l) {
        const float* modl = MOD + (size_t)l * NB * 9216;
        hipLaunchKernelGGL(norm_mod_kernel, dim3(MR / 4), dim3(256), 0, stream, xcur, norm_g + (size_t)(l * 3 + 0) * DM, modl + 0 * DM, modl + 1 * DM, 9216, HN);
        launch_gemm(HN, WT1 + (size_t)(l * 2 + 0) * 2 * FF * DM, 2 * FF, DM, pg8::EpiSwiglu{ACT}, stream);
        launch_gemm(ACT, WT2 + (size_t)(l * 2 + 0) * DM * FF, DM, FF, pg8::EpiResidual{xcur, out, modl + 2 * DM, 9216, 0.5f}, stream);
        xcur = out;
        hipLaunchKernelGGL(norm_mod_kernel, dim3(MR / 4), dim3(256), 0, stream, xcur, norm_g + (size_t)(l * 3 + 1) * DM, modl + 3 * DM, modl + 4 * DM, 9216, HN);
        launch_gemm(HN, WTIN + (size_t)l * NINP * DM, NINP, DM, pg8::EpiInProj{C16, Z16, AB32, QN32, KC32, KV16, GR32}, stream);
        hipLaunchKernelGGL(gdn_prep_kernel, dim3(MR * 12 / 4), dim3(256), 0, stream, C16, conv_w + (size_t)l * 4 * 1536, AB32, a_log + l * 4, dt_bias + l * 4, GQ, GK, GV, Gg, Gb);
        hipLaunchKernelGGL(rope_kernel, dim3(MR * 14 * 8 / 256), dim3(256), 0, stream, positions, QN32, KC32, KV16);
        hipLaunchKernelGGL(compress_kernel, dim3(2 * NB * NCMP * NG), dim3(128), 0, stream, KC32, KV16, pe_k + (size_t)l * 2048, w1_k + (size_t)l * 2048 * 128, w2_k + (size_t)l * 128 * 64,
                           pe_v + (size_t)l * 2048, w1_v + (size_t)l * 2048 * 128, w2_v + (size_t)l * 128 * 64, KCMP, VCMP);
        hipLaunchKernelGGL(gdn_scan_kernel, dim3(NB * GH * 2), dim3(64), 0, stream, GQ, GK, GV, Gg, Gb, OG32);
        hipLaunchKernelGGL(gdn_out_kernel, dim3(MR), dim3(256), 0, stream, OG32, Z16, gdn_ng + l * GD, HN);
        hipLaunchKernelGGL(cmpattn_kernel, dim3(NB * NG * NT / 4), dim3(256), 0, stream, QN32, KCMP, VCMP, GR32, OACC, SEL);
        hipLaunchKernelGGL(selwin_kernel, dim3(NB * NG * NT / 4), dim3(256), 0, stream, QN32, KV16, GR32, OACC, SEL, nsa_ng + l * HD, HN);
        launch_gemm(HN, WTOUT + (size_t)l * DM * DM, DM, DM, pg8::EpiResidual{xcur, out, modl + 5 * DM, 9216, 1.0f}, stream);
        hipLaunchKernelGGL(norm_mod_kernel, dim3(MR / 4), dim3(256), 0, stream, xcur, norm_g + (size_t)(l * 3 + 2) * DM, modl + 6 * DM, modl + 7 * DM, 9216, HN);
        launch_gemm(HN, WT1 + (size_t)(l * 2 + 1) * 2 * FF * DM, 2 * FF, DM, pg8::EpiSwiglu{ACT}, stream);
        launch_gemm(ACT, WT2 + (size_t)(l * 2 + 1) * DM * FF, DM, FF, pg8::EpiResidual{xcur, out, modl + 8 * DM, 9216, 0.5f}, stream);
    }
    hipLaunchKernelGGL(final_norm_kernel, dim3(MR / 4), dim3(256), 0, stream, out, final_g);
}
```

```cpp
#include <hip/hip_runtime.h>
#include <cstdio>
#include <cstdint>

constexpr int NB = 4, NT = 4096, DM = 1024, MR = NB * NT, FF = 2816, NIN = 3360, NINP = 3584, DEPTH = 2;
constexpr int GH = 4, GD = 128, GW = 512;
constexpr int NH = 8, NG = 2, HD = 64;
constexpr int NCMP = 255, NBLK = 64, NSEL = 16, WIN = 512;
constexpr float EPS = 1e-6f;
constexpr size_t MiB = 1u << 20;
constexpr size_t WS_CTL = 0, WS_MOD = 1 * MiB, WS_WT1 = 4 * MiB, WS_WT2 = 48 * MiB, WS_WTIN = 70 * MiB, WS_WTOUT = 84 * MiB, WS_W1C = 88 * MiB,
                 WS_HN = 90 * MiB, WS_ACT = 122 * MiB, WS_C16 = 122 * MiB, WS_OG32 = 122 * MiB, WS_Z16 = 170 * MiB, WS_KV16 = 186 * MiB,
                 WS_QN32 = 210 * MiB, WS_KC32 = 242 * MiB, WS_AB32 = 250 * MiB, WS_GR32 = 251 * MiB, WS_GQ = 253 * MiB, WS_GK = 269 * MiB, WS_GV = 285 * MiB,
                 WS_GG = 301 * MiB, WS_GB = 301 * MiB + 512 * 1024, WS_KCMP = 302 * MiB, WS_VCMP = 302 * MiB + 512 * 1024, WS_SEL = 303 * MiB, WS_OACC = 304 * MiB, WS_END = 336 * MiB;

typedef unsigned short f16_t;
typedef _Float16 h2_t __attribute__((ext_vector_type(2)));
typedef float f32x2_t __attribute__((ext_vector_type(2)));
typedef float f32x4_t __attribute__((ext_vector_type(4)));
typedef unsigned u32x4_t __attribute__((ext_vector_type(4)));
typedef unsigned u32x2_t __attribute__((ext_vector_type(2)));
__device__ __forceinline__ unsigned pkh(float lo, float hi) { f32x2_t v = {lo, hi}; h2_t h = __builtin_convertvector(v, h2_t); return __builtin_bit_cast(unsigned, h); }
__device__ __forceinline__ float h2f(f16_t u) { return (float)__builtin_bit_cast(_Float16, u); }
__device__ __forceinline__ f16_t f2h(float f) { return __builtin_bit_cast(f16_t, (_Float16)f); }
__device__ __forceinline__ float hlo(unsigned u) { return h2f((f16_t)(u & 0xffffu)); }
__device__ __forceinline__ float hhi(unsigned u) { return h2f((f16_t)(u >> 16)); }
__device__ __forceinline__ float siluf(float x) { return x / (1.f + __expf(-x)); }
__device__ __forceinline__ float sigmf(float x) { return 1.f / (1.f + __expf(-x)); }
__device__ __forceinline__ float wave_sum(float v) {
#pragma unroll
    for (int o = 1; o < 64; o <<= 1) v += __shfl_xor(v, o);
    return v;
}
__device__ __forceinline__ float wave_max(float v) {
#pragma unroll
    for (int o = 1; o < 64; o <<= 1) v = fmaxf(v, __shfl_xor(v, o));
    return v;
}

namespace pg8 {
#define PG8_LAS __attribute__((address_space(3)))
typedef unsigned short bf16_t;
typedef _Float16 bf16x8 __attribute__((ext_vector_type(8)));
typedef float f32x4 __attribute__((ext_vector_type(4)));
typedef unsigned u32x4 __attribute__((ext_vector_type(4)));
constexpr int BM = 256, BK = 64, HALF = 128, HTB = HALF * BK * 2  , STAGE_BYTES = 8 * HTB, NXCD = 8, WGM = 8;

__host__ __device__ __forceinline__ int lds_byte(int r, int c) { const int st = (r >> 4) * 2 + (c >> 5), rr = r & 15, cc = c & 31, ob = rr * 64 + cc * 2; return st * 1024 + (ob ^ (((ob >> 9) & 1) << 5)); }
__host__ __device__ __forceinline__ void stage_rc(int b, int& R, int& C) { const int st = b / 1024, sb = b % 1024, swz = sb ^ (((sb >> 9) & 1) << 5); R = (st >> 1) * 16 + swz / 64; C = (st & 1) * 32 + (swz % 64) / 2; }
__host__ __device__ __forceinline__ int perm32(int rho) { const int n = rho >> 4, i = rho & 15; return 8 * (i >> 2) + 4 * n + (i & 3); }

struct Unit { int pm, pn; };
struct Gemm { const bf16_t* A; const bf16_t* Bt; int M, N, K, pad; };

struct StaticOrder {
    int nM, nN, nwg, G, c;
    __host__ __device__ void init(int M, int N, int G_, int c_) { nM = M / BM; nN = N / BM; nwg = nM * nN; G = G_; c = c_; }
    __host__ __device__ bool next(int i, Unit& u) const {
        const long L = (long)i * G + c; if (L >= nwg) return false;
        int wgid = (int)L; { const int q = nwg / NXCD, r = nwg % NXCD, xcd = wgid % NXCD, off = wgid / NXCD; wgid = (xcd < r ? xcd * (q + 1) : r * (q + 1) + (xcd - r) * q) + off; }
        const int nig = WGM * nN, gid = wgid / nig, fm = gid * WGM, gsz = (nM - fm) < WGM ? (nM - fm) : WGM;
        u.pm = fm + ((wgid % nig) % gsz); u.pn = (wgid % nig) / gsz; return true;
    }
    __device__ __forceinline__ void a_ready(const Unit&) const {}
    __device__ __forceinline__ void done(const Unit&) const {}
};


template <class Epi, class Sched, bool ALIGN_EPI = false, bool SP2 = false>
__device__ __forceinline__ void gemm_phase(PG8_LAS unsigned char* lds, const Gemm g, const Sched& S, const Epi& E) {
    int tid_ = threadIdx.x; asm volatile("" : "+v"(tid_));
    const int tid = tid_, wid = __builtin_amdgcn_readfirstlane(tid >> 6), lane = tid & 63, wr = wid >> 2, wc = wid & 3, fr = lane & 15, fq = lane >> 4;
    const int K = g.K, nt = K / BK;
    unsigned voffA[2], voffB[2];
#pragma unroll
    for (int i = 0; i < 2; ++i) { int R, C; stage_rc(tid * 16 + i * 8192, R, C); const int Rb = Epi::PERM ? ((R & ~31) + perm32(R & 31)) : R;
        voffA[i] = (unsigned)(R * K + C) * 2u; voffB[i] = (unsigned)(Rb * K + C) * 2u; }
    const size_t kstep = (size_t)(BK * 2);
    const size_t hstep = (size_t)HALF * K * 2;
    const size_t tstep = 2 * hstep;
    const unsigned ldsw = (unsigned)wid * 1024u;
    const int aoff = lds_byte(wr * 64 + fr, fq * 8), boff = lds_byte(wc * 32 + fr, fq * 8);
#define PG8_SA(b, h) (((b) * 2 + (h)) * HTB)
#define PG8_SB(b, h) ((4 + (b) * 2 + (h)) * HTB)
#define PG8_STAGE(bufoff, gbase, voff) do { _Pragma("unroll") for (int _i = 0; _i < 2; ++_i) \
        __builtin_amdgcn_global_load_lds((const unsigned*)((const char*)(gbase) + (voff)[_i]), (PG8_LAS unsigned*)(lds + (bufoff) + ldsw + _i * 8192), 16, 0, 0); } while (0)
#define PG8_LDA(dst, b, h) do { _Pragma("unroll") for (int m = 0; m < 4; ++m) _Pragma("unroll") for (int k = 0; k < 2; ++k) dst[m][k] = *(const PG8_LAS bf16x8*)(lds + PG8_SA(b, h) + aoff + m * 2048 + k * 1024); } while (0)
#define PG8_LDB(dst, b, h) do { _Pragma("unroll") for (int n = 0; n < 2; ++n) _Pragma("unroll") for (int k = 0; k < 2; ++k) dst[n][k] = *(const PG8_LAS bf16x8*)(lds + PG8_SB(b, h) + boff + n * 2048 + k * 1024); } while (0)
#define PG8_MMA(ai, bj, At, Bt) do { __builtin_amdgcn_s_setprio(1); _Pragma("unroll") for (int m = 0; m < 4; ++m) _Pragma("unroll") for (int n = 0; n < 2; ++n) _Pragma("unroll") for (int k = 0; k < 2; ++k) \
        acc[ai][bj][m][n] = __builtin_amdgcn_mfma_f32_16x16x32_f16(Bt[n][k], At[m][k], acc[ai][bj][m][n], 0, 0, 0); __builtin_amdgcn_s_setprio(0); } while (0)
#define PG8_WAIT_V(n) asm volatile("s_waitcnt vmcnt(" #n ")" ::: "memory")
#define PG8_WAIT_L(n) asm volatile("s_waitcnt lgkmcnt(" #n ")" ::: "memory")
#define PG8_BAR __builtin_amdgcn_s_barrier()
#define PG8_SCHED __builtin_amdgcn_sched_barrier(0)
    Unit cur, nxt; int ui = 0;
    if (!S.next(0, cur)) return;
    f32x4 acc[2][2][4][2];
#pragma unroll
    for (int a = 0; a < 2; ++a)
#pragma unroll
        for (int b = 0; b < 2; ++b)
#pragma unroll
            for (int m = 0; m < 4; ++m)
#pragma unroll
                for (int n = 0; n < 2; ++n) acc[a][b][m][n] = (f32x4){0.f, 0.f, 0.f, 0.f};
    bf16x8 At[4][2], B0[2][2], B1[2][2];
    const char* cA = (const char*)g.A + (size_t)cur.pm * tstep; const char* cB = (const char*)g.Bt + (size_t)cur.pn * tstep;
    S.a_ready(cur);
    if constexpr (SP2) {
        PG8_STAGE(PG8_SB(0, 0), cB, voffB); PG8_STAGE(PG8_SB(0, 1), cB + hstep, voffB); PG8_STAGE(PG8_SA(0, 0), cA, voffA); PG8_STAGE(PG8_SA(0, 1), cA + hstep, voffA);
        if (wr == 1) PG8_BAR;
        PG8_WAIT_V(2); PG8_BAR;
        PG8_STAGE(PG8_SB(1, 0), cB + kstep, voffB); PG8_STAGE(PG8_SA(1, 0), cA + kstep, voffA); PG8_STAGE(PG8_SB(1, 1), cB + hstep + kstep, voffB);
        PG8_WAIT_V(6); PG8_BAR;
    } else {
        PG8_STAGE(PG8_SB(0, 0), cB, voffB); PG8_STAGE(PG8_SA(0, 0), cA, voffA); PG8_STAGE(PG8_SB(0, 1), cB + hstep, voffB); PG8_STAGE(PG8_SA(0, 1), cA + hstep, voffA);
        if (wr == 1) PG8_BAR;
        PG8_WAIT_V(4); PG8_BAR;
        PG8_STAGE(PG8_SB(1, 0), cB + kstep, voffB); PG8_STAGE(PG8_SA(1, 0), cA + kstep, voffA); PG8_STAGE(PG8_SB(1, 1), cB + hstep + kstep, voffB);
        PG8_WAIT_V(6); PG8_BAR;
    }
    for (;;) {
        const bool has_next = S.next(ui + 1, nxt);
        const char* nA = has_next ? (const char*)g.A + (size_t)nxt.pm * tstep : cA; const char* nB = has_next ? (const char*)g.Bt + (size_t)nxt.pn * tstep : cB;
        for (int t = 0; t < nt; t += 2) {
            const bool last = (t == nt - 2);
            const char* a1 = cA + (size_t)(t + 1) * kstep;
            const char* a2 = last ? nA : cA + (size_t)(t + 2) * kstep; const char* b2 = last ? nB : cB + (size_t)(t + 2) * kstep;
            const char* a3 = a2 + kstep; const char* b3 = b2 + kstep;
            if (last && has_next) S.a_ready(nxt);
            if constexpr (SP2) {
            PG8_LDB(B0, 0, 0); PG8_LDB(B1, 0, 1); PG8_SCHED; PG8_LDA(At, 0, 0); PG8_STAGE(PG8_SA(1, 1), a1 + hstep, voffA);
            PG8_WAIT_V(8); PG8_WAIT_L(0); PG8_BAR; PG8_MMA(0, 0, At, B0); PG8_MMA(0, 1, At, B1); PG8_BAR; PG8_SCHED;
            PG8_LDA(At, 0, 1); PG8_STAGE(PG8_SB(0, 0), b2, voffB); PG8_STAGE(PG8_SB(0, 1), b2 + hstep, voffB); PG8_STAGE(PG8_SA(0, 0), a2, voffA);
            PG8_WAIT_V(8); PG8_WAIT_L(0); PG8_BAR; PG8_MMA(1, 0, At, B0); PG8_MMA(1, 1, At, B1); PG8_BAR; PG8_SCHED;
            PG8_LDB(B0, 1, 0); PG8_LDB(B1, 1, 1); PG8_SCHED; PG8_LDA(At, 1, 0); PG8_STAGE(PG8_SA(0, 1), a2 + hstep, voffA);
            PG8_WAIT_V(8); PG8_WAIT_L(0); PG8_BAR; PG8_MMA(0, 0, At, B0); PG8_MMA(0, 1, At, B1); PG8_BAR; PG8_SCHED;
            PG8_LDA(At, 1, 1); PG8_STAGE(PG8_SB(1, 0), b3, voffB); PG8_STAGE(PG8_SB(1, 1), b3 + hstep, voffB); PG8_STAGE(PG8_SA(1, 0), a3, voffA);
            PG8_WAIT_V(8); PG8_WAIT_L(0); PG8_BAR; PG8_MMA(1, 0, At, B0); PG8_MMA(1, 1, At, B1); PG8_BAR; PG8_SCHED;
            } else {
            PG8_LDB(B0, 0, 0); PG8_SCHED; PG8_LDA(At, 0, 0); PG8_STAGE(PG8_SA(1, 1), a1 + hstep, voffA);
            PG8_WAIT_L(8); PG8_BAR; PG8_WAIT_L(0); PG8_MMA(0, 0, At, B0); PG8_BAR; PG8_SCHED;
            PG8_LDB(B1, 0, 1); PG8_STAGE(PG8_SB(0, 0), b2, voffB);
            PG8_BAR; PG8_WAIT_L(0); PG8_MMA(0, 1, At, B1); PG8_BAR;
            PG8_LDA(At, 0, 1); PG8_STAGE(PG8_SA(0, 0), a2, voffA);
            PG8_BAR; PG8_WAIT_L(0); PG8_MMA(1, 0, At, B0); PG8_BAR; PG8_SCHED;
            PG8_STAGE(PG8_SB(0, 1), b2 + hstep, voffB);
            PG8_WAIT_V(6); PG8_BAR; PG8_MMA(1, 1, At, B1); PG8_BAR;
            PG8_LDB(B0, 1, 0); PG8_SCHED; PG8_LDA(At, 1, 0); PG8_STAGE(PG8_SA(0, 1), a2 + hstep, voffA);
            PG8_WAIT_L(8); PG8_BAR; PG8_WAIT_L(0); PG8_MMA(0, 0, At, B0); PG8_BAR; PG8_SCHED;
            PG8_LDB(B1, 1, 1); PG8_STAGE(PG8_SB(1, 0), b3, voffB);
            PG8_BAR; PG8_WAIT_L(0); PG8_MMA(0, 1, At, B1); PG8_BAR;
            PG8_LDA(At, 1, 1); PG8_STAGE(PG8_SA(1, 0), a3, voffA);
            PG8_BAR; PG8_WAIT_L(0); PG8_MMA(1, 0, At, B0); PG8_BAR; PG8_SCHED;
            PG8_STAGE(PG8_SB(1, 1), b3 + hstep, voffB);
            PG8_WAIT_V(6); PG8_BAR; PG8_MMA(1, 1, At, B1); PG8_BAR;
            }
        }
        if constexpr (ALIGN_EPI) { if (wr == 0) PG8_BAR; }
        if constexpr (!Epi::AFTER_DRAIN) { E(acc, cur, wr, wc, fr, fq); S.done(cur); }
        if (!has_next) break;
#pragma unroll
        for (int a = 0; a < 2; ++a)
#pragma unroll
            for (int b = 0; b < 2; ++b)
#pragma unroll
                for (int m = 0; m < 4; ++m)
#pragma unroll
                    for (int n = 0; n < 2; ++n) acc[a][b][m][n] = (f32x4){0.f, 0.f, 0.f, 0.f};
        cur = nxt; cA = nA; cB = nB; ++ui;
        if constexpr (ALIGN_EPI) { if (wr == 1) PG8_BAR; }
    }
    PG8_WAIT_V(0);
    if constexpr (!ALIGN_EPI) { if (wr == 0) PG8_BAR; }
    PG8_BAR;
    if constexpr (Epi::AFTER_DRAIN) { E.fused(acc, cur, wr, wc, fr, fq, lds, wid, lane); S.done(cur); }
#undef PG8_SA
#undef PG8_SB
#undef PG8_STAGE
#undef PG8_LDA
#undef PG8_LDB
#undef PG8_MMA
#undef PG8_WAIT_V
#undef PG8_WAIT_L
#undef PG8_BAR
#undef PG8_SCHED
}
}

namespace pg8 {
struct EpiSwiglu {
    static constexpr bool PERM = true, AFTER_DRAIN = false;
    f16_t* O;
    __device__ __forceinline__ void operator()(const f32x4 (&acc)[2][2][4][2], const Unit& u, int wr, int wc, int fr, int fq) const {
        const int row0 = u.pm * BM + wr * 64 + fr, col0 = u.pn * 128 + wc * 32 + 8 * fq;
#pragma unroll
        for (int ai = 0; ai < 2; ++ai)
#pragma unroll
            for (int m = 0; m < 4; ++m) {
                const f32x4 g0 = acc[ai][0][m][0], g1 = acc[ai][0][m][1], u0 = acc[ai][1][m][0], u1 = acc[ai][1][m][1];
                u32x4 w;
                w.x = pkh(siluf(g0[0]) * u0[0], siluf(g0[1]) * u0[1]); w.y = pkh(siluf(g0[2]) * u0[2], siluf(g0[3]) * u0[3]);
                w.z = pkh(siluf(g1[0]) * u1[0], siluf(g1[1]) * u1[1]); w.w = pkh(siluf(g1[2]) * u1[2], siluf(g1[3]) * u1[3]);
                *(u32x4*)(O + (size_t)(row0 + ai * HALF + m * 16) * FF + col0) = w;
            }
    }
};
struct EpiResidual {
    static constexpr bool PERM = false, AFTER_DRAIN = false;
    const float* base; float* out; const float* gate; int gstride; float coef;
    __device__ __forceinline__ void operator()(const f32x4 (&acc)[2][2][4][2], const Unit& u, int wr, int wc, int fr, int fq) const {
        const int row0 = u.pm * BM + wr * 64 + fr, col0 = u.pn * BM + wc * 32 + 4 * fq;
        const float* gp = gate + (size_t)(u.pm / (NT / BM)) * gstride + col0;
        f32x4 gv[2][2];
#pragma unroll
        for (int bj = 0; bj < 2; ++bj)
#pragma unroll
            for (int n = 0; n < 2; ++n) gv[bj][n] = *(const f32x4*)(gp + bj * HALF + n * 16) * coef;
#pragma unroll
        for (int ai = 0; ai < 2; ++ai)
#pragma unroll
            for (int m = 0; m < 4; ++m) { const size_t off = (size_t)(row0 + ai * HALF + m * 16) * DM + col0;
#pragma unroll
                for (int bj = 0; bj < 2; ++bj)
#pragma unroll
                    for (int n = 0; n < 2; ++n) { const f32x4 bs = *(const f32x4*)(base + off + bj * HALF + n * 16);
                        *(f32x4*)(out + off + bj * HALF + n * 16) = bs + gv[bj][n] * acc[ai][bj][m][n]; } }
    }
};
struct EpiInProj {
    static constexpr bool PERM = true, AFTER_DRAIN = false;
    f16_t* C16; f16_t* Z16; float* AB32; float* QN32; float* KC32; f16_t* KV16; float* GR32;
    __device__ __forceinline__ void operator()(const f32x4 (&acc)[2][2][4][2], const Unit& u, int wr, int wc, int fr, int fq) const {
        const int row0 = u.pm * BM + wr * 64 + fr;
#pragma unroll
        for (int bj = 0; bj < 2; ++bj) {
            const int c0 = u.pn * BM + bj * HALF + wc * 32 + 8 * fq;
            int kind; size_t ld; int cc; void* basep;
            if (c0 < 1536)      { kind = 0; basep = C16;  ld = 1536; cc = c0; }
            else if (c0 < 2048) { kind = 0; basep = Z16;  ld = 512;  cc = c0 - 1536; }
            else if (c0 < 2056) { kind = 1; basep = AB32; ld = 8;    cc = 0; }
            else if (c0 < 2568) { kind = 1; basep = QN32; ld = 512;  cc = c0 - 2056; }
            else if (c0 < 2696) { kind = 1; basep = KC32; ld = 128;  cc = c0 - 2568; }
            else if (c0 < 3336) { kind = 0; basep = KV16; ld = 640;  cc = c0 - 2696; }
            else if (c0 < 3360) { kind = 1; basep = GR32; ld = 24;   cc = c0 - 3336; }
            else continue;
#pragma unroll
            for (int ai = 0; ai < 2; ++ai)
#pragma unroll
                for (int m = 0; m < 4; ++m) {
                    const size_t row = (size_t)(row0 + ai * HALF + m * 16);
                    const f32x4 v0 = acc[ai][bj][m][0], v1 = acc[ai][bj][m][1];
                    if (kind == 0) { u32x4 w; w.x = pkh(v0[0], v0[1]); w.y = pkh(v0[2], v0[3]); w.z = pkh(v1[0], v1[1]); w.w = pkh(v1[2], v1[3]);
                        *(u32x4*)((f16_t*)basep + row * ld + cc) = w; }
                    else { float* p = (float*)basep + row * ld + cc; *(f32x4*)p = v0; *(f32x4*)(p + 4) = v1; }
                }
        }
    }
};
}

#define GAS __attribute__((address_space(1)))
#define LAS __attribute__((address_space(3)))
typedef GAS unsigned gu32;
#define RLX_AGENT __ATOMIC_RELAXED, __HIP_MEMORY_SCOPE_AGENT
#define XB_TMO      128
#define XB_XCNT(j)  (256  + 64 * (j))
#define XB_XSUB(j)  (1280 + 64 * (j))
#define XB_XGEN(j)  (2304 + 64 * (j))
#define XB_TOP      3328
#define XB_TOPGEN   3392
#define XCD_BAR_WORDS 3456
#define XB_SPIN_CAP (1u << 18)

__device__ __forceinline__ unsigned xb_ld(unsigned* p)              { return __hip_atomic_load(p, __ATOMIC_RELAXED, __HIP_MEMORY_SCOPE_AGENT); }
__device__ __forceinline__ unsigned xb_add(unsigned* p, unsigned v) { return __hip_atomic_fetch_add(p, v, __ATOMIC_RELAXED, __HIP_MEMORY_SCOPE_AGENT); }
__device__ __forceinline__ unsigned xb_xcc_id() { return (unsigned)__builtin_amdgcn_s_getreg((3 << 11) | 20) & 0xFu; }
#define XB_SPIN(cond, bar) do { unsigned _sp = 0; while (cond) { __builtin_amdgcn_s_sleep(1); \
    if ((++_sp & 255u) == 0u) { if (xb_ld(&(bar)[XB_TMO])) break; if (_sp > XB_SPIN_CAP) { atomicAdd(&(bar)[XB_TMO], 1u); break; } } } } while (0)

struct XcdBarrier {
    unsigned* bar; unsigned x;
    volatile LAS unsigned* st;
};

__device__ __forceinline__ XcdBarrier xcd_barrier_post(unsigned* bar, volatile LAS unsigned* st) {
    XcdBarrier b; b.bar = bar; b.x = xb_xcc_id(); b.st = st;
    if (threadIdx.x == 0) (void)xb_add(&bar[XB_XCNT(b.x)], 1u);
    return b;
}
__device__ __forceinline__ void xcd_barrier_complete(unsigned* bar, unsigned x, unsigned& nloc, unsigned& nx) {
    const unsigned G = gridDim.x * gridDim.y * gridDim.z;
    unsigned sum, cnt, mine, sp = 0u;
    for (;;) {
        sum = 0u; cnt = 0u; mine = 0u;
#pragma unroll
        for (unsigned j = 0; j < 16; ++j) { const unsigned c = xb_ld(&bar[XB_XCNT(j)]); sum += c; cnt += (c > 0u) ? 1u : 0u; mine = (j == x) ? c : mine; }
        if (sum == G) break;
        __builtin_amdgcn_s_sleep(1);
        if ((++sp & 255u) == 0u) { if (xb_ld(&bar[XB_TMO])) break; if (sp > XB_SPIN_CAP) { atomicAdd(&bar[XB_TMO], 1u); break; } }
    }
    nloc = mine > 0u ? mine : 1u; nx = cnt > 0u ? cnt : 1u;
}

__device__ __forceinline__ void xcd_barrier(const XcdBarrier& b) {
    asm volatile("s_waitcnt vmcnt(0)" ::: "memory");
    __syncthreads();
    if (threadIdx.x == 0) {
        unsigned* bar = b.bar;
        __builtin_amdgcn_s_waitcnt(0);
        unsigned nloc = b.st[0], nx = b.st[1];
        if (nloc == 0u) { xcd_barrier_complete(bar, b.x, nloc, nx); b.st[0] = nloc; b.st[1] = nx; }
        const unsigned old = xb_add(&bar[XB_XSUB(b.x)], 1u);
        const unsigned gen = old / nloc;
        if (old + 1u == (gen + 1u) * nloc) {
            __builtin_amdgcn_fence(__ATOMIC_RELEASE, "agent");
            asm volatile("s_waitcnt vmcnt(0)" ::: "memory");
            const unsigned og = xb_add(&bar[XB_TOP], 1u);
            const unsigned tg = og / nx;
            if (og + 1u == (tg + 1u) * nx) xb_add(&bar[XB_TOPGEN], 1u);
            else XB_SPIN(xb_ld(&bar[XB_TOPGEN]) == tg, bar);
            __builtin_amdgcn_fence(__ATOMIC_ACQUIRE, "agent");
            xb_add(&bar[XB_XGEN(b.x)], 1u);
            asm volatile("s_waitcnt vmcnt(0)" ::: "memory");
        } else {
            XB_SPIN(xb_ld(&bar[XB_XGEN(b.x)]) == gen, bar);
            __builtin_amdgcn_fence(__ATOMIC_ACQUIRE, "agent");
            asm volatile("s_waitcnt vmcnt(0)" ::: "memory");
        }
    }
    __syncthreads();
}

constexpr int NWAVES = 8, NTHR = 512;
constexpr int RING_BYTES = 131072, LDSCTL_OFF = RING_BYTES, LDS_BYTES = 147456;
constexpr int CW_BAR = 4096;
constexpr size_t CTL_ZERO_BYTES = 64 * 1024;

struct Params {
    const float *x, *c; const int* positions; const float *ada_w, *ada_b, *norm_g, *ffn_w_in, *ffn_w_out, *mix_w_in, *conv_w, *a_log, *dt_bias, *gdn_ng,
                *pe_k, *w1_k, *w2_k, *pe_v, *w1_v, *w2_v, *nsa_ng, *mix_w_out, *final_g;
    float* out; unsigned char* ws;
};
struct Ctx { LAS unsigned char* lds; int tid, lane, wave, bid, G, gw, NGW; };
__device__ __forceinline__ const __attribute__((address_space(4))) Params* kargs() {
    const __attribute__((address_space(4))) Params* q = (const __attribute__((address_space(4))) Params*)__builtin_amdgcn_kernarg_segment_ptr();
    asm volatile("" : "+s"(q)); return q;
}
#define PA(f) (kargs()->f)
#define WSP(T, off) ((T*)(PA(ws) + (off)))

__device__ __forceinline__ void phase_mod(const Ctx& C, const float* c, const float* ada_w, const float* ada_b, float* mod) {
    LAS float* cond = (LAS float*)C.lds; LAS float* part = (LAS float*)(C.lds + 16384);
    for (int i = C.tid; i < NB * DM; i += NTHR) cond[i] = siluf(c[i]);
    __syncthreads();
    for (int item = C.bid; item < 2 * 9216 / 64; item += C.G) {
        const int col = item * 64 + C.lane, l = col / 9216, j = col % 9216;
        const float* w = ada_w + (size_t)l * DM * 9216 + j; const int k0 = C.wave * 128;
        float a0 = 0.f, a1 = 0.f, a2 = 0.f, a3 = 0.f;
#pragma unroll 8
        for (int k = k0; k < k0 + 128; ++k) { const float wv = w[(size_t)k * 9216]; a0 += cond[k] * wv; a1 += cond[DM + k] * wv; a2 += cond[2 * DM + k] * wv; a3 += cond[3 * DM + k] * wv; }
        part[(C.wave * 4 + 0) * 64 + C.lane] = a0; part[(C.wave * 4 + 1) * 64 + C.lane] = a1; part[(C.wave * 4 + 2) * 64 + C.lane] = a2; part[(C.wave * 4 + 3) * 64 + C.lane] = a3;
        __syncthreads();
        if (C.wave < 4) { float s = ada_b[l * 9216 + j];
#pragma unroll
            for (int w8 = 0; w8 < 8; ++w8) s += part[(w8 * 4 + C.wave) * 64 + C.lane];
            mod[((size_t)l * NB + C.wave) * 9216 + j] = s; }
        __syncthreads();
    }
}
__device__ __forceinline__ void wconv_item(const float* W, int K, int N, f16_t* WT, int k0, int n0, int r0, LAS float* scr, int lane) {
#pragma unroll 8
    for (int i = 0; i < 32; ++i) { const int kk = 2 * i + (lane >> 5); scr[kk * 33 + (lane & 31)] = W[(size_t)(k0 + kk) * N + n0 + (lane & 31)]; }
    __builtin_amdgcn_wave_barrier();
    const int c = lane & 7;
#pragma unroll
    for (int j = 0; j < 4; ++j) { const int n = (lane >> 3) + 8 * j; const LAS float* s = scr + (8 * c) * 33 + n;
        u32x4_t o; o.x = pkh(s[0 * 33], s[1 * 33]); o.y = pkh(s[2 * 33], s[3 * 33]); o.z = pkh(s[4 * 33], s[5 * 33]); o.w = pkh(s[6 * 33], s[7 * 33]);
        *(u32x4_t*)(WT + (size_t)(r0 + n) * K + k0 + 8 * c) = o; }
    __builtin_amdgcn_wave_barrier();
}
__device__ __forceinline__ void phase_wconv(const Ctx& C, f16_t* WT1, f16_t* WT2, f16_t* WTIN, f16_t* WTOUT) {
    LAS float* scr = (LAS float*)(C.lds + 32768) + C.wave * (64 * 33);
    constexpr int I1 = 16 * 176, I2 = 44 * 32, I3 = 16 * 105, I4 = 16 * 32, T1 = 4 * I1, T2 = 4 * I2, T3 = 2 * I3, T4 = 2 * I4;
    for (int it = C.gw; it < T1 + T2 + T3 + T4; it += C.NGW) {
        int r = it;
        if (r < T1) { const int mi = r / I1, q = r % I1, kb = q / 176, nb = q % 176, n0 = 32 * nb, half = n0 / FF, jj = n0 % FF;
            wconv_item(PA(ffn_w_in) + (size_t)mi * DM * 2 * FF, DM, 2 * FF, WT1 + (size_t)mi * 2 * FF * DM, 64 * kb, n0, 256 * (jj / 128) + 128 * half + (jj % 128), scr, C.lane); continue; }
        r -= T1;
        if (r < T2) { const int mi = r / I2, q = r % I2, kb = q / 32, nb = q % 32;
            wconv_item(PA(ffn_w_out) + (size_t)mi * FF * DM, FF, DM, WT2 + (size_t)mi * DM * FF, 64 * kb, 32 * nb, 32 * nb, scr, C.lane); continue; }
        r -= T2;
        if (r < T3) { const int mi = r / I3, q = r % I3, kb = q / 105, nb = q % 105;
            wconv_item(PA(mix_w_in) + (size_t)mi * DM * NIN, DM, NIN, WTIN + (size_t)mi * NINP * DM, 64 * kb, 32 * nb, 32 * nb, scr, C.lane); continue; }
        r -= T3;
        { const int mi = r / I4, q = r % I4, kb = q / 32, nb = q % 32;
            wconv_item(PA(mix_w_out) + (size_t)mi * DM * DM, DM, DM, WTOUT + (size_t)mi * DM * DM, 64 * kb, 32 * nb, 32 * nb, scr, C.lane); }
    }
    constexpr int PADV = (NINP - NIN) * DM * 2 / 16;
    for (int i = C.bid * NTHR + C.tid; i < 2 * PADV; i += C.G * NTHR) { const int l = i / PADV, q = i % PADV;
        ((u32x4_t*)(WTIN + ((size_t)l * NINP + NIN) * DM))[q] = (u32x4_t){0u, 0u, 0u, 0u}; }
}
__device__ __forceinline__ void phase_norm(const Ctx& C, const float* x, const float* g, const float* shift, const float* scale, f16_t* hn) {
    for (int m = C.gw; m < MR; m += C.NGW) {
        const int b = m / NT; const f32x4_t* xr = (const f32x4_t*)(x + (size_t)m * DM) + C.lane;
        f32x4_t v[4]; float s = 0.f;
#pragma unroll
        for (int j = 0; j < 4; ++j) { v[j] = xr[64 * j]; s += v[j].x * v[j].x + v[j].y * v[j].y + v[j].z * v[j].z + v[j].w * v[j].w; }
        const float rstd = rsqrtf(wave_sum(s) * (1.f / DM) + EPS);
        u32x2_t* o = (u32x2_t*)(hn + (size_t)m * DM) + C.lane;
#pragma unroll
        for (int j = 0; j < 4; ++j) {
            const f32x4_t gg = ((const f32x4_t*)g)[C.lane + 64 * j], sh = ((const f32x4_t*)(shift + (size_t)b * 9216))[C.lane + 64 * j], sc = ((const f32x4_t*)(scale + (size_t)b * 9216))[C.lane + 64 * j];
            const f32x4_t h = v[j] * rstd * gg * (sc + 1.f) + sh;
            u32x2_t w; w.x = pkh(h.x, h.y); w.y = pkh(h.z, h.w); o[64 * j] = w;
        }
    }
}
__device__ __forceinline__ void phase_final_norm(const Ctx& C, float* x, const float* g) {
    for (int m = C.gw; m < MR; m += C.NGW) {
        f32x4_t* xr = (f32x4_t*)(x + (size_t)m * DM) + C.lane;
        f32x4_t v[4]; float s = 0.f;
#pragma unroll
        for (int j = 0; j < 4; ++j) { v[j] = xr[64 * j]; s += v[j].x * v[j].x + v[j].y * v[j].y + v[j].z * v[j].z + v[j].w * v[j].w; }
        const float rstd = rsqrtf(wave_sum(s) * (1.f / DM) + EPS);
#pragma unroll
        for (int j = 0; j < 4; ++j) xr[64 * j] = v[j] * rstd * ((const f32x4_t*)g)[C.lane + 64 * j];
    }
}
__device__ __forceinline__ void phase_gdn_prep(const Ctx& C, const f16_t* C16, const float* convw, const float* AB32, const float* a_log, const float* dt_bias,
                                               f16_t* GQ, f16_t* GK, f16_t* GV, float* Gg, float* Gb) {
    const int lane = C.lane;
    for (int wv = C.gw; wv < MR * 12; wv += C.NGW) {
        const int m = wv / 12, hs = wv % 12, b = m / NT, t = m % NT; const int c = hs * 128 + 2 * lane;
        float y0 = 0.f, y1 = 0.f;
#pragma unroll
        for (int i = 0; i < 4; ++i) { const int tt = t - 3 + i; if (tt >= 0) { const unsigned xv = *(const unsigned*)(C16 + (size_t)(m - 3 + i) * 1536 + c);
                y0 += hlo(xv) * convw[i * 1536 + c]; y1 += hhi(xv) * convw[i * 1536 + c + 1]; } }
        y0 = siluf(y0); y1 = siluf(y1);
        const int which = hs >> 2, h = hs & 3;
        if (which < 2) { const float ss = wave_sum(y0 * y0 + y1 * y1); float r = rsqrtf(ss + EPS); if (which == 0) r *= 0.08838834764831845f; y0 *= r; y1 *= r; }
        f16_t* dst = (which == 0 ? GQ : which == 1 ? GK : GV) + ((size_t)(b * GH + h) * NT + t) * GD + 2 * lane;
        *(unsigned*)dst = pkh(y0, y1);
        if (hs == 8 && lane < 4) {
            const float braw = AB32[(size_t)m * 8 + lane], araw = AB32[(size_t)m * 8 + 4 + lane];
            const float xx = araw + dt_bias[lane]; const float sp = (xx > 20.f) ? xx : log1pf(__expf(xx));
            Gg[(size_t)(b * GH + lane) * NT + t] = -__expf(a_log[lane]) * sp;
            Gb[(size_t)(b * GH + lane) * NT + t] = sigmf(braw);
        }
    }
}
__device__ __forceinline__ void phase_rope(const Ctx& C, const int* positions, float* QN32, float* KC32, f16_t* KV16) {
    for (int idx = C.bid * NTHR + C.tid; idx < MR * 14 * 8; idx += C.G * NTHR) {
        const int i = idx & 7, slot = (idx >> 3) % 14, m = idx / (14 * 8);
        const float pos = (float)positions[m];
        const float invf = powf(500000.0f, -(float)i * 0.125f);
        const float ang = pos * invf; const float cs = cosf(ang), sn = sinf(ang);
        if (slot < 10) { float* q = (slot < 8) ? (QN32 + (size_t)m * 512 + slot * 64) : (KC32 + (size_t)m * 128 + (slot - 8) * 64);
            const float x1 = q[i], x2 = q[i + 8]; q[i] = x1 * cs - x2 * sn; q[i + 8] = x2 * cs + x1 * sn; }
        else { f16_t* q = KV16 + (size_t)m * 640 + ((slot < 12) ? (128 + (slot - 10) * 64) : (384 + (slot - 12) * 64));
            const float x1 = h2f(q[i]), x2 = h2f(q[i + 8]); q[i] = f2h(x1 * cs - x2 * sn); q[i + 8] = f2h(x2 * cs + x1 * sn); }
    }
}
__device__ __forceinline__ void phase_compress(const Ctx& C, const float* KC32, const f16_t* KV16, const float* pe_k, const float* w1_k, const float* w2_k,
                                               const float* pe_v, const float* w1_v, const float* w2_v, float* KCMP, float* VCMP) {
    const int sub = C.tid >> 7, st = C.tid & 127;
    LAS float* blk = (LAS float*)C.lds + sub * 2304; LAS float* hid = blk + 2048;
    constexpr int NIT = 2 * NB * NCMP * NG;
    for (int base = C.bid * 4; base < NIT; base += C.G * 4) {
        int id = base + sub; const bool act = id < NIT; if (!act) id = 0;
        const int g = id % NG; id /= NG; const int n = id % NCMP; id /= NCMP; const int b = id % NB; const int which = id / NB;
        const float* pe = which ? pe_v : pe_k; const float* w1 = which ? w1_v : w1_k; const float* w2 = which ? w2_v : w2_k;
        for (int k = st; k < 2048; k += 128) { const int l = k >> 6, d = k & 63; const size_t m = (size_t)b * NT + 16 * n + l;
            const float v = which ? h2f(KV16[m * 640 + g * 64 + d]) : KC32[m * 128 + g * 64 + d]; blk[k] = v + pe[k]; }
        __syncthreads();
        float a = 0.f;
#pragma unroll 8
        for (int k = 0; k < 2048; ++k) a += blk[k] * w1[(size_t)k * 128 + st];
        hid[st] = siluf(a);
        __syncthreads();
        if (st < 64 && act) { float o = 0.f;
#pragma unroll 8
            for (int j = 0; j < 128; ++j) o += hid[j] * w2[j * 64 + st];
            (which ? VCMP : KCMP)[((size_t)(b * NG + g) * 256 + n) * 64 + st] = o; }
        __syncthreads();
    }
}
__device__ __forceinline__ void phase_cmpattn(const Ctx& C, const float* QN32, const float* KCMP, const float* VCMP, const float* GR32, float* OACC, unsigned long long* SEL) {
    const int lane = C.lane;
    LAS float* qs = (LAS float*)C.lds + C.wave * 1408; LAS float* P = qs + 256; LAS float* imps = P + 1024;
    for (int id = C.gw; id < NB * NG * NT; id += C.NGW) {
        const int t = id % NT, g = (id / NT) % NG, b = id / (NT * NG); const size_t m = (size_t)b * NT + t;
#pragma unroll
        for (int r = 0; r < 4; ++r) qs[r * 64 + lane] = QN32[m * 512 + (g * 4 + r) * 64 + lane] * 0.125f;
        __builtin_amdgcn_wave_barrier();
        const int nvalid = (t >= 31) ? min((t - 31) / 16 + 1, NCMP) : 0;
        const float* kc = KCMP + (size_t)(b * NG + g) * 256 * 64; const float* vc = VCMP + (size_t)(b * NG + g) * 256 * 64;
        float s[4][4];
#pragma unroll
        for (int i = 0; i < 4; ++i) { const int n = lane + 64 * i;
            if (n < nvalid) { float a0 = 0.f, a1 = 0.f, a2 = 0.f, a3 = 0.f; const float* kp = kc + (size_t)n * 64;
                for (int d = 0; d < 64; ++d) { const float kv = kp[d]; a0 += qs[d] * kv; a1 += qs[64 + d] * kv; a2 += qs[128 + d] * kv; a3 += qs[192 + d] * kv; }
                s[0][i] = a0; s[1][i] = a1; s[2][i] = a2; s[3][i] = a3; }
            else { s[0][i] = s[1][i] = s[2][i] = s[3][i] = -INFINITY; } }
#pragma unroll
        for (int r = 0; r < 4; ++r) {
            float mx = fmaxf(fmaxf(s[r][0], s[r][1]), fmaxf(s[r][2], s[r][3])); mx = wave_max(mx);
            float e[4], sum = 0.f;
#pragma unroll
            for (int i = 0; i < 4; ++i) { e[i] = (lane + 64 * i < nvalid) ? __expf(s[r][i] - mx) : 0.f; sum += e[i]; }
            sum = wave_sum(sum); const float inv = 1.f / fmaxf(sum, 1e-30f);
#pragma unroll
            for (int i = 0; i < 4; ++i) P[r * 256 + lane + 64 * i] = e[i] * inv;
        }
        __builtin_amdgcn_wave_barrier();
        float o0 = 0.f, o1 = 0.f, o2 = 0.f, o3 = 0.f;
        for (int n = 0; n < nvalid; ++n) { const float v = vc[(size_t)n * 64 + lane]; o0 += P[n] * v; o1 += P[256 + n] * v; o2 += P[512 + n] * v; o3 += P[768 + n] * v; }
        { const float* gr = GR32 + m * 24 + (g * 4) * 3; float* oa = OACC + m * 512 + (g * 4) * 64 + lane;
          oa[0] = sigmf(gr[0]) * o0; oa[64] = sigmf(gr[3]) * o1; oa[128] = sigmf(gr[6]) * o2; oa[192] = sigmf(gr[9]) * o3; }
        float imp = 0.f; { const int n0 = max(4 * lane - 1, 0), n1 = min(4 * lane + 3, NCMP - 1);
            for (int n = n0; n <= n1; ++n) imp += P[n] + P[256 + n] + P[512 + n] + P[768 + n]; }
        const int cur = t >> 6; const bool valid = lane <= cur; const bool forced = (lane == 0) || (lane == cur) || (lane == cur - 1);
        const float val = forced ? INFINITY : (valid ? imp : -INFINITY);
        imps[lane] = val;
        __builtin_amdgcn_wave_barrier();
        int rank = 0;
        for (int j = 0; j < 64; ++j) { const float o = imps[j]; rank += (o > val || (o == val && j < lane)) ? 1 : 0; }
        const unsigned long long mask = __ballot((rank < NSEL) && valid);
        if (lane == 0) SEL[(size_t)(b * NG + g) * NT + t] = mask;
        __builtin_amdgcn_wave_barrier();
    }
}
__device__ __forceinline__ void attn_block(const f16_t* Kb, const f16_t* Vb, int pos0, int lo, int t, int lane, const LAS float* qs, LAS float* pl, float (&mx)[4], float (&ls)[4], float (&o)[4]) {
    const int pos = pos0 + lane; const bool ok = (pos <= t) && (pos >= lo);
    float s[4] = {-INFINITY, -INFINITY, -INFINITY, -INFINITY};
    if (ok) { const u32x4_t* kp = (const u32x4_t*)(Kb + (size_t)pos * 640); float a0 = 0.f, a1 = 0.f, a2 = 0.f, a3 = 0.f;
#pragma unroll
        for (int c8 = 0; c8 < 8; ++c8) { const u32x4_t kv = kp[c8]; const unsigned ku[4] = {kv.x, kv.y, kv.z, kv.w};
#pragma unroll
            for (int e = 0; e < 4; ++e) { const float k0 = hlo(ku[e]), k1 = hhi(ku[e]); const int d = c8 * 8 + e * 2;
                a0 += qs[d] * k0 + qs[d + 1] * k1; a1 += qs[64 + d] * k0 + qs[64 + d + 1] * k1; a2 += qs[128 + d] * k0 + qs[128 + d + 1] * k1; a3 += qs[192 + d] * k0 + qs[192 + d + 1] * k1; } }
        s[0] = a0; s[1] = a1; s[2] = a2; s[3] = a3; }
    float al[4];
#pragma unroll
    for (int r = 0; r < 4; ++r) { const float bm = wave_max(s[r]); const float mn = fmaxf(mx[r], bm);
        al[r] = (mn == -INFINITY) ? 1.f : __expf(mx[r] - mn); const float pp = ok ? __expf(s[r] - mn) : 0.f; mx[r] = mn;
        ls[r] = ls[r] * al[r] + wave_sum(pp); pl[r * 64 + lane] = pp; o[r] *= al[r]; }
    __builtin_amdgcn_wave_barrier();
    const int kmax = min(64, t - pos0 + 1);
    for (int k = 0; k < kmax; ++k) { const float v = h2f(Vb[(size_t)(pos0 + k) * 640 + lane]);
        o[0] += pl[k] * v; o[1] += pl[64 + k] * v; o[2] += pl[128 + k] * v; o[3] += pl[192 + k] * v; }
    __builtin_amdgcn_wave_barrier();
}
__device__ __forceinline__ void phase_selwin(const Ctx& C, const float* QN32, const f16_t* KV16, const float* GR32, const float* OACC, const unsigned long long* SEL, const float* ng, f16_t* Y) {
    const int lane = C.lane;
    LAS float* qs = (LAS float*)C.lds + C.wave * 512; LAS float* pl = qs + 256;
    for (int id = C.gw; id < NB * NG * NT; id += C.NGW) {
        const int t = id % NT, g = (id / NT) % NG, b = id / (NT * NG); const size_t m = (size_t)b * NT + t;
#pragma unroll
        for (int r = 0; r < 4; ++r) qs[r * 64 + lane] = QN32[m * 512 + (g * 4 + r) * 64 + lane] * 0.125f;
        __builtin_amdgcn_wave_barrier();
        const f16_t* base = KV16 + (size_t)b * NT * 640 + g * 64;
        const f16_t *Ks = base + 128, *Vs = base + 256, *Kw = base + 384, *Vw = base + 512;
        const unsigned long long mask = SEL[(size_t)(b * NG + g) * NT + t];
        float mx[4], ls[4], o[4], osel[4];
#pragma unroll
        for (int r = 0; r < 4; ++r) { mx[r] = -INFINITY; ls[r] = 0.f; o[r] = 0.f; }
        const int cur = t >> 6;
        for (int j = 0; j <= cur; ++j) if ((mask >> j) & 1ull) attn_block(Ks, Vs, 64 * j, 0, t, lane, qs, pl, mx, ls, o);
#pragma unroll
        for (int r = 0; r < 4; ++r) { osel[r] = o[r] / fmaxf(ls[r], 1e-30f); mx[r] = -INFINITY; ls[r] = 0.f; o[r] = 0.f; }
        const int lo = max(t - WIN + 1, 0);
        for (int j = lo >> 6; j <= cur; ++j) attn_block(Kw, Vw, 64 * j, lo, t, lane, qs, pl, mx, ls, o);
#pragma unroll
        for (int r = 0; r < 4; ++r) { const int hq = g * 4 + r; const float* gr = GR32 + m * 24 + hq * 3;
            float v = OACC[m * 512 + hq * 64 + lane] + sigmf(gr[1]) * osel[r] + sigmf(gr[2]) * (o[r] / fmaxf(ls[r], 1e-30f));
            const float ss = wave_sum(v * v); v = v * rsqrtf(ss * (1.f / 64.f) + EPS) * ng[lane];
            Y[m * DM + 512 + hq * 64 + lane] = f2h(v); }
        __builtin_amdgcn_wave_barrier();
    }
}
__device__ __forceinline__ void phase_scan_simple(const Ctx& C, const f16_t* GQ, const f16_t* GK, const f16_t* GV, const float* Gg, const float* Gb, float* OG) {
    if (C.wave != 0) return;
    LAS float* qs = (LAS float*)C.lds; LAS float* ks = qs + 32 * 128; LAS float* ab = ks + 32 * 128;
    const int lane = C.lane;
    for (int job = C.bid; job < NB * GH * 2; job += C.G) {
        const int bh = job >> 1, dv = (job & 1) * 64 + lane, b = bh / GH, h = bh % GH;
        float S[128];
#pragma unroll
        for (int i = 0; i < 128; ++i) S[i] = 0.f;
        const f16_t* q = GQ + (size_t)bh * NT * GD; const f16_t* k = GK + (size_t)bh * NT * GD; const f16_t* v = GV + (size_t)bh * NT * GD;
        for (int t0 = 0; t0 < NT; t0 += 32) {
            __builtin_amdgcn_wave_barrier();
            for (int i = lane; i < 32 * 64; i += 64) { const int tt = i >> 6, c = (i & 63) * 2; const unsigned qv = *(const unsigned*)(q + (size_t)(t0 + tt) * GD + c), kv = *(const unsigned*)(k + (size_t)(t0 + tt) * GD + c);
                qs[tt * 128 + c] = hlo(qv); qs[tt * 128 + c + 1] = hhi(qv); ks[tt * 128 + c] = hlo(kv); ks[tt * 128 + c + 1] = hhi(kv); }
            if (lane < 32) { ab[lane] = __expf(Gg[(size_t)bh * NT + t0 + lane]); ab[32 + lane] = Gb[(size_t)bh * NT + t0 + lane]; }
            __builtin_amdgcn_wave_barrier();
            for (int tt = 0; tt < 32; ++tt) {
                const float a = ab[tt], beta = ab[32 + tt]; const float vv = h2f(v[(size_t)(t0 + tt) * GD + dv]);
                float kS = 0.f;
#pragma unroll
                for (int i = 0; i < 128; ++i) kS += ks[tt * 128 + i] * S[i];
                const float vn = beta * (vv - a * kS);
                float oo = 0.f;
#pragma unroll
                for (int i = 0; i < 128; ++i) { S[i] = a * S[i] + ks[tt * 128 + i] * vn; oo += qs[tt * 128 + i] * S[i]; }
                OG[((size_t)b * NT + t0 + tt) * GW + h * GD + dv] = oo;
            }
        }
    }
}
__device__ __forceinline__ void phase_gdn_out(const Ctx& C, const float* OG, const f16_t* Z16, const float* ng, f16_t* Y) {
    const int lane = C.lane;
    for (int wv = C.gw; wv < MR * GH; wv += C.NGW) {
        const int m = wv >> 2, h = wv & 3;
        const f32x2_t o = *(const f32x2_t*)(OG + (size_t)m * GW + h * GD + 2 * lane);
        const float r = rsqrtf(wave_sum(o.x * o.x + o.y * o.y) * (1.f / GD) + EPS);
        const unsigned z = *(const unsigned*)(Z16 + (size_t)m * GW + h * GD + 2 * lane);
        *(unsigned*)(Y + (size_t)m * DM + h * GD + 2 * lane) = pkh(o.x * r * ng[2 * lane] * siluf(hlo(z)), o.y * r * ng[2 * lane + 1] * siluf(hhi(z)));
    }
}

template <class Epi> __device__ __forceinline__ void run_gemm(LAS unsigned char* lds, const f16_t* A, const f16_t* Bt, int N, int K, const Epi& E) {
    pg8::Gemm g{A, Bt, MR, N, K, 0}; pg8::StaticOrder S; S.init(MR, N, (int)gridDim.x, (int)blockIdx.x);
    pg8::gemm_phase<Epi, pg8::StaticOrder, true, true>(lds, g, S, E);
}
__device__ __forceinline__ Ctx make_ctx(LAS unsigned char* lds) {
    Ctx C; C.lds = lds; int t = threadIdx.x; asm volatile("" : "+v"(t));
    C.tid = t; C.lane = t & 63; C.wave = __builtin_amdgcn_readfirstlane(t >> 6);
    C.bid = blockIdx.x; C.G = gridDim.x; C.gw = C.bid * NWAVES + C.wave; C.NGW = C.G * NWAVES; return C;
}
__global__ void __launch_bounds__(NTHR, 2) mega_fwd(Params p_unused) {
    extern __shared__ __attribute__((aligned(16))) unsigned char lds_raw[];
    LAS unsigned char* lds = (LAS unsigned char*)lds_raw;
    for (int u = threadIdx.x; u < (LDS_BYTES - LDSCTL_OFF) / 4; u += NTHR) ((LAS unsigned*)(lds + LDSCTL_OFF))[u] = 0u;
    __syncthreads();
    XcdBarrier bar = xcd_barrier_post(WSP(unsigned, WS_CTL) + CW_BAR, (volatile LAS unsigned*)(lds + LDSCTL_OFF + 64));
#define GRID_BAR() do { bar.bar = WSP(unsigned, WS_CTL) + CW_BAR; xcd_barrier(bar); } while (0)
#define MODL(l) (WSP(float, WS_MOD) + (size_t)(l) * NB * 9216)
    { Ctx C = make_ctx(lds); phase_mod(C, PA(c), PA(ada_w), PA(ada_b), WSP(float, WS_MOD)); }
    { Ctx C = make_ctx(lds); phase_wconv(C, WSP(f16_t, WS_WT1), WSP(f16_t, WS_WT2), WSP(f16_t, WS_WTIN), WSP(f16_t, WS_WTOUT)); }
    GRID_BAR();
#pragma unroll 1
    for (int l = 0; l < DEPTH; ++l) {
        { Ctx C = make_ctx(lds); phase_norm(C, l == 0 ? PA(x) : (const float*)PA(out), PA(norm_g) + (size_t)(l * 3 + 0) * DM, MODL(l) + 0 * DM, MODL(l) + 1 * DM, WSP(f16_t, WS_HN)); }
        GRID_BAR();
        run_gemm(lds, WSP(f16_t, WS_HN), WSP(f16_t, WS_WT1) + (size_t)(l * 2 + 0) * 2 * FF * DM, 2 * FF, DM, pg8::EpiSwiglu{WSP(f16_t, WS_ACT)});
        GRID_BAR();
        run_gemm(lds, WSP(f16_t, WS_ACT), WSP(f16_t, WS_WT2) + (size_t)(l * 2 + 0) * DM * FF, DM, FF, pg8::EpiResidual{l == 0 ? PA(x) : (const float*)PA(out), PA(out), MODL(l) + 2 * DM, 9216, 0.5f});
        GRID_BAR();
        { Ctx C = make_ctx(lds); phase_norm(C, PA(out), PA(norm_g) + (size_t)(l * 3 + 1) * DM, MODL(l) + 3 * DM, MODL(l) + 4 * DM, WSP(f16_t, WS_HN)); }
        GRID_BAR();
        run_gemm(lds, WSP(f16_t, WS_HN), WSP(f16_t, WS_WTIN) + (size_t)l * NINP * DM, NINP, DM,
                 pg8::EpiInProj{WSP(f16_t, WS_C16), WSP(f16_t, WS_Z16), WSP(float, WS_AB32), WSP(float, WS_QN32), WSP(float, WS_KC32), WSP(f16_t, WS_KV16), WSP(float, WS_GR32)});
        GRID_BAR();
        { Ctx C = make_ctx(lds); phase_gdn_prep(C, WSP(f16_t, WS_C16), PA(conv_w) + (size_t)l * 4 * 1536, WSP(float, WS_AB32), PA(a_log) + l * 4, PA(dt_bias) + l * 4,
                                                WSP(f16_t, WS_GQ), WSP(f16_t, WS_GK), WSP(f16_t, WS_GV), WSP(float, WS_GG), WSP(float, WS_GB)); }
        { Ctx C = make_ctx(lds); phase_rope(C, PA(positions), WSP(float, WS_QN32), WSP(float, WS_KC32), WSP(f16_t, WS_KV16)); }
        GRID_BAR();
        { Ctx C = make_ctx(lds); phase_compress(C, WSP(float, WS_KC32), WSP(f16_t, WS_KV16), PA(pe_k) + (size_t)l * 2048, PA(w1_k) + (size_t)l * 2048 * 128, PA(w2_k) + (size_t)l * 128 * 64,
                                                PA(pe_v) + (size_t)l * 2048, PA(w1_v) + (size_t)l * 2048 * 128, PA(w2_v) + (size_t)l * 128 * 64, WSP(float, WS_KCMP), WSP(float, WS_VCMP)); }
        { Ctx C = make_ctx(lds); phase_scan_simple(C, WSP(f16_t, WS_GQ), WSP(f16_t, WS_GK), WSP(f16_t, WS_GV), WSP(float, WS_GG), WSP(float, WS_GB), WSP(float, WS_OG32)); }
        GRID_BAR();
        { Ctx C = make_ctx(lds); phase_gdn_out(C, WSP(float, WS_OG32), WSP(f16_t, WS_Z16), PA(gdn_ng) + l * GD, WSP(f16_t, WS_HN)); }
        { Ctx C = make_ctx(lds); phase_cmpattn(C, WSP(float, WS_QN32), WSP(float, WS_KCMP), WSP(float, WS_VCMP), WSP(float, WS_GR32), WSP(float, WS_OACC), WSP(unsigned long long, WS_SEL)); }
        GRID_BAR();
        { Ctx C = make_ctx(lds); phase_selwin(C, WSP(float, WS_QN32), WSP(f16_t, WS_KV16), WSP(float, WS_GR32), WSP(float, WS_OACC), WSP(unsigned long long, WS_SEL), PA(nsa_ng) + l * HD, WSP(f16_t, WS_HN)); }
        GRID_BAR();
        run_gemm(lds, WSP(f16_t, WS_HN), WSP(f16_t, WS_WTOUT) + (size_t)l * DM * DM, DM, DM, pg8::EpiResidual{PA(out), PA(out), MODL(l) + 5 * DM, 9216, 1.0f});
        GRID_BAR();
        { Ctx C = make_ctx(lds); phase_norm(C, PA(out), PA(norm_g) + (size_t)(l * 3 + 2) * DM, MODL(l) + 6 * DM, MODL(l) + 7 * DM, WSP(f16_t, WS_HN)); }
        GRID_BAR();
        run_gemm(lds, WSP(f16_t, WS_HN), WSP(f16_t, WS_WT1) + (size_t)(l * 2 + 1) * 2 * FF * DM, 2 * FF, DM, pg8::EpiSwiglu{WSP(f16_t, WS_ACT)});
        GRID_BAR();
        run_gemm(lds, WSP(f16_t, WS_ACT), WSP(f16_t, WS_WT2) + (size_t)(l * 2 + 1) * DM * FF, DM, FF, pg8::EpiResidual{PA(out), PA(out), MODL(l) + 8 * DM, 9216, 0.5f});
        GRID_BAR();
    }
    { Ctx C = make_ctx(lds); phase_final_norm(C, PA(out), PA(final_g)); }
}

extern "C" void kernel_launch(void* const* d_in, const int* in_sizes, int n_in, void* d_out, int out_size, void* d_ws, size_t ws_size, hipStream_t stream) {
    static int grid = 0;
    if (grid == 0) {
        if (n_in != 22 || out_size != MR * DM || ws_size < WS_END) { fprintf(stderr, "kernel_launch: unexpected shapes (n_in %d out %d ws %zu)\n", n_in, out_size, ws_size); grid = -1; return; }
        int dev = 0, cus = 0, per_cu = 0;
        if (hipGetDevice(&dev) != hipSuccess || hipDeviceGetAttribute(&cus, hipDeviceAttributeMultiprocessorCount, dev) != hipSuccess) { grid = -1; return; }
        if (hipFuncSetAttribute((const void*)mega_fwd, hipFuncAttributeMaxDynamicSharedMemorySize, LDS_BYTES) != hipSuccess) { fprintf(stderr, "kernel_launch: hipFuncSetAttribute failed\n"); grid = -1; return; }
        if (hipOccupancyMaxActiveBlocksPerMultiprocessor(&per_cu, (const void*)mega_fwd, NTHR, LDS_BYTES) != hipSuccess || per_cu < 1) { fprintf(stderr, "kernel_launch: occupancy query says %d\n", per_cu); (void)hipGetLastError(); grid = -1; return; }
        grid = cus;
    }
    if (grid < 0) return;
    (void)hipMemsetAsync((char*)d_ws + WS_CTL, 0, CTL_ZERO_BYTES, stream);
    Params p{};
    p.x = (const float*)d_in[0]; p.c = (const float*)d_in[1]; p.positions = (const int*)d_in[2]; p.ada_w = (const float*)d_in[3]; p.ada_b = (const float*)d_in[4];
    p.norm_g = (const float*)d_in[5]; p.ffn_w_in = (const float*)d_in[6]; p.ffn_w_out = (const float*)d_in[7]; p.mix_w_in = (const float*)d_in[8]; p.conv_w = (const float*)d_in[9];
    p.a_log = (const float*)d_in[10]; p.dt_bias = (const float*)d_in[11]; p.gdn_ng = (const float*)d_in[12]; p.pe_k = (const float*)d_in[13]; p.w1_k = (const float*)d_in[14];
    p.w2_k = (const float*)d_in[15]; p.pe_v = (const float*)d_in[16]; p.w1_v = (const float*)d_in[17]; p.w2_v = (const float*)d_in[18]; p.nsa_ng = (const float*)d_in[19];
    p.mix_w_out = (const float*)d_in[20]; p.final_g = (const float*)d_in[21]; p.out = (float*)d_out; p.ws = (unsigned char*)d_ws;
    hipLaunchKernelGGL(mega_fwd, dim3(grid), dim3(NTHR), LDS_BYTES, stream, p);
}
```

```cpp
#include <hip/hip_runtime.h>
#include <cstdio>
#include <cstdint>

constexpr int NB = 4, NT = 4096, DM = 1024, MR = NB * NT, FF = 2816, NIN = 3360, NINP = 3584, DEPTH = 2;
constexpr int GH = 4, GD = 128, GW = 512;
constexpr int NH = 8, NG = 2, HD = 64;
constexpr int NCMP = 255, NBLK = 64, NSEL = 16, WIN = 512;
constexpr float EPS = 1e-6f;
constexpr size_t MiB = 1u << 20;
constexpr size_t WS_CTL = 0, WS_MOD = 1 * MiB, WS_WT1 = 4 * MiB, WS_WT2 = 48 * MiB, WS_WTIN = 70 * MiB, WS_WTOUT = 84 * MiB, WS_W1C = 88 * MiB,
                 WS_HN = 90 * MiB, WS_ACT = 122 * MiB, WS_C16 = 122 * MiB, WS_UIMG = 122 * MiB, WS_ATT = 138 * MiB, WS_DL = 146 * MiB, WS_Z16 = 170 * MiB, WS_KV16 = 186 * MiB,
                 WS_QN32 = 210 * MiB, WS_KC32 = 242 * MiB, WS_AB32 = 250 * MiB, WS_GR32 = 251 * MiB, WS_GQ = 253 * MiB, WS_GK = 269 * MiB, WS_GV = 285 * MiB,
                 WS_GG = 301 * MiB, WS_GB = 301 * MiB + 512 * 1024, WS_KCMP = 302 * MiB, WS_VCMP = 302 * MiB + 512 * 1024, WS_SEL = 303 * MiB, WS_OACC = 304 * MiB, WS_END = 336 * MiB;

typedef unsigned short f16_t;
typedef _Float16 h2_t __attribute__((ext_vector_type(2)));
typedef float f32x2_t __attribute__((ext_vector_type(2)));
typedef float f32x4_t __attribute__((ext_vector_type(4)));
typedef unsigned u32x4_t __attribute__((ext_vector_type(4)));
typedef unsigned u32x2_t __attribute__((ext_vector_type(2)));
__device__ __forceinline__ unsigned pkh(float lo, float hi) { f32x2_t v = {lo, hi}; h2_t h = __builtin_convertvector(v, h2_t); return __builtin_bit_cast(unsigned, h); }
__device__ __forceinline__ float h2f(f16_t u) { return (float)__builtin_bit_cast(_Float16, u); }
__device__ __forceinline__ f16_t f2h(float f) { return __builtin_bit_cast(f16_t, (_Float16)f); }
__device__ __forceinline__ float hlo(unsigned u) { return h2f((f16_t)(u & 0xffffu)); }
__device__ __forceinline__ float hhi(unsigned u) { return h2f((f16_t)(u >> 16)); }
__device__ __forceinline__ float siluf(float x) { return x / (1.f + __expf(-x)); }
__device__ __forceinline__ float sigmf(float x) { return 1.f / (1.f + __expf(-x)); }
__device__ __forceinline__ float wave_sum(float v) {
#pragma unroll
    for (int o = 1; o < 64; o <<= 1) v += __shfl_xor(v, o);
    return v;
}
__device__ __forceinline__ float wave_max(float v) {
#pragma unroll
    for (int o = 1; o < 64; o <<= 1) v = fmaxf(v, __shfl_xor(v, o));
    return v;
}

namespace pg8 {
#define PG8_LAS __attribute__((address_space(3)))
typedef unsigned short bf16_t;
typedef _Float16 bf16x8 __attribute__((ext_vector_type(8)));
typedef float f32x4 __attribute__((ext_vector_type(4)));
typedef unsigned u32x4 __attribute__((ext_vector_type(4)));
constexpr int BM = 256, BK = 64, HALF = 128, HTB = HALF * BK * 2  , STAGE_BYTES = 8 * HTB, NXCD = 8, WGM = 8;

__host__ __device__ __forceinline__ int lds_byte(int r, int c) { const int st = (r >> 4) * 2 + (c >> 5), rr = r & 15, cc = c & 31, ob = rr * 64 + cc * 2; return st * 1024 + (ob ^ (((ob >> 9) & 1) << 5)); }
__host__ __device__ __forceinline__ void stage_rc(int b, int& R, int& C) { const int st = b / 1024, sb = b % 1024, swz = sb ^ (((sb >> 9) & 1) << 5); R = (st >> 1) * 16 + swz / 64; C = (st & 1) * 32 + (swz % 64) / 2; }
__host__ __device__ __forceinline__ int perm32(int rho) { const int n = rho >> 4, i = rho & 15; return 8 * (i >> 2) + 4 * n + (i & 3); }

struct Unit { int pm, pn; };
struct Gemm { const bf16_t* A; const bf16_t* Bt; int M, N, K, pad; };

struct StaticOrder {
    int nM, nN, nwg, G, c;
    __host__ __device__ void init(int M, int N, int G_, int c_) { nM = M / BM; nN = N / BM; nwg = nM * nN; G = G_; c = c_; }
    __host__ __device__ bool next(int i, Unit& u) const {
        const long L = (long)i * G + c; if (L >= nwg) return false;
        int wgid = (int)L; { const int q = nwg / NXCD, r = nwg % NXCD, xcd = wgid % NXCD, off = wgid / NXCD; wgid = (xcd < r ? xcd * (q + 1) : r * (q + 1) + (xcd - r) * q) + off; }
        const int nig = WGM * nN, gid = wgid / nig, fm = gid * WGM, gsz = (nM - fm) < WGM ? (nM - fm) : WGM;
        u.pm = fm + ((wgid % nig) % gsz); u.pn = (wgid % nig) / gsz; return true;
    }
    __device__ __forceinline__ void a_ready(const Unit&) const {}
    __device__ __forceinline__ void done(const Unit&) const {}
};


template <class Epi, class Sched, bool ALIGN_EPI = false, bool SP2 = false>
__device__ __forceinline__ void gemm_phase(PG8_LAS unsigned char* lds, const Gemm g, const Sched& S, const Epi& E) {
    int tid_ = threadIdx.x; asm volatile("" : "+v"(tid_));
    const int tid = tid_, wid = __builtin_amdgcn_readfirstlane(tid >> 6), lane = tid & 63, wr = wid >> 2, wc = wid & 3, fr = lane & 15, fq = lane >> 4;
    const int K = g.K, nt = K / BK;
    unsigned voffA[2], voffB[2];
#pragma unroll
    for (int i = 0; i < 2; ++i) { int R, C; stage_rc(tid * 16 + i * 8192, R, C); const int Rb = Epi::PERM ? ((R & ~31) + perm32(R & 31)) : R;
        voffA[i] = (unsigned)(R * K + C) * 2u; voffB[i] = (unsigned)(Rb * K + C) * 2u; }
    const size_t kstep = (size_t)(BK * 2);
    const size_t hstep = (size_t)HALF * K * 2;
    const size_t tstep = 2 * hstep;
    const unsigned ldsw = (unsigned)wid * 1024u;
    const int aoff = lds_byte(wr * 64 + fr, fq * 8), boff = lds_byte(wc * 32 + fr, fq * 8);
#define PG8_SA(b, h) (((b) * 2 + (h)) * HTB)
#define PG8_SB(b, h) ((4 + (b) * 2 + (h)) * HTB)
#define PG8_STAGE(bufoff, gbase, voff) do { _Pragma("unroll") for (int _i = 0; _i < 2; ++_i) \
        __builtin_amdgcn_global_load_lds((const unsigned*)((const char*)(gbase) + (voff)[_i]), (PG8_LAS unsigned*)(lds + (bufoff) + ldsw + _i * 8192), 16, 0, 0); } while (0)
#define PG8_LDA(dst, b, h) do { _Pragma("unroll") for (int m = 0; m < 4; ++m) _Pragma("unroll") for (int k = 0; k < 2; ++k) dst[m][k] = *(const PG8_LAS bf16x8*)(lds + PG8_SA(b, h) + aoff + m * 2048 + k * 1024); } while (0)
#define PG8_LDB(dst, b, h) do { _Pragma("unroll") for (int n = 0; n < 2; ++n) _Pragma("unroll") for (int k = 0; k < 2; ++k) dst[n][k] = *(const PG8_LAS bf16x8*)(lds + PG8_SB(b, h) + boff + n * 2048 + k * 1024); } while (0)
#define PG8_MMA(ai, bj, At, Bt) do { __builtin_amdgcn_s_setprio(1); _Pragma("unroll") for (int m = 0; m < 4; ++m) _Pragma("unroll") for (int n = 0; n < 2; ++n) _Pragma("unroll") for (int k = 0; k < 2; ++k) \
        acc[ai][bj][m][n] = __builtin_amdgcn_mfma_f32_16x16x32_f16(Bt[n][k], At[m][k], acc[ai][bj][m][n], 0, 0, 0); __builtin_amdgcn_s_setprio(0); } while (0)
#define PG8_WAIT_V(n) asm volatile("s_waitcnt vmcnt(" #n ")" ::: "memory")
#define PG8_WAIT_L(n) asm volatile("s_waitcnt lgkmcnt(" #n ")" ::: "memory")
#define PG8_BAR __builtin_amdgcn_s_barrier()
#define PG8_SCHED __builtin_amdgcn_sched_barrier(0)
    Unit cur, nxt; int ui = 0;
    if (!S.next(0, cur)) return;
    f32x4 acc[2][2][4][2];
#pragma unroll
    for (int a = 0; a < 2; ++a)
#pragma unroll
        for (int b = 0; b < 2; ++b)
#pragma unroll
            for (int m = 0; m < 4; ++m)
#pragma unroll
                for (int n = 0; n < 2; ++n) acc[a][b][m][n] = (f32x4){0.f, 0.f, 0.f, 0.f};
    bf16x8 At[4][2], B0[2][2], B1[2][2];
    const char* cA = (const char*)g.A + (size_t)cur.pm * tstep; const char* cB = (const char*)g.Bt + (size_t)cur.pn * tstep;
    S.a_ready(cur);
    if constexpr (SP2) {
        PG8_STAGE(PG8_SB(0, 0), cB, voffB); PG8_STAGE(PG8_SB(0, 1), cB + hstep, voffB); PG8_STAGE(PG8_SA(0, 0), cA, voffA); PG8_STAGE(PG8_SA(0, 1), cA + hstep, voffA);
        if (wr == 1) PG8_BAR;
        PG8_WAIT_V(2); PG8_BAR;
        PG8_STAGE(PG8_SB(1, 0), cB + kstep, voffB); PG8_STAGE(PG8_SA(1, 0), cA + kstep, voffA); PG8_STAGE(PG8_SB(1, 1), cB + hstep + kstep, voffB);
        PG8_WAIT_V(6); PG8_BAR;
    } else {
        PG8_STAGE(PG8_SB(0, 0), cB, voffB); PG8_STAGE(PG8_SA(0, 0), cA, voffA); PG8_STAGE(PG8_SB(0, 1), cB + hstep, voffB); PG8_STAGE(PG8_SA(0, 1), cA + hstep, voffA);
        if (wr == 1) PG8_BAR;
        PG8_WAIT_V(4); PG8_BAR;
        PG8_STAGE(PG8_SB(1, 0), cB + kstep, voffB); PG8_STAGE(PG8_SA(1, 0), cA + kstep, voffA); PG8_STAGE(PG8_SB(1, 1), cB + hstep + kstep, voffB);
        PG8_WAIT_V(6); PG8_BAR;
    }
    for (;;) {
        const bool has_next = S.next(ui + 1, nxt);
        const char* nA = has_next ? (const char*)g.A + (size_t)nxt.pm * tstep : cA; const char* nB = has_next ? (const char*)g.Bt + (size_t)nxt.pn * tstep : cB;
        for (int t = 0; t < nt; t += 2) {
            const bool last = (t == nt - 2);
            const char* a1 = cA + (size_t)(t + 1) * kstep;
            const char* a2 = last ? nA : cA + (size_t)(t + 2) * kstep; const char* b2 = last ? nB : cB + (size_t)(t + 2) * kstep;
            const char* a3 = a2 + kstep; const char* b3 = b2 + kstep;
            if (last && has_next) S.a_ready(nxt);
            if constexpr (SP2) {
            PG8_LDB(B0, 0, 0); PG8_LDB(B1, 0, 1); PG8_SCHED; PG8_LDA(At, 0, 0); PG8_STAGE(PG8_SA(1, 1), a1 + hstep, voffA);
            PG8_WAIT_V(8); PG8_WAIT_L(0); PG8_BAR; PG8_MMA(0, 0, At, B0); PG8_MMA(0, 1, At, B1); PG8_BAR; PG8_SCHED;
            PG8_LDA(At, 0, 1); PG8_STAGE(PG8_SB(0, 0), b2, voffB); PG8_STAGE(PG8_SB(0, 1), b2 + hstep, voffB); PG8_STAGE(PG8_SA(0, 0), a2, voffA);
            PG8_WAIT_V(8); PG8_WAIT_L(0); PG8_BAR; PG8_MMA(1, 0, At, B0); PG8_MMA(1, 1, At, B1); PG8_BAR; PG8_SCHED;
            PG8_LDB(B0, 1, 0); PG8_LDB(B1, 1, 1); PG8_SCHED; PG8_LDA(At, 1, 0); PG8_STAGE(PG8_SA(0, 1), a2 + hstep, voffA);
            PG8_WAIT_V(8); PG8_WAIT_L(0); PG8_BAR; PG8_MMA(0, 0, At, B0); PG8_MMA(0, 1, At, B1); PG8_BAR; PG8_SCHED;
            PG8_LDA(At, 1, 1); PG8_STAGE(PG8_SB(1, 0), b3, voffB); PG8_STAGE(PG8_SB(1, 1), b3 + hstep, voffB); PG8_STAGE(PG8_SA(1, 0), a3, voffA);
            PG8_WAIT_V(8); PG8_WAIT_L(0); PG8_BAR; PG8_MMA(1, 0, At, B0); PG8_MMA(1, 1, At, B1); PG8_BAR; PG8_SCHED;
            } else {
            PG8_LDB(B0, 0, 0); PG8_SCHED; PG8_LDA(At, 0, 0); PG8_STAGE(PG8_SA(1, 1), a1 + hstep, voffA);
            PG8_WAIT_L(8); PG8_BAR; PG8_WAIT_L(0); PG8_MMA(0, 0, At, B0); PG8_BAR; PG8_SCHED;
            PG8_LDB(B1, 0, 1); PG8_STAGE(PG8_SB(0, 0), b2, voffB);
            PG8_BAR; PG8_WAIT_L(0); PG8_MMA(0, 1, At, B1); PG8_BAR;
            PG8_LDA(At, 0, 1); PG8_STAGE(PG8_SA(0, 0), a2, voffA);
            PG8_BAR; PG8_WAIT_L(0); PG8_MMA(1, 0, At, B0); PG8_BAR; PG8_SCHED;
            PG8_STAGE(PG8_SB(0, 1), b2 + hstep, voffB);
            PG8_WAIT_V(6); PG8_BAR; PG8_MMA(1, 1, At, B1); PG8_BAR;
            PG8_LDB(B0, 1, 0); PG8_SCHED; PG8_LDA(At, 1, 0); PG8_STAGE(PG8_SA(0, 1), a2 + hstep, voffA);
            PG8_WAIT_L(8); PG8_BAR; PG8_WAIT_L(0); PG8_MMA(0, 0, At, B0); PG8_BAR; PG8_SCHED;
            PG8_LDB(B1, 1, 1); PG8_STAGE(PG8_SB(1, 0), b3, voffB);
            PG8_BAR; PG8_WAIT_L(0); PG8_MMA(0, 1, At, B1); PG8_BAR;
            PG8_LDA(At, 1, 1); PG8_STAGE(PG8_SA(1, 0), a3, voffA);
            PG8_BAR; PG8_WAIT_L(0); PG8_MMA(1, 0, At, B0); PG8_BAR; PG8_SCHED;
            PG8_STAGE(PG8_SB(1, 1), b3 + hstep, voffB);
            PG8_WAIT_V(6); PG8_BAR; PG8_MMA(1, 1, At, B1); PG8_BAR;
            }
        }
        if constexpr (ALIGN_EPI) { if (wr == 0) PG8_BAR; }
        if constexpr (!Epi::AFTER_DRAIN) { E(acc, cur, wr, wc, fr, fq); S.done(cur); }
        if (!has_next) break;
#pragma unroll
        for (int a = 0; a < 2; ++a)
#pragma unroll
            for (int b = 0; b < 2; ++b)
#pragma unroll
                for (int m = 0; m < 4; ++m)
#pragma unroll
                    for (int n = 0; n < 2; ++n) acc[a][b][m][n] = (f32x4){0.f, 0.f, 0.f, 0.f};
        cur = nxt; cA = nA; cB = nB; ++ui;
        if constexpr (ALIGN_EPI) { if (wr == 1) PG8_BAR; }
    }
    PG8_WAIT_V(0);
    if constexpr (!ALIGN_EPI) { if (wr == 0) PG8_BAR; }
    PG8_BAR;
    if constexpr (Epi::AFTER_DRAIN) { E.fused(acc, cur, wr, wc, fr, fq, lds, wid, lane); S.done(cur); }
#undef PG8_SA
#undef PG8_SB
#undef PG8_STAGE
#undef PG8_LDA
#undef PG8_LDB
#undef PG8_MMA
#undef PG8_WAIT_V
#undef PG8_WAIT_L
#undef PG8_BAR
#undef PG8_SCHED
}
}

namespace pg8 {
struct EpiSwiglu {
    static constexpr bool PERM = true, AFTER_DRAIN = false;
    f16_t* O;
    __device__ __forceinline__ void operator()(const f32x4 (&acc)[2][2][4][2], const Unit& u, int wr, int wc, int fr, int fq) const {
        const int row0 = u.pm * BM + wr * 64 + fr, col0 = u.pn * 128 + wc * 32 + 8 * fq;
#pragma unroll
        for (int ai = 0; ai < 2; ++ai)
#pragma unroll
            for (int m = 0; m < 4; ++m) {
                const f32x4 g0 = acc[ai][0][m][0], g1 = acc[ai][0][m][1], u0 = acc[ai][1][m][0], u1 = acc[ai][1][m][1];
                u32x4 w;
                w.x = pkh(siluf(g0[0]) * u0[0], siluf(g0[1]) * u0[1]); w.y = pkh(siluf(g0[2]) * u0[2], siluf(g0[3]) * u0[3]);
                w.z = pkh(siluf(g1[0]) * u1[0], siluf(g1[1]) * u1[1]); w.w = pkh(siluf(g1[2]) * u1[2], siluf(g1[3]) * u1[3]);
                *(u32x4*)(O + (size_t)(row0 + ai * HALF + m * 16) * FF + col0) = w;
            }
    }
};
struct EpiResidual {
    static constexpr bool PERM = false, AFTER_DRAIN = false;
    const float* base; float* out; const float* gate; int gstride; float coef;
    __device__ __forceinline__ void operator()(const f32x4 (&acc)[2][2][4][2], const Unit& u, int wr, int wc, int fr, int fq) const {
        const int row0 = u.pm * BM + wr * 64 + fr, col0 = u.pn * BM + wc * 32 + 4 * fq;
        const float* gp = gate + (size_t)(u.pm / (NT / BM)) * gstride + col0;
        f32x4 gv[2][2];
#pragma unroll
        for (int bj = 0; bj < 2; ++bj)
#pragma unroll
            for (int n = 0; n < 2; ++n) gv[bj][n] = *(const f32x4*)(gp + bj * HALF + n * 16) * coef;
#pragma unroll
        for (int ai = 0; ai < 2; ++ai)
#pragma unroll
            for (int m = 0; m < 4; ++m) { const size_t off = (size_t)(row0 + ai * HALF + m * 16) * DM + col0;
#pragma unroll
                for (int bj = 0; bj < 2; ++bj)
#pragma unroll
                    for (int n = 0; n < 2; ++n) { const f32x4 bs = *(const f32x4*)(base + off + bj * HALF + n * 16);
                        *(f32x4*)(out + off + bj * HALF + n * 16) = bs + gv[bj][n] * acc[ai][bj][m][n]; } }
    }
};
struct EpiInProj {
    static constexpr bool PERM = true, AFTER_DRAIN = false;
    f16_t* C16; f16_t* Z16; float* AB32; float* QN32; float* KC32; f16_t* KV16; float* GR32;
    __device__ __forceinline__ void operator()(const f32x4 (&acc)[2][2][4][2], const Unit& u, int wr, int wc, int fr, int fq) const {
        const int row0 = u.pm * BM + wr * 64 + fr;
#pragma unroll
        for (int bj = 0; bj < 2; ++bj) {
            const int c0 = u.pn * BM + bj * HALF + wc * 32 + 8 * fq;
            int kind; size_t ld; int cc; void* basep;
            if (c0 < 1536)      { kind = 0; basep = C16;  ld = 1536; cc = c0; }
            else if (c0 < 2048) { kind = 0; basep = Z16;  ld = 512;  cc = c0 - 1536; }
            else if (c0 < 2056) { kind = 1; basep = AB32; ld = 8;    cc = 0; }
            else if (c0 < 2568) { kind = 1; basep = QN32; ld = 512;  cc = c0 - 2056; }
            else if (c0 < 2696) { kind = 1; basep = KC32; ld = 128;  cc = c0 - 2568; }
            else if (c0 < 3336) { kind = 0; basep = KV16; ld = 640;  cc = c0 - 2696; }
            else if (c0 < 3360) { kind = 1; basep = GR32; ld = 24;   cc = c0 - 3336; }
            else continue;
#pragma unroll
            for (int ai = 0; ai < 2; ++ai)
#pragma unroll
                for (int m = 0; m < 4; ++m) {
                    const size_t row = (size_t)(row0 + ai * HALF + m * 16);
                    const f32x4 v0 = acc[ai][bj][m][0], v1 = acc[ai][bj][m][1];
                    if (kind == 0) { u32x4 w; w.x = pkh(v0[0], v0[1]); w.y = pkh(v0[2], v0[3]); w.z = pkh(v1[0], v1[1]); w.w = pkh(v1[2], v1[3]);
                        *(u32x4*)((f16_t*)basep + row * ld + cc) = w; }
                    else { float* p = (float*)basep + row * ld + cc; *(f32x4*)p = v0; *(f32x4*)(p + 4) = v1; }
                }
        }
    }
};
}

#define GAS __attribute__((address_space(1)))
#define LAS __attribute__((address_space(3)))
typedef GAS unsigned gu32;
#define RLX_AGENT __ATOMIC_RELAXED, __HIP_MEMORY_SCOPE_AGENT
#define XB_TMO      128
#define XB_XCNT(j)  (256  + 64 * (j))
#define XB_XSUB(j)  (1280 + 64 * (j))
#define XB_XGEN(j)  (2304 + 64 * (j))
#define XB_TOP      3328
#define XB_TOPGEN   3392
#define XCD_BAR_WORDS 3456
#define XB_SPIN_CAP (1u << 18)

__device__ __forceinline__ unsigned xb_ld(unsigned* p)              { return __hip_atomic_load(p, __ATOMIC_RELAXED, __HIP_MEMORY_SCOPE_AGENT); }
__device__ __forceinline__ unsigned xb_add(unsigned* p, unsigned v) { return __hip_atomic_fetch_add(p, v, __ATOMIC_RELAXED, __HIP_MEMORY_SCOPE_AGENT); }
__device__ __forceinline__ unsigned xb_xcc_id() { return (unsigned)__builtin_amdgcn_s_getreg((3 << 11) | 20) & 0xFu; }
#define XB_SPIN(cond, bar) do { unsigned _sp = 0; while (cond) { __builtin_amdgcn_s_sleep(1); \
    if ((++_sp & 255u) == 0u) { if (xb_ld(&(bar)[XB_TMO])) break; if (_sp > XB_SPIN_CAP) { atomicAdd(&(bar)[XB_TMO], 1u); break; } } } } while (0)

struct XcdBarrier {
    unsigned* bar; unsigned x;
    volatile LAS unsigned* st;
};

__device__ __forceinline__ XcdBarrier xcd_barrier_post(unsigned* bar, volatile LAS unsigned* st) {
    XcdBarrier b; b.bar = bar; b.x = xb_xcc_id(); b.st = st;
    if (threadIdx.x == 0) (void)xb_add(&bar[XB_XCNT(b.x)], 1u);
    return b;
}
__device__ __forceinline__ void xcd_barrier_complete(unsigned* bar, unsigned x, unsigned& nloc, unsigned& nx) {
    const unsigned G = gridDim.x * gridDim.y * gridDim.z;
    unsigned sum, cnt, mine, sp = 0u;
    for (;;) {
        sum = 0u; cnt = 0u; mine = 0u;
#pragma unroll
        for (unsigned j = 0; j < 16; ++j) { const unsigned c = xb_ld(&bar[XB_XCNT(j)]); sum += c; cnt += (c > 0u) ? 1u : 0u; mine = (j == x) ? c : mine; }
        if (sum == G) break;
        __builtin_amdgcn_s_sleep(1);
        if ((++sp & 255u) == 0u) { if (xb_ld(&bar[XB_TMO])) break; if (sp > XB_SPIN_CAP) { atomicAdd(&bar[XB_TMO], 1u); break; } }
    }
    nloc = mine > 0u ? mine : 1u; nx = cnt > 0u ? cnt : 1u;
}

__device__ __forceinline__ void xcd_barrier(const XcdBarrier& b) {
    asm volatile("s_waitcnt vmcnt(0)" ::: "memory");
    __syncthreads();
    if (threadIdx.x == 0) {
        unsigned* bar = b.bar;
        __builtin_amdgcn_s_waitcnt(0);
        unsigned nloc = b.st[0], nx = b.st[1];
        if (nloc == 0u) { xcd_barrier_complete(bar, b.x, nloc, nx); b.st[0] = nloc; b.st[1] = nx; }
        const unsigned old = xb_add(&bar[XB_XSUB(b.x)], 1u);
        const unsigned gen = old / nloc;
        if (old + 1u == (gen + 1u) * nloc) {
            __builtin_amdgcn_fence(__ATOMIC_RELEASE, "agent");
            asm volatile("s_waitcnt vmcnt(0)" ::: "memory");
            const unsigned og = xb_add(&bar[XB_TOP], 1u);
            const unsigned tg = og / nx;
            if (og + 1u == (tg + 1u) * nx) xb_add(&bar[XB_TOPGEN], 1u);
            else XB_SPIN(xb_ld(&bar[XB_TOPGEN]) == tg, bar);
            __builtin_amdgcn_fence(__ATOMIC_ACQUIRE, "agent");
            xb_add(&bar[XB_XGEN(b.x)], 1u);
            asm volatile("s_waitcnt vmcnt(0)" ::: "memory");
        } else {
            XB_SPIN(xb_ld(&bar[XB_XGEN(b.x)]) == gen, bar);
            __builtin_amdgcn_fence(__ATOMIC_ACQUIRE, "agent");
            asm volatile("s_waitcnt vmcnt(0)" ::: "memory");
        }
    }
    __syncthreads();
}

__device__ __forceinline__ void xcd_barrier_fast(const XcdBarrier& b) {
    asm volatile("s_waitcnt vmcnt(0)" ::: "memory");
    __syncthreads();
    if (threadIdx.x == 0) {
        unsigned* bar = b.bar;
        __builtin_amdgcn_s_waitcnt(0);
        unsigned nloc = b.st[0], nx = b.st[1];
        const unsigned old = xb_add(&bar[XB_XSUB(b.x)], 1u);
        const unsigned gen = old / nloc;
        if (old + 1u == (gen + 1u) * nloc) {
            __builtin_amdgcn_fence(__ATOMIC_RELEASE, "agent");
            asm volatile("s_waitcnt vmcnt(0)" ::: "memory");
            const unsigned og = xb_add(&bar[XB_TOP], 1u);
            const unsigned tg = og / nx;
            if (og + 1u == (tg + 1u) * nx) xb_add(&bar[XB_TOPGEN], 1u);
            else XB_SPIN(xb_ld(&bar[XB_TOPGEN]) == tg, bar);
            __builtin_amdgcn_fence(__ATOMIC_ACQUIRE, "agent");
            xb_add(&bar[XB_XGEN(b.x)], 1u);
            asm volatile("s_waitcnt vmcnt(0)" ::: "memory");
        } else {
            XB_SPIN(xb_ld(&bar[XB_XGEN(b.x)]) == gen, bar);
            __builtin_amdgcn_fence(__ATOMIC_ACQUIRE, "agent");
            asm volatile("s_waitcnt vmcnt(0)" ::: "memory");
        }
    }
    __syncthreads();
}

constexpr int NWAVES = 8, NTHR = 512;
constexpr int RING_BYTES = 131072, LDSCTL_OFF = RING_BYTES, LDS_BYTES = 147456;
constexpr int CW_BAR = 4096;
constexpr size_t CTL_ZERO_BYTES = 64 * 1024;

struct Params {
    const float *x, *c; const int* positions; const float *ada_w, *ada_b, *norm_g, *ffn_w_in, *ffn_w_out, *mix_w_in, *conv_w, *a_log, *dt_bias, *gdn_ng,
                *pe_k, *w1_k, *w2_k, *pe_v, *w1_v, *w2_v, *nsa_ng, *mix_w_out, *final_g;
    float* out; unsigned char* ws;
};
struct Ctx { LAS unsigned char* lds; int tid, lane, wave, bid, G, gw, NGW; };
__device__ __forceinline__ const __attribute__((address_space(4))) Params* kargs() {
    const __attribute__((address_space(4))) Params* q = (const __attribute__((address_space(4))) Params*)__builtin_amdgcn_kernarg_segment_ptr();
    asm volatile("" : "+s"(q)); return q;
}
#define PA(f) (kargs()->f)
#define WSP(T, off) ((T*)(PA(ws) + (off)))

__device__ __forceinline__ void phase_mod(const Ctx& C, const float* c, const float* ada_w, const float* ada_b, float* mod) {
    LAS float* cond = (LAS float*)C.lds; LAS float* part = (LAS float*)(C.lds + 16384);
    for (int i = C.tid; i < NB * DM; i += NTHR) cond[i] = siluf(c[i]);
    __syncthreads();
    for (int item = C.bid; item < 2 * 9216 / 64; item += C.G) {
        const int col = item * 64 + C.lane, l = col / 9216, j = col % 9216;
        const float* w = ada_w + (size_t)l * DM * 9216 + j; const int k0 = C.wave * 128;
        float a0 = 0.f, a1 = 0.f, a2 = 0.f, a3 = 0.f;
#pragma unroll 8
        for (int k = k0; k < k0 + 128; ++k) { const float wv = w[(size_t)k * 9216]; a0 += cond[k] * wv; a1 += cond[DM + k] * wv; a2 += cond[2 * DM + k] * wv; a3 += cond[3 * DM + k] * wv; }
        part[(C.wave * 4 + 0) * 64 + C.lane] = a0; part[(C.wave * 4 + 1) * 64 + C.lane] = a1; part[(C.wave * 4 + 2) * 64 + C.lane] = a2; part[(C.wave * 4 + 3) * 64 + C.lane] = a3;
        __syncthreads();
        if (C.wave < 4) { float s = ada_b[l * 9216 + j];
#pragma unroll
            for (int w8 = 0; w8 < 8; ++w8) s += part[(w8 * 4 + C.wave) * 64 + C.lane];
            mod[((size_t)l * NB + C.wave) * 9216 + j] = s; }
        __syncthreads();
    }
}
__device__ __forceinline__ void wconv_item(const float* W, int K, int N, f16_t* WT, int k0, int n0, int r0, LAS float* scr, int lane) {
#pragma unroll 8
    for (int i = 0; i < 32; ++i) { const int kk = 2 * i + (lane >> 5); scr[kk * 33 + (lane & 31)] = W[(size_t)(k0 + kk) * N + n0 + (lane & 31)]; }
    __builtin_amdgcn_wave_barrier();
    const int c = lane & 7;
#pragma unroll
    for (int j = 0; j < 4; ++j) { const int n = (lane >> 3) + 8 * j; const LAS float* s = scr + (8 * c) * 33 + n;
        u32x4_t o; o.x = pkh(s[0 * 33], s[1 * 33]); o.y = pkh(s[2 * 33], s[3 * 33]); o.z = pkh(s[4 * 33], s[5 * 33]); o.w = pkh(s[6 * 33], s[7 * 33]);
        *(u32x4_t*)(WT + (size_t)(r0 + n) * K + k0 + 8 * c) = o; }
    __builtin_amdgcn_wave_barrier();
}
__device__ __forceinline__ void phase_wconv(const Ctx& C, f16_t* WT1, f16_t* WT2, f16_t* WTIN, f16_t* WTOUT) {
    LAS float* scr = (LAS float*)(C.lds + 32768) + C.wave * (64 * 33);
    constexpr int I1 = 16 * 176, I2 = 44 * 32, I3 = 16 * 105, I4 = 16 * 32, T1 = 4 * I1, T2 = 4 * I2, T3 = 2 * I3, T4 = 2 * I4;
    for (int it = C.gw; it < T1 + T2 + T3 + T4; it += C.NGW) {
        int r = it;
        if (r < T1) { const int mi = r / I1, q = r % I1, kb = q / 176, nb = q % 176, n0 = 32 * nb, half = n0 / FF, jj = n0 % FF;
            wconv_item(PA(ffn_w_in) + (size_t)mi * DM * 2 * FF, DM, 2 * FF, WT1 + (size_t)mi * 2 * FF * DM, 64 * kb, n0, 256 * (jj / 128) + 128 * half + (jj % 128), scr, C.lane); continue; }
        r -= T1;
        if (r < T2) { const int mi = r / I2, q = r % I2, kb = q / 32, nb = q % 32;
            wconv_item(PA(ffn_w_out) + (size_t)mi * FF * DM, FF, DM, WT2 + (size_t)mi * DM * FF, 64 * kb, 32 * nb, 32 * nb, scr, C.lane); continue; }
        r -= T2;
        if (r < T3) { const int mi = r / I3, q = r % I3, kb = q / 105, nb = q % 105;
            wconv_item(PA(mix_w_in) + (size_t)mi * DM * NIN, DM, NIN, WTIN + (size_t)mi * NINP * DM, 64 * kb, 32 * nb, 32 * nb, scr, C.lane); continue; }
        r -= T3;
        { const int mi = r / I4, q = r % I4, kb = q / 32, nb = q % 32;
            wconv_item(PA(mix_w_out) + (size_t)mi * DM * DM, DM, DM, WTOUT + (size_t)mi * DM * DM, 64 * kb, 32 * nb, 32 * nb, scr, C.lane); }
    }
    constexpr int PADV = (NINP - NIN) * DM * 2 / 16;
    for (int i = C.bid * NTHR + C.tid; i < 2 * PADV; i += C.G * NTHR) { const int l = i / PADV, q = i % PADV;
        ((u32x4_t*)(WTIN + ((size_t)l * NINP + NIN) * DM))[q] = (u32x4_t){0u, 0u, 0u, 0u}; }
}
__device__ __forceinline__ void phase_norm(const Ctx& C, const float* x, const float* g, const float* shift, const float* scale, f16_t* hn) {
    for (int m = C.gw; m < MR; m += C.NGW) {
        const int b = m / NT; const f32x4_t* xr = (const f32x4_t*)(x + (size_t)m * DM) + C.lane;
        f32x4_t v[4]; float s = 0.f;
#pragma unroll
        for (int j = 0; j < 4; ++j) { v[j] = xr[64 * j]; s += v[j].x * v[j].x + v[j].y * v[j].y + v[j].z * v[j].z + v[j].w * v[j].w; }
        const float rstd = rsqrtf(wave_sum(s) * (1.f / DM) + EPS);
        u32x2_t* o = (u32x2_t*)(hn + (size_t)m * DM) + C.lane;
#pragma unroll
        for (int j = 0; j < 4; ++j) {
            const f32x4_t gg = ((const f32x4_t*)g)[C.lane + 64 * j], sh = ((const f32x4_t*)(shift + (size_t)b * 9216))[C.lane + 64 * j], sc = ((const f32x4_t*)(scale + (size_t)b * 9216))[C.lane + 64 * j];
            const f32x4_t h = v[j] * rstd * gg * (sc + 1.f) + sh;
            u32x2_t w; w.x = pkh(h.x, h.y); w.y = pkh(h.z, h.w); o[64 * j] = w;
        }
    }
}
__device__ __forceinline__ void phase_final_norm(const Ctx& C, float* x, const float* g) {
    for (int m = C.gw; m < MR; m += C.NGW) {
        f32x4_t* xr = (f32x4_t*)(x + (size_t)m * DM) + C.lane;
        f32x4_t v[4]; float s = 0.f;
#pragma unroll
        for (int j = 0; j < 4; ++j) { v[j] = xr[64 * j]; s += v[j].x * v[j].x + v[j].y * v[j].y + v[j].z * v[j].z + v[j].w * v[j].w; }
        const float rstd = rsqrtf(wave_sum(s) * (1.f / DM) + EPS);
#pragma unroll
        for (int j = 0; j < 4; ++j) xr[64 * j] = v[j] * rstd * ((const f32x4_t*)g)[C.lane + 64 * j];
    }
}
__device__ __forceinline__ void phase_gdn_prep(const Ctx& C, const f16_t* C16, const float* convw, const float* AB32, const float* a_log, const float* dt_bias,
                                               f16_t* GQ, f16_t* GK, f16_t* GV, float* Gg, float* Gb) {
    const int lane = C.lane;
    for (int wv = C.gw; wv < MR * 12; wv += C.NGW) {
        const int m = wv / 12, hs = wv % 12, b = m / NT, t = m % NT; const int c = hs * 128 + 2 * lane;
        float y0 = 0.f, y1 = 0.f;
#pragma unroll
        for (int i = 0; i < 4; ++i) { const int tt = t - 3 + i; if (tt >= 0) { const unsigned xv = *(const unsigned*)(C16 + (size_t)(m - 3 + i) * 1536 + c);
                y0 += hlo(xv) * convw[i * 1536 + c]; y1 += hhi(xv) * convw[i * 1536 + c + 1]; } }
        y0 = siluf(y0); y1 = siluf(y1);
        const int which = hs >> 2, h = hs & 3;
        if (which < 2) { const float ss = wave_sum(y0 * y0 + y1 * y1); float r = rsqrtf(ss + EPS); if (which == 0) r *= 0.08838834764831845f; y0 *= r; y1 *= r; }
        f16_t* dst = (which == 0 ? GQ : which == 1 ? GK : GV) + ((size_t)(b * GH + h) * NT + t) * GD + 2 * lane;
        *(unsigned*)dst = pkh(y0, y1);
        if (hs == 8 && lane < 4) {
            const float braw = AB32[(size_t)m * 8 + lane], araw = AB32[(size_t)m * 8 + 4 + lane];
            const float xx = araw + dt_bias[lane]; const float sp = (xx > 20.f) ? xx : log1pf(__expf(xx));
            Gg[(size_t)(b * GH + lane) * NT + t] = -__expf(a_log[lane]) * sp;
            Gb[(size_t)(b * GH + lane) * NT + t] = sigmf(braw);
        }
    }
}
__device__ __forceinline__ void phase_rope(const Ctx& C, const int* positions, float* QN32, float* KC32, f16_t* KV16) {
    for (int idx = C.bid * NTHR + C.tid; idx < MR * 14 * 8; idx += C.G * NTHR) {
        const int i = idx & 7, slot = (idx >> 3) % 14, m = idx / (14 * 8);
        const float pos = (float)positions[m];
        const float invf = powf(500000.0f, -(float)i * 0.125f);
        const float ang = pos * invf; const float cs = cosf(ang), sn = sinf(ang);
        if (slot < 10) { float* q = (slot < 8) ? (QN32 + (size_t)m * 512 + slot * 64) : (KC32 + (size_t)m * 128 + (slot - 8) * 64);
            const float x1 = q[i], x2 = q[i + 8]; q[i] = x1 * cs - x2 * sn; q[i + 8] = x2 * cs + x1 * sn; }
        else { f16_t* q = KV16 + (size_t)m * 640 + ((slot < 12) ? (128 + (slot - 10) * 64) : (384 + (slot - 12) * 64));
            const float x1 = h2f(q[i]), x2 = h2f(q[i + 8]); q[i] = f2h(x1 * cs - x2 * sn); q[i + 8] = f2h(x2 * cs + x1 * sn); }
    }
}
__device__ __forceinline__ void phase_compress(const Ctx& C, const float* KC32, const f16_t* KV16, const float* pe_k, const float* w1_k, const float* w2_k,
                                               const float* pe_v, const float* w1_v, const float* w2_v, float* KCMP, float* VCMP) {
    const int sub = C.tid >> 7, st = C.tid & 127;
    LAS float* blk = (LAS float*)C.lds + sub * 2304; LAS float* hid = blk + 2048;
    constexpr int NIT = 2 * NB * NCMP * NG;
    for (int base = C.bid * 4; base < NIT; base += C.G * 4) {
        int id = base + sub; const bool act = id < NIT; if (!act) id = 0;
        const int g = id % NG; id /= NG; const int n = id % NCMP; id /= NCMP; const int b = id % NB; const int which = id / NB;
        const float* pe = which ? pe_v : pe_k; const float* w1 = which ? w1_v : w1_k; const float* w2 = which ? w2_v : w2_k;
        for (int k = st; k < 2048; k += 128) { const int l = k >> 6, d = k & 63; const size_t m = (size_t)b * NT + 16 * n + l;
            const float v = which ? h2f(KV16[m * 640 + g * 64 + d]) : KC32[m * 128 + g * 64 + d]; blk[k] = v + pe[k]; }
        __syncthreads();
        float a = 0.f;
#pragma unroll 8
        for (int k = 0; k < 2048; ++k) a += blk[k] * w1[(size_t)k * 128 + st];
        hid[st] = siluf(a);
        __syncthreads();
        if (st < 64 && act) { float o = 0.f;
#pragma unroll 8
            for (int j = 0; j < 128; ++j) o += hid[j] * w2[j * 64 + st];
            (which ? VCMP : KCMP)[((size_t)(b * NG + g) * 256 + n) * 64 + st] = o; }
        __syncthreads();
    }
}
__device__ __forceinline__ void phase_cmpattn(const Ctx& C, int first, const float* QN32, const float* KCMP, const float* VCMP, const float* GR32, float* OACC, unsigned long long* SEL) {
    const int lane = C.lane;
    LAS float* qs = (LAS float*)C.lds + C.wave * 1408; LAS float* P = qs + 256; LAS float* imps = P + 1024;
    for (int id = C.gw - first * NWAVES; id < NB * NG * NT; id += C.NGW - first * NWAVES) {
        const int t = id % NT, g = (id / NT) % NG, b = id / (NT * NG); const size_t m = (size_t)b * NT + t;
#pragma unroll
        for (int r = 0; r < 4; ++r) qs[r * 64 + lane] = QN32[m * 512 + (g * 4 + r) * 64 + lane] * 0.125f;
        __builtin_amdgcn_wave_barrier();
        const int nvalid = (t >= 31) ? min((t - 31) / 16 + 1, NCMP) : 0;
        const float* kc = KCMP + (size_t)(b * NG + g) * 256 * 64; const float* vc = VCMP + (size_t)(b * NG + g) * 256 * 64;
        float s[4][4];
#pragma unroll
        for (int i = 0; i < 4; ++i) { const int n = lane + 64 * i;
            if (n < nvalid) { float a0 = 0.f, a1 = 0.f, a2 = 0.f, a3 = 0.f; const float* kp = kc + (size_t)n * 64;
                for (int d = 0; d < 64; ++d) { const float kv = kp[d]; a0 += qs[d] * kv; a1 += qs[64 + d] * kv; a2 += qs[128 + d] * kv; a3 += qs[192 + d] * kv; }
                s[0][i] = a0; s[1][i] = a1; s[2][i] = a2; s[3][i] = a3; }
            else { s[0][i] = s[1][i] = s[2][i] = s[3][i] = -INFINITY; } }
#pragma unroll
        for (int r = 0; r < 4; ++r) {
            float mx = fmaxf(fmaxf(s[r][0], s[r][1]), fmaxf(s[r][2], s[r][3])); mx = wave_max(mx);
            float e[4], sum = 0.f;
#pragma unroll
            for (int i = 0; i < 4; ++i) { e[i] = (lane + 64 * i < nvalid) ? __expf(s[r][i] - mx) : 0.f; sum += e[i]; }
            sum = wave_sum(sum); const float inv = 1.f / fmaxf(sum, 1e-30f);
#pragma unroll
            for (int i = 0; i < 4; ++i) P[r * 256 + lane + 64 * i] = e[i] * inv;
        }
        __builtin_amdgcn_wave_barrier();
        float o0 = 0.f, o1 = 0.f, o2 = 0.f, o3 = 0.f;
        for (int n = 0; n < nvalid; ++n) { const float v = vc[(size_t)n * 64 + lane]; o0 += P[n] * v; o1 += P[256 + n] * v; o2 += P[512 + n] * v; o3 += P[768 + n] * v; }
        { const float* gr = GR32 + m * 24 + (g * 4) * 3; float* oa = OACC + m * 512 + (g * 4) * 64 + lane;
          oa[0] = sigmf(gr[0]) * o0; oa[64] = sigmf(gr[3]) * o1; oa[128] = sigmf(gr[6]) * o2; oa[192] = sigmf(gr[9]) * o3; }
        float imp = 0.f; { const int n0 = max(4 * lane - 1, 0), n1 = min(4 * lane + 3, NCMP - 1);
            for (int n = n0; n <= n1; ++n) imp += P[n] + P[256 + n] + P[512 + n] + P[768 + n]; }
        const int cur = t >> 6; const bool valid = lane <= cur; const bool forced = (lane == 0) || (lane == cur) || (lane == cur - 1);
        const float val = forced ? INFINITY : (valid ? imp : -INFINITY);
        imps[lane] = val;
        __builtin_amdgcn_wave_barrier();
        int rank = 0;
        for (int j = 0; j < 64; ++j) { const float o = imps[j]; rank += (o > val || (o == val && j < lane)) ? 1 : 0; }
        const unsigned long long mask = __ballot((rank < NSEL) && valid);
        if (lane == 0) SEL[(size_t)(b * NG + g) * NT + t] = mask;
        __builtin_amdgcn_wave_barrier();
    }
}
__device__ __forceinline__ void attn_block(const f16_t* Kb, const f16_t* Vb, int pos0, int lo, int t, int lane, const LAS float* qs, LAS float* pl, float (&mx)[4], float (&ls)[4], float (&o)[4]) {
    const int pos = pos0 + lane; const bool ok = (pos <= t) && (pos >= lo);
    float s[4] = {-INFINITY, -INFINITY, -INFINITY, -INFINITY};
    if (ok) { const u32x4_t* kp = (const u32x4_t*)(Kb + (size_t)pos * 640); float a0 = 0.f, a1 = 0.f, a2 = 0.f, a3 = 0.f;
#pragma unroll
        for (int c8 = 0; c8 < 8; ++c8) { const u32x4_t kv = kp[c8]; const unsigned ku[4] = {kv.x, kv.y, kv.z, kv.w};
#pragma unroll
            for (int e = 0; e < 4; ++e) { const float k0 = hlo(ku[e]), k1 = hhi(ku[e]); const int d = c8 * 8 + e * 2;
                a0 += qs[d] * k0 + qs[d + 1] * k1; a1 += qs[64 + d] * k0 + qs[64 + d + 1] * k1; a2 += qs[128 + d] * k0 + qs[128 + d + 1] * k1; a3 += qs[192 + d] * k0 + qs[192 + d + 1] * k1; } }
        s[0] = a0; s[1] = a1; s[2] = a2; s[3] = a3; }
    float al[4];
#pragma unroll
    for (int r = 0; r < 4; ++r) { const float bm = wave_max(s[r]); const float mn = fmaxf(mx[r], bm);
        al[r] = (mn == -INFINITY) ? 1.f : __expf(mx[r] - mn); const float pp = ok ? __expf(s[r] - mn) : 0.f; mx[r] = mn;
        ls[r] = ls[r] * al[r] + wave_sum(pp); pl[r * 64 + lane] = pp; o[r] *= al[r]; }
    __builtin_amdgcn_wave_barrier();
    const int kmax = min(64, t - pos0 + 1);
    for (int k = 0; k < kmax; ++k) { const float v = h2f(Vb[(size_t)(pos0 + k) * 640 + lane]);
        o[0] += pl[k] * v; o[1] += pl[64 + k] * v; o[2] += pl[128 + k] * v; o[3] += pl[192 + k] * v; }
    __builtin_amdgcn_wave_barrier();
}
__device__ __forceinline__ void phase_selwin(const Ctx& C, const float* QN32, const f16_t* KV16, const float* GR32, const float* OACC, const unsigned long long* SEL, const float* ng, f16_t* Y) {
    const int lane = C.lane;
    LAS float* qs = (LAS float*)C.lds + C.wave * 512; LAS float* pl = qs + 256;
    for (int id = C.gw; id < NB * NG * NT; id += C.NGW) {
        const int t = id % NT, g = (id / NT) % NG, b = id / (NT * NG); const size_t m = (size_t)b * NT + t;
#pragma unroll
        for (int r = 0; r < 4; ++r) qs[r * 64 + lane] = QN32[m * 512 + (g * 4 + r) * 64 + lane] * 0.125f;
        __builtin_amdgcn_wave_barrier();
        const f16_t* base = KV16 + (size_t)b * NT * 640 + g * 64;
        const f16_t *Ks = base + 128, *Vs = base + 256, *Kw = base + 384, *Vw = base + 512;
        const unsigned long long mask = SEL[(size_t)(b * NG + g) * NT + t];
        float mx[4], ls[4], o[4], osel[4];
#pragma unroll
        for (int r = 0; r < 4; ++r) { mx[r] = -INFINITY; ls[r] = 0.f; o[r] = 0.f; }
        const int cur = t >> 6;
        for (int j = 0; j <= cur; ++j) if ((mask >> j) & 1ull) attn_block(Ks, Vs, 64 * j, 0, t, lane, qs, pl, mx, ls, o);
#pragma unroll
        for (int r = 0; r < 4; ++r) { osel[r] = o[r] / fmaxf(ls[r], 1e-30f); mx[r] = -INFINITY; ls[r] = 0.f; o[r] = 0.f; }
        const int lo = max(t - WIN + 1, 0);
        for (int j = lo >> 6; j <= cur; ++j) attn_block(Kw, Vw, 64 * j, lo, t, lane, qs, pl, mx, ls, o);
#pragma unroll
        for (int r = 0; r < 4; ++r) { const int hq = g * 4 + r; const float* gr = GR32 + m * 24 + hq * 3;
            float v = OACC[m * 512 + hq * 64 + lane] + sigmf(gr[1]) * osel[r] + sigmf(gr[2]) * (o[r] / fmaxf(ls[r], 1e-30f));
            const float ss = wave_sum(v * v); v = v * rsqrtf(ss * (1.f / 64.f) + EPS) * ng[lane];
            Y[m * DM + 512 + hq * 64 + lane] = f2h(v); }
        __builtin_amdgcn_wave_barrier();
    }
}
__device__ __forceinline__ void phase_scan_simple(const Ctx& C, const f16_t* GQ, const f16_t* GK, const f16_t* GV, const float* Gg, const float* Gb, float* OG) {
    if (C.wave != 0) return;
    LAS float* qs = (LAS float*)C.lds; LAS float* ks = qs + 32 * 128; LAS float* ab = ks + 32 * 128;
    const int lane = C.lane;
    for (int job = C.bid; job < NB * GH * 2; job += C.G) {
        const int bh = job >> 1, dv = (job & 1) * 64 + lane, b = bh / GH, h = bh % GH;
        float S[128];
#pragma unroll
        for (int i = 0; i < 128; ++i) S[i] = 0.f;
        const f16_t* q = GQ + (size_t)bh * NT * GD; const f16_t* k = GK + (size_t)bh * NT * GD; const f16_t* v = GV + (size_t)bh * NT * GD;
        for (int t0 = 0; t0 < NT; t0 += 32) {
            __builtin_amdgcn_wave_barrier();
            for (int i = lane; i < 32 * 64; i += 64) { const int tt = i >> 6, c = (i & 63) * 2; const unsigned qv = *(const unsigned*)(q + (size_t)(t0 + tt) * GD + c), kv = *(const unsigned*)(k + (size_t)(t0 + tt) * GD + c);
                qs[tt * 128 + c] = hlo(qv); qs[tt * 128 + c + 1] = hhi(qv); ks[tt * 128 + c] = hlo(kv); ks[tt * 128 + c + 1] = hhi(kv); }
            if (lane < 32) { ab[lane] = __expf(Gg[(size_t)bh * NT + t0 + lane]); ab[32 + lane] = Gb[(size_t)bh * NT + t0 + lane]; }
            __builtin_amdgcn_wave_barrier();
            for (int tt = 0; tt < 32; ++tt) {
                const float a = ab[tt], beta = ab[32 + tt]; const float vv = h2f(v[(size_t)(t0 + tt) * GD + dv]);
                float kS = 0.f;
#pragma unroll
                for (int i = 0; i < 128; ++i) kS += ks[tt * 128 + i] * S[i];
                const float vn = beta * (vv - a * kS);
                float oo = 0.f;
#pragma unroll
                for (int i = 0; i < 128; ++i) { S[i] = a * S[i] + ks[tt * 128 + i] * vn; oo += qs[tt * 128 + i] * S[i]; }
                OG[((size_t)b * NT + t0 + tt) * GW + h * GD + dv] = oo;
            }
        }
    }
}
__device__ __forceinline__ void phase_gdn_out(const Ctx& C, const float* OG, const f16_t* Z16, const float* ng, f16_t* Y) {
    const int lane = C.lane;
    for (int wv = C.gw; wv < MR * GH; wv += C.NGW) {
        const int m = wv >> 2, h = wv & 3;
        const f32x2_t o = *(const f32x2_t*)(OG + (size_t)m * GW + h * GD + 2 * lane);
        const float r = rsqrtf(wave_sum(o.x * o.x + o.y * o.y) * (1.f / GD) + EPS);
        const unsigned z = *(const unsigned*)(Z16 + (size_t)m * GW + h * GD + 2 * lane);
        *(unsigned*)(Y + (size_t)m * DM + h * GD + 2 * lane) = pkh(o.x * r * ng[2 * lane] * siluf(hlo(z)), o.y * r * ng[2 * lane + 1] * siluf(hhi(z)));
    }
}

typedef _Float16 h8_t __attribute__((ext_vector_type(8)));
typedef _Float16 h4_t __attribute__((ext_vector_type(4)));
typedef float f32x16_t __attribute__((ext_vector_type(16)));
__device__ __forceinline__ h8_t ldfrag_perm(const f16_t* p16, int h) {
    const h4_t a = *(const h4_t*)(p16 + 4 * h), b = *(const h4_t*)(p16 + 8 + 4 * h);
    return (h8_t){a[0], a[1], a[2], a[3], b[0], b[1], b[2], b[3]};
}
__device__ __forceinline__ h8_t acc2frag(const f32x16_t& x, int s) {
    u32x4_t w; w.x = pkh(x[8 * s + 0], x[8 * s + 1]); w.y = pkh(x[8 * s + 2], x[8 * s + 3]); w.z = pkh(x[8 * s + 4], x[8 * s + 5]); w.w = pkh(x[8 * s + 6], x[8 * s + 7]);
    return __builtin_bit_cast(h8_t, w);
}
__device__ __forceinline__ int crow16(int reg, int h) { return (reg & 3) + 8 * (reg >> 2) + 4 * h; }

__device__ __forceinline__ void phase_gdn_chunk(const Ctx& C, f16_t* GQ, f16_t* GK, f16_t* GV, const float* Gg, const float* Gb, f16_t* UIMG, f16_t* ATT, float* DL) {
    const int hb = C.tid >> 8, th = C.tid & 255, lane = C.lane, hw = C.wave & 3, r = lane & 31, h = lane >> 5;
    LAS unsigned char* base = C.lds + hb * 65536;
    LAS f16_t* Kt = (LAS f16_t*)base;
    LAS f16_t* Qt = (LAS f16_t*)(base + 17408);
    LAS float* Lm = (LAS float*)(base + 34816);
    LAS float* gcs = (LAS float*)(base + 51200);
    for (int u = C.bid * 2 + hb; u < NB * GH * 64; u += C.G * 2) {
        const int bh = u >> 6, n = u & 63; const size_t row0 = (size_t)bh * NT + 64 * n;
        if (hw == 0) {
            float g = Gg[row0 + lane];
#pragma unroll
            for (int o = 1; o < 64; o <<= 1) { const float t = __shfl_up(g, o); if (lane >= o) g += t; }
            const float glast = __shfl(g, 63);
            gcs[lane] = g; gcs[64 + lane] = __expf(g); gcs[128 + lane] = Gb[row0 + lane]; gcs[192 + lane] = __expf(glast - g);
            if (lane == 63) DL[u] = __expf(g);
        }
#pragma unroll
        for (int q = 0; q < 4; ++q) { const int idx = th + 256 * q, row = idx >> 4, ch = idx & 15;
            *(LAS u32x4_t*)(Kt + row * 136 + ch * 8) = *(const u32x4_t*)(GK + (row0 + row) * GD + ch * 8);
            *(LAS u32x4_t*)(Qt + row * 136 + ch * 8) = *(const u32x4_t*)(GQ + (row0 + row) * GD + ch * 8); }
        __syncthreads();
        { const int ti = hw >> 1, tj = hw & 1;
          f32x16_t kk = {}, qk = {};
          if (ti >= tj) {
#pragma unroll
              for (int s = 0; s < 8; ++s) {
                  const h8_t bk = *(const LAS h8_t*)(Kt + (32 * tj + r) * 136 + 16 * s + 8 * h);
                  const h8_t ak = *(const LAS h8_t*)(Kt + (32 * ti + r) * 136 + 16 * s + 8 * h);
                  const h8_t aq = *(const LAS h8_t*)(Qt + (32 * ti + r) * 136 + 16 * s + 8 * h);
                  kk = __builtin_amdgcn_mfma_f32_32x32x16_f16(ak, bk, kk, 0, 0, 0);
                  qk = __builtin_amdgcn_mfma_f32_32x32x16_f16(aq, bk, qk, 0, 0, 0);
              }
          }
          const int sidx = 32 * tj + r; const float gs = gcs[sidx];
          f16_t* att = ATT + (size_t)u * 4096;
#pragma unroll
          for (int reg = 0; reg < 16; ++reg) { const int c = 32 * ti + crow16(reg, h);
              const float dec = (sidx <= c) ? __expf(gcs[c] - gs) : 0.f;
              Lm[c * 64 + sidx] = (sidx < c) ? gcs[128 + c] * kk[reg] * dec : 0.f;
              att[c * 64 + sidx] = f2h(qk[reg] * dec); }
        }
        __syncthreads();
        float sol[64];
        { const bool isu = th < 128; const int col = th & 127;
#pragma unroll
          for (int c = 0; c < 64; ++c) { const float bc = gcs[128 + c];
              sol[c] = isu ? bc * h2f(GV[(row0 + c) * GD + col]) : bc * gcs[64 + c] * h2f(Kt[c * 136 + col]); }
#pragma unroll
          for (int c = 1; c < 64; ++c) { float a0 = 0.f, a1 = 0.f;
#pragma unroll
              for (int s4 = 0; s4 < (c + 3) / 4; ++s4) { const f32x4_t lv = *(const LAS f32x4_t*)(Lm + c * 64 + 4 * s4);
                  if (4 * s4 + 0 < c) a0 += lv.x * sol[4 * s4 + 0];
                  if (4 * s4 + 1 < c) a1 += lv.y * sol[4 * s4 + 1];
                  if (4 * s4 + 2 < c) a0 += lv.z * sol[4 * s4 + 2];
                  if (4 * s4 + 3 < c) a1 += lv.w * sol[4 * s4 + 3]; }
              sol[c] -= a0 + a1; }
        }
        __syncthreads();
        if (th < 128) {
            const int w = th >> 5, rr = th & 31; f16_t* up = UIMG + (size_t)u * 8192 + w * 2048;
#pragma unroll
            for (int tile = 0; tile < 2; ++tile)
#pragma unroll
                for (int hh = 0; hh < 2; ++hh) { u32x4_t o0, o1;
#define SOLV(reg) sol[32 * tile + ((reg) & 3) + 8 * ((reg) >> 2) + 4 * hh]
                    o0.x = pkh(SOLV(0), SOLV(1)); o0.y = pkh(SOLV(2), SOLV(3)); o0.z = pkh(SOLV(4), SOLV(5)); o0.w = pkh(SOLV(6), SOLV(7));
                    o1.x = pkh(SOLV(8), SOLV(9)); o1.y = pkh(SOLV(10), SOLV(11)); o1.z = pkh(SOLV(12), SOLV(13)); o1.w = pkh(SOLV(14), SOLV(15));
#undef SOLV
                    u32x4_t* dst = (u32x4_t*)(up + tile * 1024 + (rr + 32 * hh) * 16); dst[0] = o0; dst[1] = o1; }
        } else { const int col = th - 128;
#pragma unroll
            for (int c = 0; c < 64; ++c) GV[(row0 + c) * GD + col] = f2h(sol[c]); }
#pragma unroll
        for (int q = 0; q < 4; ++q) { const int idx = th + 256 * q, row = idx >> 4, ch = idx & 15; const float e = gcs[64 + row];
            const h8_t v = *(const LAS h8_t*)(Qt + row * 136 + ch * 8); u32x4_t o;
            o.x = pkh((float)v[0] * e, (float)v[1] * e); o.y = pkh((float)v[2] * e, (float)v[3] * e); o.z = pkh((float)v[4] * e, (float)v[5] * e); o.w = pkh((float)v[6] * e, (float)v[7] * e);
            *(u32x4_t*)(GQ + (row0 + row) * GD + ch * 8) = o; }
        { const int dk = th & 127, ch = th >> 7; f16_t* kd = GK + row0 * GD + dk * 64 + 32 * ch;
#pragma unroll
          for (int q = 0; q < 4; ++q) { float v[8];
#pragma unroll
              for (int e = 0; e < 8; ++e) { const int c = 32 * ch + 8 * q + e; v[e] = h2f(Kt[c * 136 + dk]) * gcs[192 + c]; }
              u32x4_t o; o.x = pkh(v[0], v[1]); o.y = pkh(v[2], v[3]); o.z = pkh(v[4], v[5]); o.w = pkh(v[6], v[7]);
              *(u32x4_t*)(kd + 8 * q) = o; } }
        __syncthreads();
    }
}

__device__ __forceinline__ void phase_gdn_scan(const Ctx& C, int bh, const f16_t* QG, const f16_t* KDT, const f16_t* W, const f16_t* UIMG, const f16_t* ATT, const float* DL,
                                               const f16_t* Z16, const float* ng, f16_t* Y) {
    const int lane = C.lane, r = lane & 31, h = lane >> 5, w = C.wave, b = bh / GH, hh = bh % GH;
    LAS float* Ot = (LAS float*)C.lds;
    f32x16_t S[4];
#pragma unroll
    for (int T = 0; T < 4; ++T) S[T] = (f32x16_t){};
#pragma unroll 1
    for (int n = 0; n < 64; ++n) {
        if (w < 4) {
            const size_t row0 = (size_t)bh * NT + 64 * n; const int u = bh * 64 + n;
            const f16_t* Wp = W + row0 * GD; const f16_t* Qp = QG + row0 * GD; const f16_t* Ap = ATT + (size_t)u * 4096; const f16_t* Kp = KDT + row0 * GD;
            h8_t sf[4][2];
#pragma unroll
            for (int T = 0; T < 4; ++T) { sf[T][0] = acc2frag(S[T], 0); sf[T][1] = acc2frag(S[T], 1); }
            f32x16_t ws[2], qs[2];
#pragma unroll
            for (int ct = 0; ct < 2; ++ct) { ws[ct] = (f32x16_t){}; qs[ct] = (f32x16_t){};
#pragma unroll
                for (int T = 0; T < 4; ++T)
#pragma unroll
                    for (int s = 0; s < 2; ++s) {
                        ws[ct] = __builtin_amdgcn_mfma_f32_32x32x16_f16(ldfrag_perm(Wp + (32 * ct + r) * GD + 32 * T + 16 * s, h), sf[T][s], ws[ct], 0, 0, 0);
                        qs[ct] = __builtin_amdgcn_mfma_f32_32x32x16_f16(ldfrag_perm(Qp + (32 * ct + r) * GD + 32 * T + 16 * s, h), sf[T][s], qs[ct], 0, 0, 0);
                    } }
            h8_t vf[2][2];
#pragma unroll
            for (int ct = 0; ct < 2; ++ct) { const h8_t* up = (const h8_t*)(UIMG + (size_t)u * 8192 + w * 2048 + ct * 1024 + lane * 16); const h8_t u0 = up[0], u1 = up[1];
                f32x16_t vn;
#pragma unroll
                for (int e = 0; e < 8; ++e) { vn[e] = (float)u0[e] - ws[ct][e]; vn[8 + e] = (float)u1[e] - ws[ct][8 + e]; }
                vf[ct][0] = acc2frag(vn, 0); vf[ct][1] = acc2frag(vn, 1); }
#pragma unroll
            for (int ct = 0; ct < 2; ++ct)
#pragma unroll
                for (int c2 = 0; c2 < 2; ++c2)
#pragma unroll
                    for (int s = 0; s < 2; ++s)
                        qs[ct] = __builtin_amdgcn_mfma_f32_32x32x16_f16(ldfrag_perm(Ap + (32 * ct + r) * 64 + 32 * c2 + 16 * s, h), vf[c2][s], qs[ct], 0, 0, 0);
#pragma unroll
            for (int ct = 0; ct < 2; ++ct)
#pragma unroll
                for (int reg = 0; reg < 16; ++reg) Ot[(32 * ct + crow16(reg, h)) * 132 + 32 * w + r] = qs[ct][reg];
            const float dl = DL[u];
#pragma unroll
            for (int T = 0; T < 4; ++T) { S[T] = S[T] * dl;
#pragma unroll
                for (int c2 = 0; c2 < 2; ++c2)
#pragma unroll
                    for (int s = 0; s < 2; ++s)
                        S[T] = __builtin_amdgcn_mfma_f32_32x32x16_f16(ldfrag_perm(Kp + (32 * T + r) * 64 + 32 * c2 + 16 * s, h), vf[c2][s], S[T], 0, 0, 0); }
        }
        __syncthreads();
#pragma unroll
        for (int i = 0; i < 8; ++i) { const int c = 8 * w + i; const size_t m = (size_t)b * NT + 64 * n + c;
            const f32x2_t o = *(const LAS f32x2_t*)(Ot + c * 132 + 2 * lane);
            const float rr = rsqrtf(wave_sum(o.x * o.x + o.y * o.y) * (1.f / GD) + EPS);
            const unsigned z = *(const unsigned*)(Z16 + m * GW + hh * GD + 2 * lane);
            *(unsigned*)(Y + m * DM + hh * GD + 2 * lane) = pkh(o.x * rr * ng[2 * lane] * siluf(hlo(z)), o.y * rr * ng[2 * lane + 1] * siluf(hhi(z))); }
        __syncthreads();
    }
}

template <class Epi> __device__ __forceinline__ void run_gemm(LAS unsigned char* lds, const f16_t* A, const f16_t* Bt, int N, int K, const Epi& E) {
    int bid = blockIdx.x, G = gridDim.x; asm volatile("" : "+s"(bid), "+s"(G));
    pg8::Gemm g{A, Bt, MR, N, K, 0}; pg8::StaticOrder S; S.init(MR, N, G, bid);
    pg8::gemm_phase<Epi, pg8::StaticOrder, true, true>(lds, g, S, E);
}
__device__ __forceinline__ Ctx make_ctx(LAS unsigned char* lds) {
    Ctx C; C.lds = lds; int t = threadIdx.x; asm volatile("" : "+v"(t));
    C.tid = t; C.lane = t & 63; C.wave = __builtin_amdgcn_readfirstlane(t >> 6);
    int bid = blockIdx.x, G = gridDim.x; asm volatile("" : "+s"(bid), "+s"(G));
    C.bid = bid; C.G = G; C.gw = C.bid * NWAVES + C.wave; C.NGW = C.G * NWAVES; return C;
}
__global__ void __launch_bounds__(NTHR, 2) mega_fwd(Params p_unused) {
    extern __shared__ __attribute__((aligned(16))) unsigned char lds_raw[];
    LAS unsigned char* lds = (LAS unsigned char*)lds_raw;
    for (int u = threadIdx.x; u < (LDS_BYTES - LDSCTL_OFF) / 4; u += NTHR) ((LAS unsigned*)(lds + LDSCTL_OFF))[u] = 0u;
    __syncthreads();
    (void)xcd_barrier_post(WSP(unsigned, WS_CTL) + CW_BAR, (volatile LAS unsigned*)(lds + LDSCTL_OFF + 64));
#define MK_BAR(b_) XcdBarrier b_; b_.bar = WSP(unsigned, WS_CTL) + CW_BAR; { unsigned x_ = xb_xcc_id(); asm volatile("" : "+s"(x_)); b_.x = x_; } b_.st = (volatile LAS unsigned*)(lds + LDSCTL_OFF + 64)
#define GRID_BAR_FIRST() do { MK_BAR(b_); xcd_barrier(b_); } while (0)
#define GRID_BAR() do { MK_BAR(b_); xcd_barrier_fast(b_); } while (0)
#define MODL(l) (WSP(float, WS_MOD) + (size_t)(l) * NB * 9216)
    { Ctx C = make_ctx(lds); phase_mod(C, PA(c), PA(ada_w), PA(ada_b), WSP(float, WS_MOD)); }
    { Ctx C = make_ctx(lds); phase_wconv(C, WSP(f16_t, WS_WT1), WSP(f16_t, WS_WT2), WSP(f16_t, WS_WTIN), WSP(f16_t, WS_WTOUT)); }
    GRID_BAR_FIRST();
#pragma unroll 1
    for (int l = 0; l < DEPTH; ++l) {
        { Ctx C = make_ctx(lds); phase_norm(C, l == 0 ? PA(x) : (const float*)PA(out), PA(norm_g) + (size_t)(l * 3 + 0) * DM, MODL(l) + 0 * DM, MODL(l) + 1 * DM, WSP(f16_t, WS_HN)); }
        GRID_BAR();
        run_gemm(lds, WSP(f16_t, WS_HN), WSP(f16_t, WS_WT1) + (size_t)(l * 2 + 0) * 2 * FF * DM, 2 * FF, DM, pg8::EpiSwiglu{WSP(f16_t, WS_ACT)});
        GRID_BAR();
        run_gemm(lds, WSP(f16_t, WS_ACT), WSP(f16_t, WS_WT2) + (size_t)(l * 2 + 0) * DM * FF, DM, FF, pg8::EpiResidual{l == 0 ? PA(x) : (const float*)PA(out), PA(out), MODL(l) + 2 * DM, 9216, 0.5f});
        GRID_BAR();
        { Ctx C = make_ctx(lds); phase_norm(C, PA(out), PA(norm_g) + (size_t)(l * 3 + 1) * DM, MODL(l) + 3 * DM, MODL(l) + 4 * DM, WSP(f16_t, WS_HN)); }
        GRID_BAR();
        run_gemm(lds, WSP(f16_t, WS_HN), WSP(f16_t, WS_WTIN) + (size_t)l * NINP * DM, NINP, DM,
                 pg8::EpiInProj{WSP(f16_t, WS_C16), WSP(f16_t, WS_Z16), WSP(float, WS_AB32), WSP(float, WS_QN32), WSP(float, WS_KC32), WSP(f16_t, WS_KV16), WSP(float, WS_GR32)});
        GRID_BAR();
        { Ctx C = make_ctx(lds); phase_gdn_prep(C, WSP(f16_t, WS_C16), PA(conv_w) + (size_t)l * 4 * 1536, WSP(float, WS_AB32), PA(a_log) + l * 4, PA(dt_bias) + l * 4,
                                                WSP(f16_t, WS_GQ), WSP(f16_t, WS_GK), WSP(f16_t, WS_GV), WSP(float, WS_GG), WSP(float, WS_GB)); }
        { Ctx C = make_ctx(lds); phase_rope(C, PA(positions), WSP(float, WS_QN32), WSP(float, WS_KC32), WSP(f16_t, WS_KV16)); }
        GRID_BAR();
        { Ctx C = make_ctx(lds); phase_compress(C, WSP(float, WS_KC32), WSP(f16_t, WS_KV16), PA(pe_k) + (size_t)l * 2048, PA(w1_k) + (size_t)l * 2048 * 128, PA(w2_k) + (size_t)l * 128 * 64,
                                                PA(pe_v) + (size_t)l * 2048, PA(w1_v) + (size_t)l * 2048 * 128, PA(w2_v) + (size_t)l * 128 * 64, WSP(float, WS_KCMP), WSP(float, WS_VCMP)); }
        { Ctx C = make_ctx(lds); phase_gdn_chunk(C, WSP(f16_t, WS_GQ), WSP(f16_t, WS_GK), WSP(f16_t, WS_GV), WSP(float, WS_GG), WSP(float, WS_GB), WSP(f16_t, WS_UIMG), WSP(f16_t, WS_ATT), WSP(float, WS_DL)); }
        GRID_BAR();
        { Ctx C = make_ctx(lds); if (C.bid < NB * GH) phase_gdn_scan(C, C.bid, WSP(f16_t, WS_GQ), WSP(f16_t, WS_GK), WSP(f16_t, WS_GV), WSP(f16_t, WS_UIMG), WSP(f16_t, WS_ATT), WSP(float, WS_DL),
                                                                          WSP(f16_t, WS_Z16), PA(gdn_ng) + l * GD, WSP(f16_t, WS_HN));
          else phase_cmpattn(C, NB * GH, WSP(float, WS_QN32), WSP(float, WS_KCMP), WSP(float, WS_VCMP), WSP(float, WS_GR32), WSP(float, WS_OACC), WSP(unsigned long long, WS_SEL)); }
        GRID_BAR();
        { Ctx C = make_ctx(lds); phase_selwin(C, WSP(float, WS_QN32), WSP(f16_t, WS_KV16), WSP(float, WS_GR32), WSP(float, WS_OACC), WSP(unsigned long long, WS_SEL), PA(nsa_ng) + l * HD, WSP(f16_t, WS_HN)); }
        GRID_BAR();
        run_gemm(lds, WSP(f16_t, WS_HN), WSP(f16_t, WS_WTOUT) + (size_t)l * DM * DM, DM, DM, pg8::EpiResidual{PA(out), PA(out), MODL(l) + 5 * DM, 9216, 1.0f});
        GRID_BAR();
        { Ctx C = make_ctx(lds); phase_norm(C, PA(out), PA(norm_g) + (size_t)(l * 3 + 2) * DM, MODL(l) + 6 * DM, MODL(l) + 7 * DM, WSP(f16_t, WS_HN)); }
        GRID_BAR();
        run_gemm(lds, WSP(f16_t, WS_HN), WSP(f16_t, WS_WT1) + (size_t)(l * 2 + 1) * 2 * FF * DM, 2 * FF, DM, pg8::EpiSwiglu{WSP(f16_t, WS_ACT)});
        GRID_BAR();
        run_gemm(lds, WSP(f16_t, WS_ACT), WSP(f16_t, WS_WT2) + (size_t)(l * 2 + 1) * DM * FF, DM, FF, pg8::EpiResidual{PA(out), PA(out), MODL(l) + 8 * DM, 9216, 0.5f});
        GRID_BAR();
    }
    { Ctx C = make_ctx(lds); phase_final_norm(C, PA(out), PA(final_g)); }
}

extern "C" void kernel_launch(void* const* d_in, const int* in_sizes, int n_in, void* d_out, int out_size, void* d_ws, size_t ws_size, hipStream_t stream) {
    static int grid = 0;
    if (grid == 0) {
        if (n_in != 22 || out_size != MR * DM || ws_size < WS_END) { fprintf(stderr, "kernel_launch: unexpected shapes (n_in %d out %d ws %zu)\n", n_in, out_size, ws_size); grid = -1; return; }
        int dev = 0, cus = 0, per_cu = 0;
        if (hipGetDevice(&dev) != hipSuccess || hipDeviceGetAttribute(&cus, hipDeviceAttributeMultiprocessorCount, dev) != hipSuccess) { grid = -1; return; }
        if (hipFuncSetAttribute((const void*)mega_fwd, hipFuncAttributeMaxDynamicSharedMemorySize, LDS_BYTES) != hipSuccess) { fprintf(stderr, "kernel_launch: hipFuncSetAttribute failed\n"); grid = -1; return; }
        if (hipOccupancyMaxActiveBlocksPerMultiprocessor(&per_cu, (const void*)mega_fwd, NTHR, LDS_BYTES) != hipSuccess || per_cu < 1) { fprintf(stderr, "kernel_launch: occupancy query says %d\n", per_cu); (void)hipGetLastError(); grid = -1; return; }
        grid = cus;
    }
    if (grid < 0) return;
    (void)hipMemsetAsync((char*)d_ws + WS_CTL, 0, CTL_ZERO_BYTES, stream);
    Params p{};
    p.x = (const float*)d_in[0]; p.c = (const float*)d_in[1]; p.positions = (const int*)d_in[2]; p.ada_w = (const float*)d_in[3]; p.ada_b = (const float*)d_in[4];
    p.norm_g = (const float*)d_in[5]; p.ffn_w_in = (const float*)d_in[6]; p.ffn_w_out = (const float*)d_in[7]; p.mix_w_in = (const float*)d_in[8]; p.conv_w = (const float*)d_in[9];
    p.a_log = (const float*)d_in[10]; p.dt_bias = (const float*)d_in[11]; p.gdn_ng = (const float*)d_in[12]; p.pe_k = (const float*)d_in[13]; p.w1_k = (const float*)d_in[14];
    p.w2_k = (const float*)d_in[15]; p.pe_v = (const float*)d_in[16]; p.w1_v = (const float*)d_in[17]; p.w2_v = (const float*)d_in[18]; p.nsa_ng = (const float*)d_in[19];
    p.mix_w_out = (const float*)d_in[20]; p.final_g = (const float*)d_in[21]; p.out = (float*)d_out; p.ws = (unsigned char*)d_ws;
    hipLaunchKernelGGL(mega_fwd, dim3(grid), dim3(NTHR), LDS_BYTES, stream, p);
}
```

```cpp
#include <hip/hip_runtime.h>
#include <cstdio>
#include <cstdint>

constexpr int NB = 4, NT = 4096, DM = 1024, MR = NB * NT, FF = 2816, NIN = 3360, NINP = 3584, DEPTH = 2;
constexpr int GH = 4, GD = 128, GW = 512;
constexpr int NH = 8, NG = 2, HD = 64;
constexpr int NCMP = 255, NBLK = 64, NSEL = 16, WIN = 512;
constexpr float EPS = 1e-6f;
constexpr size_t MiB = 1u << 20;
constexpr size_t WS_CTL = 0, WS_MOD = 1 * MiB, WS_WT1 = 4 * MiB, WS_WT2 = 48 * MiB, WS_WTIN = 70 * MiB, WS_WTOUT = 84 * MiB, WS_W1C = 88 * MiB,
                 WS_HN = 90 * MiB, WS_ACT = 122 * MiB, WS_C16 = 122 * MiB, WS_UIMG = 122 * MiB, WS_ATT = 138 * MiB, WS_DL = 146 * MiB, WS_Z16 = 170 * MiB, WS_KV16 = 186 * MiB,
                 WS_QN32 = 210 * MiB, WS_KC32 = 242 * MiB, WS_AB32 = 250 * MiB, WS_GR32 = 251 * MiB, WS_GQ = 253 * MiB, WS_GK = 269 * MiB, WS_GV = 285 * MiB,
                 WS_GG = 301 * MiB, WS_GB = 301 * MiB + 512 * 1024, WS_KCMP = 302 * MiB, WS_VCMP = 302 * MiB + 512 * 1024, WS_SEL = 303 * MiB, WS_OACC = 304 * MiB, WS_END = 336 * MiB,
                 WS_W2C = 2 * MiB, WS_C1 = 2 * MiB + 128 * 1024, WS_VST = 147 * MiB, WS_VWT = 151 * MiB, WS_KCMP16 = 302 * MiB, WS_VCMPT = 302 * MiB + 512 * 1024,
                 WS_Q16 = 304 * MiB, WS_KCR = 320 * MiB, WS_KSR = 324 * MiB, WS_KWR = 328 * MiB, WS_VC16 = 332 * MiB;
constexpr int CW_NSA = 8192;

typedef unsigned short f16_t;
typedef _Float16 h2_t __attribute__((ext_vector_type(2)));
typedef float f32x2_t __attribute__((ext_vector_type(2)));
typedef float f32x4_t __attribute__((ext_vector_type(4)));
typedef unsigned u32x4_t __attribute__((ext_vector_type(4)));
typedef unsigned u32x2_t __attribute__((ext_vector_type(2)));
__device__ __forceinline__ unsigned pkh(float lo, float hi) { f32x2_t v = {lo, hi}; h2_t h = __builtin_convertvector(v, h2_t); return __builtin_bit_cast(unsigned, h); }
__device__ __forceinline__ float h2f(f16_t u) { return (float)__builtin_bit_cast(_Float16, u); }
__device__ __forceinline__ f16_t f2h(float f) { return __builtin_bit_cast(f16_t, (_Float16)f); }
__device__ __forceinline__ float hlo(unsigned u) { return h2f((f16_t)(u & 0xffffu)); }
__device__ __forceinline__ float hhi(unsigned u) { return h2f((f16_t)(u >> 16)); }
__device__ __forceinline__ float siluf(float x) { return x / (1.f + __expf(-x)); }
__device__ __forceinline__ float sigmf(float x) { return 1.f / (1.f + __expf(-x)); }
__device__ __forceinline__ float wave_sum(float v) {
#pragma unroll
    for (int o = 1; o < 64; o <<= 1) v += __shfl_xor(v, o);
    return v;
}
__device__ __forceinline__ float wave_max(float v) {
#pragma unroll
    for (int o = 1; o < 64; o <<= 1) v = fmaxf(v, __shfl_xor(v, o));
    return v;
}

namespace pg8 {
#define PG8_LAS __attribute__((address_space(3)))
typedef unsigned short bf16_t;
typedef _Float16 bf16x8 __attribute__((ext_vector_type(8)));
typedef float f32x4 __attribute__((ext_vector_type(4)));
typedef unsigned u32x4 __attribute__((ext_vector_type(4)));
constexpr int BM = 256, BK = 64, HALF = 128, HTB = HALF * BK * 2  , STAGE_BYTES = 8 * HTB, NXCD = 8, WGM = 8;

__host__ __device__ __forceinline__ int lds_byte(int r, int c) { const int st = (r >> 4) * 2 + (c >> 5), rr = r & 15, cc = c & 31, ob = rr * 64 + cc * 2; return st * 1024 + (ob ^ (((ob >> 9) & 1) << 5)); }
__host__ __device__ __forceinline__ void stage_rc(int b, int& R, int& C) { const int st = b / 1024, sb = b % 1024, swz = sb ^ (((sb >> 9) & 1) << 5); R = (st >> 1) * 16 + swz / 64; C = (st & 1) * 32 + (swz % 64) / 2; }
__host__ __device__ __forceinline__ int perm32(int rho) { const int n = rho >> 4, i = rho & 15; return 8 * (i >> 2) + 4 * n + (i & 3); }

struct Unit { int pm, pn; };
struct Gemm { const bf16_t* A; const bf16_t* Bt; int M, N, K, pad; };

struct StaticOrder {
    int nM, nN, nwg, G, c;
    __host__ __device__ void init(int M, int N, int G_, int c_) { nM = M / BM; nN = N / BM; nwg = nM * nN; G = G_; c = c_; }
    __host__ __device__ bool next(int i, Unit& u) const {
        const long L = (long)i * G + c; if (L >= nwg) return false;
        int wgid = (int)L; { const int q = nwg / NXCD, r = nwg % NXCD, xcd = wgid % NXCD, off = wgid / NXCD; wgid = (xcd < r ? xcd * (q + 1) : r * (q + 1) + (xcd - r) * q) + off; }
        const int nig = WGM * nN, gid = wgid / nig, fm = gid * WGM, gsz = (nM - fm) < WGM ? (nM - fm) : WGM;
        u.pm = fm + ((wgid % nig) % gsz); u.pn = (wgid % nig) / gsz; return true;
    }
    __device__ __forceinline__ void a_ready(const Unit&) const {}
    __device__ __forceinline__ void done(const Unit&) const {}
};


template <class Epi, class Sched, bool ALIGN_EPI = false, bool SP2 = false>
__device__ __forceinline__ void gemm_phase(PG8_LAS unsigned char* lds, const Gemm g, const Sched& S, const Epi& E, int tid_) {
    asm volatile("" : "+v"(tid_));
    const int tid = tid_, wid = __builtin_amdgcn_readfirstlane(tid >> 6), lane = tid & 63, wr = wid >> 2, wc = wid & 3, fr = lane & 15, fq = lane >> 4;
    const int K = g.K, nt = K / BK;
    unsigned voffA[2], voffB[2];
#pragma unroll
    for (int i = 0; i < 2; ++i) { int R, C; stage_rc(tid * 16 + i * 8192, R, C); const int Rb = Epi::PERM ? ((R & ~31) + perm32(R & 31)) : R;
        voffA[i] = (unsigned)(R * K + C) * 2u; voffB[i] = (unsigned)(Rb * K + C) * 2u; }
    const size_t kstep = (size_t)(BK * 2);
    const size_t hstep = (size_t)HALF * K * 2;
    const size_t tstep = 2 * hstep;
    const unsigned ldsw = (unsigned)wid * 1024u;
    const int aoff = lds_byte(wr * 64 + fr, fq * 8), boff = lds_byte(wc * 32 + fr, fq * 8);
#define PG8_SA(b, h) (((b) * 2 + (h)) * HTB)
#define PG8_SB(b, h) ((4 + (b) * 2 + (h)) * HTB)
#define PG8_STAGE(bufoff, gbase, voff) do { _Pragma("unroll") for (int _i = 0; _i < 2; ++_i) \
        __builtin_amdgcn_global_load_lds((const unsigned*)((const char*)(gbase) + (voff)[_i]), (PG8_LAS unsigned*)(lds + (bufoff) + ldsw + _i * 8192), 16, 0, 0); } while (0)
#define PG8_LDA(dst, b, h) do { _Pragma("unroll") for (int m = 0; m < 4; ++m) _Pragma("unroll") for (int k = 0; k < 2; ++k) dst[m][k] = *(const PG8_LAS bf16x8*)(lds + PG8_SA(b, h) + aoff + m * 2048 + k * 1024); } while (0)
#define PG8_LDB(dst, b, h) do { _Pragma("unroll") for (int n = 0; n < 2; ++n) _Pragma("unroll") for (int k = 0; k < 2; ++k) dst[n][k] = *(const PG8_LAS bf16x8*)(lds + PG8_SB(b, h) + boff + n * 2048 + k * 1024); } while (0)
#define PG8_MMA(ai, bj, At, Bt) do { __builtin_amdgcn_s_setprio(1); _Pragma("unroll") for (int m = 0; m < 4; ++m) _Pragma("unroll") for (int n = 0; n < 2; ++n) _Pragma("unroll") for (int k = 0; k < 2; ++k) \
        acc[ai][bj][m][n] = __builtin_amdgcn_mfma_f32_16x16x32_f16(Bt[n][k], At[m][k], acc[ai][bj][m][n], 0, 0, 0); __builtin_amdgcn_s_setprio(0); } while (0)
#define PG8_WAIT_V(n) asm volatile("s_waitcnt vmcnt(" #n ")" ::: "memory")
#define PG8_WAIT_L(n) asm volatile("s_waitcnt lgkmcnt(" #n ")" ::: "memory")
#define PG8_BAR __builtin_amdgcn_s_barrier()
#define PG8_SCHED __builtin_amdgcn_sched_barrier(0)
    Unit cur, nxt; int ui = 0;
    if (!S.next(0, cur)) return;
    f32x4 acc[2][2][4][2];
#pragma unroll
    for (int a = 0; a < 2; ++a)
#pragma unroll
        for (int b = 0; b < 2; ++b)
#pragma unroll
            for (int m = 0; m < 4; ++m)
#pragma unroll
                for (int n = 0; n < 2; ++n) acc[a][b][m][n] = (f32x4){0.f, 0.f, 0.f, 0.f};
    bf16x8 At[4][2], B0[2][2], B1[2][2];
    const char* cA = (const char*)g.A + (size_t)cur.pm * tstep; const char* cB = (const char*)g.Bt + (size_t)cur.pn * tstep;
    S.a_ready(cur);
    if constexpr (SP2) {
        PG8_STAGE(PG8_SB(0, 0), cB, voffB); PG8_STAGE(PG8_SB(0, 1), cB + hstep, voffB); PG8_STAGE(PG8_SA(0, 0), cA, voffA); PG8_STAGE(PG8_SA(0, 1), cA + hstep, voffA);
        if (wr == 1) PG8_BAR;
        PG8_WAIT_V(2); PG8_BAR;
        PG8_STAGE(PG8_SB(1, 0), cB + kstep, voffB); PG8_STAGE(PG8_SA(1, 0), cA + kstep, voffA); PG8_STAGE(PG8_SB(1, 1), cB + hstep + kstep, voffB);
        PG8_WAIT_V(6); PG8_BAR;
    } else {
        PG8_STAGE(PG8_SB(0, 0), cB, voffB); PG8_STAGE(PG8_SA(0, 0), cA, voffA); PG8_STAGE(PG8_SB(0, 1), cB + hstep, voffB); PG8_STAGE(PG8_SA(0, 1), cA + hstep, voffA);
        if (wr == 1) PG8_BAR;
        PG8_WAIT_V(4); PG8_BAR;
        PG8_STAGE(PG8_SB(1, 0), cB + kstep, voffB); PG8_STAGE(PG8_SA(1, 0), cA + kstep, voffA); PG8_STAGE(PG8_SB(1, 1), cB + hstep + kstep, voffB);
        PG8_WAIT_V(6); PG8_BAR;
    }
    for (;;) {
        const bool has_next = S.next(ui + 1, nxt);
        const char* nA = has_next ? (const char*)g.A + (size_t)nxt.pm * tstep : cA; const char* nB = has_next ? (const char*)g.Bt + (size_t)nxt.pn * tstep : cB;
        for (int t = 0; t < nt; t += 2) {
            const bool last = (t == nt - 2);
            const char* a1 = cA + (size_t)(t + 1) * kstep;
            const char* a2 = last ? nA : cA + (size_t)(t + 2) * kstep; const char* b2 = last ? nB : cB + (size_t)(t + 2) * kstep;
            const char* a3 = a2 + kstep; const char* b3 = b2 + kstep;
            if (last && has_next) S.a_ready(nxt);
            if constexpr (SP2) {
            PG8_LDB(B0, 0, 0); PG8_LDB(B1, 0, 1); PG8_SCHED; PG8_LDA(At, 0, 0); PG8_STAGE(PG8_SA(1, 1), a1 + hstep, voffA);
            PG8_WAIT_V(8); PG8_WAIT_L(0); PG8_BAR; PG8_MMA(0, 0, At, B0); PG8_MMA(0, 1, At, B1); PG8_BAR; PG8_SCHED;
            PG8_LDA(At, 0, 1); PG8_STAGE(PG8_SB(0, 0), b2, voffB); PG8_STAGE(PG8_SB(0, 1), b2 + hstep, voffB); PG8_STAGE(PG8_SA(0, 0), a2, voffA);
            PG8_WAIT_V(8); PG8_WAIT_L(0); PG8_BAR; PG8_MMA(1, 0, At, B0); PG8_MMA(1, 1, At, B1); PG8_BAR; PG8_SCHED;
            PG8_LDB(B0, 1, 0); PG8_LDB(B1, 1, 1); PG8_SCHED; PG8_LDA(At, 1, 0); PG8_STAGE(PG8_SA(0, 1), a2 + hstep, voffA);
            PG8_WAIT_V(8); PG8_WAIT_L(0); PG8_BAR; PG8_MMA(0, 0, At, B0); PG8_MMA(0, 1, At, B1); PG8_BAR; PG8_SCHED;
            PG8_LDA(At, 1, 1); PG8_STAGE(PG8_SB(1, 0), b3, voffB); PG8_STAGE(PG8_SB(1, 1), b3 + hstep, voffB); PG8_STAGE(PG8_SA(1, 0), a3, voffA);
            PG8_WAIT_V(8); PG8_WAIT_L(0); PG8_BAR; PG8_MMA(1, 0, At, B0); PG8_MMA(1, 1, At, B1); PG8_BAR; PG8_SCHED;
            } else {
            PG8_LDB(B0, 0, 0); PG8_SCHED; PG8_LDA(At, 0, 0); PG8_STAGE(PG8_SA(1, 1), a1 + hstep, voffA);
            PG8_WAIT_L(8); PG8_BAR; PG8_WAIT_L(0); PG8_MMA(0, 0, At, B0); PG8_BAR; PG8_SCHED;
            PG8_LDB(B1, 0, 1); PG8_STAGE(PG8_SB(0, 0), b2, voffB);
            PG8_BAR; PG8_WAIT_L(0); PG8_MMA(0, 1, At, B1); PG8_BAR;
            PG8_LDA(At, 0, 1); PG8_STAGE(PG8_SA(0, 0), a2, voffA);
            PG8_BAR; PG8_WAIT_L(0); PG8_MMA(1, 0, At, B0); PG8_BAR; PG8_SCHED;
            PG8_STAGE(PG8_SB(0, 1), b2 + hstep, voffB);
            PG8_WAIT_V(6); PG8_BAR; PG8_MMA(1, 1, At, B1); PG8_BAR;
            PG8_LDB(B0, 1, 0); PG8_SCHED; PG8_LDA(At, 1, 0); PG8_STAGE(PG8_SA(0, 1), a2 + hstep, voffA);
            PG8_WAIT_L(8); PG8_BAR; PG8_WAIT_L(0); PG8_MMA(0, 0, At, B0); PG8_BAR; PG8_SCHED;
            PG8_LDB(B1, 1, 1); PG8_STAGE(PG8_SB(1, 0), b3, voffB);
            PG8_BAR; PG8_WAIT_L(0); PG8_MMA(0, 1, At, B1); PG8_BAR;
            PG8_LDA(At, 1, 1); PG8_STAGE(PG8_SA(1, 0), a3, voffA);
            PG8_BAR; PG8_WAIT_L(0); PG8_MMA(1, 0, At, B0); PG8_BAR; PG8_SCHED;
            PG8_STAGE(PG8_SB(1, 1), b3 + hstep, voffB);
            PG8_WAIT_V(6); PG8_BAR; PG8_MMA(1, 1, At, B1); PG8_BAR;
            }
        }
        if constexpr (ALIGN_EPI) { if (wr == 0) PG8_BAR; }
        if constexpr (!Epi::AFTER_DRAIN) { E(acc, cur, wr, wc, fr, fq); S.done(cur); }
        if (!has_next) break;
#pragma unroll
        for (int a = 0; a < 2; ++a)
#pragma unroll
            for (int b = 0; b < 2; ++b)
#pragma unroll
                for (int m = 0; m < 4; ++m)
#pragma unroll
                    for (int n = 0; n < 2; ++n) acc[a][b][m][n] = (f32x4){0.f, 0.f, 0.f, 0.f};
        cur = nxt; cA = nA; cB = nB; ++ui;
        if constexpr (ALIGN_EPI) { if (wr == 1) PG8_BAR; }
    }
    PG8_WAIT_V(0);
    if constexpr (!ALIGN_EPI) { if (wr == 0) PG8_BAR; }
    PG8_BAR;
    if constexpr (Epi::AFTER_DRAIN) { E.fused(acc, cur, wr, wc, fr, fq, lds, wid, lane); S.done(cur); }
#undef PG8_SA
#undef PG8_SB
#undef PG8_STAGE
#undef PG8_LDA
#undef PG8_LDB
#undef PG8_MMA
#undef PG8_WAIT_V
#undef PG8_WAIT_L
#undef PG8_BAR
#undef PG8_SCHED
}
}

namespace pg8 {
struct EpiSwiglu {
    static constexpr bool PERM = true, AFTER_DRAIN = false;
    f16_t* O;
    __device__ __forceinline__ void operator()(const f32x4 (&acc)[2][2][4][2], const Unit& u, int wr, int wc, int fr, int fq) const {
        const int row0 = u.pm * BM + wr * 64 + fr, col0 = u.pn * 128 + wc * 32 + 8 * fq;
#pragma unroll
        for (int ai = 0; ai < 2; ++ai)
#pragma unroll
            for (int m = 0; m < 4; ++m) {
                const f32x4 g0 = acc[ai][0][m][0], g1 = acc[ai][0][m][1], u0 = acc[ai][1][m][0], u1 = acc[ai][1][m][1];
                u32x4 w;
                w.x = pkh(siluf(g0[0]) * u0[0], siluf(g0[1]) * u0[1]); w.y = pkh(siluf(g0[2]) * u0[2], siluf(g0[3]) * u0[3]);
                w.z = pkh(siluf(g1[0]) * u1[0], siluf(g1[1]) * u1[1]); w.w = pkh(siluf(g1[2]) * u1[2], siluf(g1[3]) * u1[3]);
                *(u32x4*)(O + (size_t)(row0 + ai * HALF + m * 16) * FF + col0) = w;
            }
    }
};
struct EpiResidual {
    static constexpr bool PERM = false, AFTER_DRAIN = false;
    const float* base; float* out; const float* gate; int gstride; float coef;
    __device__ __forceinline__ void operator()(const f32x4 (&acc)[2][2][4][2], const Unit& u, int wr, int wc, int fr, int fq) const {
        const int row0 = u.pm * BM + wr * 64 + fr, col0 = u.pn * BM + wc * 32 + 4 * fq;
        const float* gp = gate + (size_t)(u.pm / (NT / BM)) * gstride + col0;
        f32x4 gv[2][2];
#pragma unroll
        for (int bj = 0; bj < 2; ++bj)
#pragma unroll
            for (int n = 0; n < 2; ++n) gv[bj][n] = *(const f32x4*)(gp + bj * HALF + n * 16) * coef;
#pragma unroll
        for (int ai = 0; ai < 2; ++ai)
#pragma unroll
            for (int m = 0; m < 4; ++m) { const size_t off = (size_t)(row0 + ai * HALF + m * 16) * DM + col0;
#pragma unroll
                for (int bj = 0; bj < 2; ++bj)
#pragma unroll
                    for (int n = 0; n < 2; ++n) { const f32x4 bs = *(const f32x4*)(base + off + bj * HALF + n * 16);
                        *(f32x4*)(out + off + bj * HALF + n * 16) = bs + gv[bj][n] * acc[ai][bj][m][n]; } }
    }
};
struct EpiInProj {
    static constexpr bool PERM = true, AFTER_DRAIN = false;
    f16_t* C16; f16_t* Z16; float* AB32; float* QN32; float* KC32; f16_t* KV16; float* GR32;
    __device__ __forceinline__ void operator()(const f32x4 (&acc)[2][2][4][2], const Unit& u, int wr, int wc, int fr, int fq) const {
        const int row0 = u.pm * BM + wr * 64 + fr;
#pragma unroll
        for (int bj = 0; bj < 2; ++bj) {
            const int c0 = u.pn * BM + bj * HALF + wc * 32 + 8 * fq;
            int kind; size_t ld; int cc; void* basep;
            if (c0 < 1536)      { kind = 0; basep = C16;  ld = 1536; cc = c0; }
            else if (c0 < 2048) { kind = 0; basep = Z16;  ld = 512;  cc = c0 - 1536; }
            else if (c0 < 2056) { kind = 1; basep = AB32; ld = 8;    cc = 0; }
            else if (c0 < 2568) { kind = 1; basep = QN32; ld = 512;  cc = c0 - 2056; }
            else if (c0 < 2696) { kind = 1; basep = KC32; ld = 128;  cc = c0 - 2568; }
            else if (c0 < 3336) { kind = 0; basep = KV16; ld = 640;  cc = c0 - 2696; }
            else if (c0 < 3360) { kind = 1; basep = GR32; ld = 24;   cc = c0 - 3336; }
            else continue;
#pragma unroll
            for (int ai = 0; ai < 2; ++ai)
#pragma unroll
                for (int m = 0; m < 4; ++m) {
                    const size_t row = (size_t)(row0 + ai * HALF + m * 16);
                    const f32x4 v0 = acc[ai][bj][m][0], v1 = acc[ai][bj][m][1];
                    if (kind == 0) { u32x4 w; w.x = pkh(v0[0], v0[1]); w.y = pkh(v0[2], v0[3]); w.z = pkh(v1[0], v1[1]); w.w = pkh(v1[2], v1[3]);
                        *(u32x4*)((f16_t*)basep + row * ld + cc) = w; }
                    else { float* p = (float*)basep + row * ld + cc; *(f32x4*)p = v0; *(f32x4*)(p + 4) = v1; }
                }
        }
    }
};
}

#define GAS __attribute__((address_space(1)))
#define LAS __attribute__((address_space(3)))
typedef GAS unsigned gu32;
#define RLX_AGENT __ATOMIC_RELAXED, __HIP_MEMORY_SCOPE_AGENT
#define XB_TMO      128
#define XB_XCNT(j)  (256  + 64 * (j))
#define XB_XSUB(j)  (1280 + 64 * (j))
#define XB_XGEN(j)  (2304 + 64 * (j))
#define XB_TOP      3328
#define XB_TOPGEN   3392
#define XCD_BAR_WORDS 3456
#define XB_SPIN_CAP (1u << 18)

__device__ __forceinline__ unsigned xb_ld(unsigned* p)              { return __hip_atomic_load(p, __ATOMIC_RELAXED, __HIP_MEMORY_SCOPE_AGENT); }
__device__ __forceinline__ unsigned xb_add(unsigned* p, unsigned v) { return __hip_atomic_fetch_add(p, v, __ATOMIC_RELAXED, __HIP_MEMORY_SCOPE_AGENT); }
__device__ __forceinline__ unsigned xb_xcc_id() { return (unsigned)__builtin_amdgcn_s_getreg((3 << 11) | 20) & 0xFu; }
#define XB_SPIN(cond, bar) do { unsigned _sp = 0; while (cond) { __builtin_amdgcn_s_sleep(1); \
    if ((++_sp & 255u) == 0u) { if (xb_ld(&(bar)[XB_TMO])) break; if (_sp > XB_SPIN_CAP) { atomicAdd(&(bar)[XB_TMO], 1u); break; } } } } while (0)

struct XcdBarrier {
    unsigned* bar; unsigned x;
    volatile LAS unsigned* st;
};

__device__ __forceinline__ XcdBarrier xcd_barrier_post(unsigned* bar, volatile LAS unsigned* st) {
    XcdBarrier b; b.bar = bar; b.x = xb_xcc_id(); b.st = st;
    if (threadIdx.x == 0) (void)xb_add(&bar[XB_XCNT(b.x)], 1u);
    return b;
}
__device__ __forceinline__ void xcd_barrier_complete(unsigned* bar, unsigned x, unsigned& nloc, unsigned& nx) {
    const unsigned G = gridDim.x * gridDim.y * gridDim.z;
    unsigned sum, cnt, mine, sp = 0u;
    for (;;) {
        sum = 0u; cnt = 0u; mine = 0u;
#pragma unroll
        for (unsigned j = 0; j < 16; ++j) { const unsigned c = xb_ld(&bar[XB_XCNT(j)]); sum += c; cnt += (c > 0u) ? 1u : 0u; mine = (j == x) ? c : mine; }
        if (sum == G) break;
        __builtin_amdgcn_s_sleep(1);
        if ((++sp & 255u) == 0u) { if (xb_ld(&bar[XB_TMO])) break; if (sp > XB_SPIN_CAP) { atomicAdd(&bar[XB_TMO], 1u); break; } }
    }
    nloc = mine > 0u ? mine : 1u; nx = cnt > 0u ? cnt : 1u;
}

__device__ __forceinline__ void xcd_barrier(const XcdBarrier& b) {
    asm volatile("s_waitcnt vmcnt(0)" ::: "memory");
    __syncthreads();
    if (threadIdx.x == 0) {
        unsigned* bar = b.bar;
        __builtin_amdgcn_s_waitcnt(0);
        unsigned nloc = b.st[0], nx = b.st[1];
        if (nloc == 0u) { xcd_barrier_complete(bar, b.x, nloc, nx); b.st[0] = nloc; b.st[1] = nx; }
        const unsigned old = xb_add(&bar[XB_XSUB(b.x)], 1u);
        const unsigned gen = old / nloc;
        if (old + 1u == (gen + 1u) * nloc) {
            __builtin_amdgcn_fence(__ATOMIC_RELEASE, "agent");
            asm volatile("s_waitcnt vmcnt(0)" ::: "memory");
            const unsigned og = xb_add(&bar[XB_TOP], 1u);
            const unsigned tg = og / nx;
            if (og + 1u == (tg + 1u) * nx) xb_add(&bar[XB_TOPGEN], 1u);
            else XB_SPIN(xb_ld(&bar[XB_TOPGEN]) == tg, bar);
            __builtin_amdgcn_fence(__ATOMIC_ACQUIRE, "agent");
            xb_add(&bar[XB_XGEN(b.x)], 1u);
            asm volatile("s_waitcnt vmcnt(0)" ::: "memory");
        } else {
            XB_SPIN(xb_ld(&bar[XB_XGEN(b.x)]) == gen, bar);
            __builtin_amdgcn_fence(__ATOMIC_ACQUIRE, "agent");
            asm volatile("s_waitcnt vmcnt(0)" ::: "memory");
        }
    }
    __syncthreads();
}

__device__ __forceinline__ void xcd_barrier_fast(const XcdBarrier& b) {
    asm volatile("s_waitcnt vmcnt(0)" ::: "memory");
    __syncthreads();
    if (threadIdx.x == 0) {
        unsigned* bar = b.bar;
        __builtin_amdgcn_s_waitcnt(0);
        unsigned nloc = b.st[0], nx = b.st[1];
        const unsigned old = xb_add(&bar[XB_XSUB(b.x)], 1u);
        const unsigned gen = old / nloc;
        if (old + 1u == (gen + 1u) * nloc) {
            __builtin_amdgcn_fence(__ATOMIC_RELEASE, "agent");
            asm volatile("s_waitcnt vmcnt(0)" ::: "memory");
            const unsigned og = xb_add(&bar[XB_TOP], 1u);
            const unsigned tg = og / nx;
            if (og + 1u == (tg + 1u) * nx) xb_add(&bar[XB_TOPGEN], 1u);
            else XB_SPIN(xb_ld(&bar[XB_TOPGEN]) == tg, bar);
            __builtin_amdgcn_fence(__ATOMIC_ACQUIRE, "agent");
            xb_add(&bar[XB_XGEN(b.x)], 1u);
            asm volatile("s_waitcnt vmcnt(0)" ::: "memory");
        } else {
            XB_SPIN(xb_ld(&bar[XB_XGEN(b.x)]) == gen, bar);
            __builtin_amdgcn_fence(__ATOMIC_ACQUIRE, "agent");
            asm volatile("s_waitcnt vmcnt(0)" ::: "memory");
        }
    }
    __syncthreads();
}

constexpr int NWAVES = 8, NTHR = 512;
constexpr int RING_BYTES = 131072, LDSCTL_OFF = RING_BYTES, LDS_BYTES = 147456;
constexpr int CW_BAR = 4096;
constexpr size_t CTL_ZERO_BYTES = 64 * 1024;

struct Params {
    const float *x, *c; const int* positions; const float *ada_w, *ada_b, *norm_g, *ffn_w_in, *ffn_w_out, *mix_w_in, *conv_w, *a_log, *dt_bias, *gdn_ng,
                *pe_k, *w1_k, *w2_k, *pe_v, *w1_v, *w2_v, *nsa_ng, *mix_w_out, *final_g;
    float* out; unsigned char* ws;
};
struct Ctx { LAS unsigned char* lds; int tid, lane, wave, bid, G, gw, NGW; };
__device__ __forceinline__ const __attribute__((address_space(4))) Params* kargs() {
    const __attribute__((address_space(4))) Params* q = (const __attribute__((address_space(4))) Params*)__builtin_amdgcn_kernarg_segment_ptr();
    asm volatile("" : "+s"(q)); return q;
}
#define PA(f) (kargs()->f)
#define WSP(T, off) ((T*)(PA(ws) + (off)))

__device__ __forceinline__ void phase_mod(const Ctx& C, const float* c, const float* ada_w, const float* ada_b, float* mod) {
    LAS float* cond = (LAS float*)C.lds; LAS float* part = (LAS float*)(C.lds + 16384);
    for (int i = C.tid; i < NB * DM; i += NTHR) cond[i] = siluf(c[i]);
    __syncthreads();
    for (int item = C.bid; item < 2 * 9216 / 64; item += C.G) {
        const int col = item * 64 + C.lane, l = col / 9216, j = col % 9216;
        const float* w = ada_w + (size_t)l * DM * 9216 + j; const int k0 = C.wave * 128;
        float a0 = 0.f, a1 = 0.f, a2 = 0.f, a3 = 0.f;
#pragma unroll 8
        for (int k = k0; k < k0 + 128; ++k) { const float wv = w[(size_t)k * 9216]; a0 += cond[k] * wv; a1 += cond[DM + k] * wv; a2 += cond[2 * DM + k] * wv; a3 += cond[3 * DM + k] * wv; }
        part[(C.wave * 4 + 0) * 64 + C.lane] = a0; part[(C.wave * 4 + 1) * 64 + C.lane] = a1; part[(C.wave * 4 + 2) * 64 + C.lane] = a2; part[(C.wave * 4 + 3) * 64 + C.lane] = a3;
        __syncthreads();
        if (C.wave < 4) { float s = ada_b[l * 9216 + j];
#pragma unroll
            for (int w8 = 0; w8 < 8; ++w8) s += part[(w8 * 4 + C.wave) * 64 + C.lane];
            mod[((size_t)l * NB + C.wave) * 9216 + j] = s; }
        __syncthreads();
    }
}
__device__ __forceinline__ void wconv_item(const float* W, int K, int N, f16_t* WT, int k0, int n0, int r0, LAS float* scr, int lane) {
#pragma unroll 8
    for (int i = 0; i < 32; ++i) { const int kk = 2 * i + (lane >> 5); scr[kk * 33 + (lane & 31)] = W[(size_t)(k0 + kk) * N + n0 + (lane & 31)]; }
    __builtin_amdgcn_wave_barrier();
    const int c = lane & 7;
#pragma unroll
    for (int j = 0; j < 4; ++j) { const int n = (lane >> 3) + 8 * j; const LAS float* s = scr + (8 * c) * 33 + n;
        u32x4_t o; o.x = pkh(s[0 * 33], s[1 * 33]); o.y = pkh(s[2 * 33], s[3 * 33]); o.z = pkh(s[4 * 33], s[5 * 33]); o.w = pkh(s[6 * 33], s[7 * 33]);
        *(u32x4_t*)(WT + (size_t)(r0 + n) * K + k0 + 8 * c) = o; }
    __builtin_amdgcn_wave_barrier();
}
__device__ __forceinline__ void phase_wconv(const Ctx& C, f16_t* WT1, f16_t* WT2, f16_t* WTIN, f16_t* WTOUT) {
    LAS float* scr = (LAS float*)(C.lds + 32768) + C.wave * (64 * 33);
    constexpr int I1 = 16 * 176, I2 = 44 * 32, I3 = 16 * 105, I4 = 16 * 32, T1 = 4 * I1, T2 = 4 * I2, T3 = 2 * I3, T4 = 2 * I4;
    for (int it = C.gw; it < T1 + T2 + T3 + T4; it += C.NGW) {
        int r = it;
        if (r < T1) { const int mi = r / I1, q = r % I1, kb = q / 176, nb = q % 176, n0 = 32 * nb, half = n0 / FF, jj = n0 % FF;
            wconv_item(PA(ffn_w_in) + (size_t)mi * DM * 2 * FF, DM, 2 * FF, WT1 + (size_t)mi * 2 * FF * DM, 64 * kb, n0, 256 * (jj / 128) + 128 * half + (jj % 128), scr, C.lane); continue; }
        r -= T1;
        if (r < T2) { const int mi = r / I2, q = r % I2, kb = q / 32, nb = q % 32;
            wconv_item(PA(ffn_w_out) + (size_t)mi * FF * DM, FF, DM, WT2 + (size_t)mi * DM * FF, 64 * kb, 32 * nb, 32 * nb, scr, C.lane); continue; }
        r -= T2;
        if (r < T3) { const int mi = r / I3, q = r % I3, kb = q / 105, nb = q % 105;
            wconv_item(PA(mix_w_in) + (size_t)mi * DM * NIN, DM, NIN, WTIN + (size_t)mi * NINP * DM, 64 * kb, 32 * nb, 32 * nb, scr, C.lane); continue; }
        r -= T3;
        { const int mi = r / I4, q = r % I4, kb = q / 32, nb = q % 32;
            wconv_item(PA(mix_w_out) + (size_t)mi * DM * DM, DM, DM, WTOUT + (size_t)mi * DM * DM, 64 * kb, 32 * nb, 32 * nb, scr, C.lane); }
    }
    constexpr int PADV = (NINP - NIN) * DM * 2 / 16;
    for (int i = C.bid * NTHR + C.tid; i < 2 * PADV; i += C.G * NTHR) { const int l = i / PADV, q = i % PADV;
        ((u32x4_t*)(WTIN + ((size_t)l * NINP + NIN) * DM))[q] = (u32x4_t){0u, 0u, 0u, 0u}; }
}
__device__ __forceinline__ void phase_norm(const Ctx& C, const float* x, const float* g, const float* shift, const float* scale, f16_t* hn) {
    for (int m = C.gw; m < MR; m += C.NGW) {
        const int b = m / NT; const f32x4_t* xr = (const f32x4_t*)(x + (size_t)m * DM) + C.lane;
        f32x4_t v[4]; float s = 0.f;
#pragma unroll
        for (int j = 0; j < 4; ++j) { v[j] = xr[64 * j]; s += v[j].x * v[j].x + v[j].y * v[j].y + v[j].z * v[j].z + v[j].w * v[j].w; }
        const float rstd = rsqrtf(wave_sum(s) * (1.f / DM) + EPS);
        u32x2_t* o = (u32x2_t*)(hn + (size_t)m * DM) + C.lane;
#pragma unroll
        for (int j = 0; j < 4; ++j) {
            const f32x4_t gg = ((const f32x4_t*)g)[C.lane + 64 * j], sh = ((const f32x4_t*)(shift + (size_t)b * 9216))[C.lane + 64 * j], sc = ((const f32x4_t*)(scale + (size_t)b * 9216))[C.lane + 64 * j];
            const f32x4_t h = v[j] * rstd * gg * (sc + 1.f) + sh;
            u32x2_t w; w.x = pkh(h.x, h.y); w.y = pkh(h.z, h.w); o[64 * j] = w;
        }
    }
}
__device__ __forceinline__ void phase_final_norm(const Ctx& C, float* x, const float* g) {
    for (int m = C.gw; m < MR; m += C.NGW) {
        f32x4_t* xr = (f32x4_t*)(x + (size_t)m * DM) + C.lane;
        f32x4_t v[4]; float s = 0.f;
#pragma unroll
        for (int j = 0; j < 4; ++j) { v[j] = xr[64 * j]; s += v[j].x * v[j].x + v[j].y * v[j].y + v[j].z * v[j].z + v[j].w * v[j].w; }
        const float rstd = rsqrtf(wave_sum(s) * (1.f / DM) + EPS);
#pragma unroll
        for (int j = 0; j < 4; ++j) xr[64 * j] = v[j] * rstd * ((const f32x4_t*)g)[C.lane + 64 * j];
    }
}
__device__ __forceinline__ void phase_gdn_prep(const Ctx& C, const f16_t* C16, const float* convw, const float* AB32, const float* a_log, const float* dt_bias,
                                               f16_t* GQ, f16_t* GK, f16_t* GV, float* Gg, float* Gb) {
    const int lane = C.lane;
    for (int wv = C.gw; wv < MR * 12; wv += C.NGW) {
        const int m = wv / 12, hs = wv % 12, b = m / NT, t = m % NT; const int c = hs * 128 + 2 * lane;
        float y0 = 0.f, y1 = 0.f;
#pragma unroll
        for (int i = 0; i < 4; ++i) { const int tt = t - 3 + i; if (tt >= 0) { const unsigned xv = *(const unsigned*)(C16 + (size_t)(m - 3 + i) * 1536 + c);
                y0 += hlo(xv) * convw[i * 1536 + c]; y1 += hhi(xv) * convw[i * 1536 + c + 1]; } }
        y0 = siluf(y0); y1 = siluf(y1);
        const int which = hs >> 2, h = hs & 3;
        if (which < 2) { const float ss = wave_sum(y0 * y0 + y1 * y1); float r = rsqrtf(ss + EPS); if (which == 0) r *= 0.08838834764831845f; y0 *= r; y1 *= r; }
        f16_t* dst = (which == 0 ? GQ : which == 1 ? GK : GV) + ((size_t)(b * GH + h) * NT + t) * GD + 2 * lane;
        *(unsigned*)dst = pkh(y0, y1);
        if (hs == 8 && lane < 4) {
            const float braw = AB32[(size_t)m * 8 + lane], araw = AB32[(size_t)m * 8 + 4 + lane];
            const float xx = araw + dt_bias[lane]; const float sp = (xx > 20.f) ? xx : log1pf(__expf(xx));
            Gg[(size_t)(b * GH + lane) * NT + t] = -__expf(a_log[lane]) * sp;
            Gb[(size_t)(b * GH + lane) * NT + t] = sigmf(braw);
        }
    }
}
__device__ __forceinline__ void phase_rope(const Ctx& C, const int* positions, float* QN32, float* KC32, f16_t* KV16) {
    for (int idx = C.bid * NTHR + C.tid; idx < MR * 14 * 8; idx += C.G * NTHR) {
        const int i = idx & 7, slot = (idx >> 3) % 14, m = idx / (14 * 8);
        const float pos = (float)positions[m];
        const float invf = powf(500000.0f, -(float)i * 0.125f);
        const float ang = pos * invf; const float cs = cosf(ang), sn = sinf(ang);
        if (slot < 10) { float* q = (slot < 8) ? (QN32 + (size_t)m * 512 + slot * 64) : (KC32 + (size_t)m * 128 + (slot - 8) * 64);
            const float x1 = q[i], x2 = q[i + 8]; q[i] = x1 * cs - x2 * sn; q[i + 8] = x2 * cs + x1 * sn; }
        else { f16_t* q = KV16 + (size_t)m * 640 + ((slot < 12) ? (128 + (slot - 10) * 64) : (384 + (slot - 12) * 64));
            const float x1 = h2f(q[i]), x2 = h2f(q[i + 8]); q[i] = f2h(x1 * cs - x2 * sn); q[i + 8] = f2h(x2 * cs + x1 * sn); }
    }
}
__device__ __forceinline__ void phase_compress(const Ctx& C, const float* KC32, const f16_t* KV16, const float* pe_k, const float* w1_k, const float* w2_k,
                                               const float* pe_v, const float* w1_v, const float* w2_v, float* KCMP, float* VCMP) {
    const int sub = C.tid >> 7, st = C.tid & 127;
    LAS float* blk = (LAS float*)C.lds + sub * 2304; LAS float* hid = blk + 2048;
    constexpr int NIT = 2 * NB * NCMP * NG;
    for (int base = C.bid * 4; base < NIT; base += C.G * 4) {
        int id = base + sub; const bool act = id < NIT; if (!act) id = 0;
        const int g = id % NG; id /= NG; const int n = id % NCMP; id /= NCMP; const int b = id % NB; const int which = id / NB;
        const float* pe = which ? pe_v : pe_k; const float* w1 = which ? w1_v : w1_k; const float* w2 = which ? w2_v : w2_k;
        for (int k = st; k < 2048; k += 128) { const int l = k >> 6, d = k & 63; const size_t m = (size_t)b * NT + 16 * n + l;
            const float v = which ? h2f(KV16[m * 640 + g * 64 + d]) : KC32[m * 128 + g * 64 + d]; blk[k] = v + pe[k]; }
        __syncthreads();
        float a = 0.f;
#pragma unroll 8
        for (int k = 0; k < 2048; ++k) a += blk[k] * w1[(size_t)k * 128 + st];
        hid[st] = siluf(a);
        __syncthreads();
        if (st < 64 && act) { float o = 0.f;
#pragma unroll 8
            for (int j = 0; j < 128; ++j) o += hid[j] * w2[j * 64 + st];
            (which ? VCMP : KCMP)[((size_t)(b * NG + g) * 256 + n) * 64 + st] = o; }
        __syncthreads();
    }
}
__device__ __forceinline__ void phase_cmpattn(const Ctx& C, int first, const float* QN32, const float* KCMP, const float* VCMP, const float* GR32, float* OACC, unsigned long long* SEL) {
    const int lane = C.lane;
    LAS float* qs = (LAS float*)C.lds + C.wave * 1408; LAS float* P = qs + 256; LAS float* imps = P + 1024;
    for (int id = C.gw - first * NWAVES; id < NB * NG * NT; id += C.NGW - first * NWAVES) {
        const int t = id % NT, g = (id / NT) % NG, b = id / (NT * NG); const size_t m = (size_t)b * NT + t;
#pragma unroll
        for (int r = 0; r < 4; ++r) qs[r * 64 + lane] = QN32[m * 512 + (g * 4 + r) * 64 + lane] * 0.125f;
        __builtin_amdgcn_wave_barrier();
        const int nvalid = (t >= 31) ? min((t - 31) / 16 + 1, NCMP) : 0;
        const float* kc = KCMP + (size_t)(b * NG + g) * 256 * 64; const float* vc = VCMP + (size_t)(b * NG + g) * 256 * 64;
        float s[4][4];
#pragma unroll
        for (int i = 0; i < 4; ++i) { const int n = lane + 64 * i;
            if (n < nvalid) { float a0 = 0.f, a1 = 0.f, a2 = 0.f, a3 = 0.f; const float* kp = kc + (size_t)n * 64;
                for (int d = 0; d < 64; ++d) { const float kv = kp[d]; a0 += qs[d] * kv; a1 += qs[64 + d] * kv; a2 += qs[128 + d] * kv; a3 += qs[192 + d] * kv; }
                s[0][i] = a0; s[1][i] = a1; s[2][i] = a2; s[3][i] = a3; }
            else { s[0][i] = s[1][i] = s[2][i] = s[3][i] = -INFINITY; } }
#pragma unroll
        for (int r = 0; r < 4; ++r) {
            float mx = fmaxf(fmaxf(s[r][0], s[r][1]), fmaxf(s[r][2], s[r][3])); mx = wave_max(mx);
            float e[4], sum = 0.f;
#pragma unroll
            for (int i = 0; i < 4; ++i) { e[i] = (lane + 64 * i < nvalid) ? __expf(s[r][i] - mx) : 0.f; sum += e[i]; }
            sum = wave_sum(sum); const float inv = 1.f / fmaxf(sum, 1e-30f);
#pragma unroll
            for (int i = 0; i < 4; ++i) P[r * 256 + lane + 64 * i] = e[i] * inv;
        }
        __builtin_amdgcn_wave_barrier();
        float o0 = 0.f, o1 = 0.f, o2 = 0.f, o3 = 0.f;
        for (int n = 0; n < nvalid; ++n) { const float v = vc[(size_t)n * 64 + lane]; o0 += P[n] * v; o1 += P[256 + n] * v; o2 += P[512 + n] * v; o3 += P[768 + n] * v; }
        { const float* gr = GR32 + m * 24 + (g * 4) * 3; float* oa = OACC + m * 512 + (g * 4) * 64 + lane;
          oa[0] = sigmf(gr[0]) * o0; oa[64] = sigmf(gr[3]) * o1; oa[128] = sigmf(gr[6]) * o2; oa[192] = sigmf(gr[9]) * o3; }
        float imp = 0.f; { const int n0 = max(4 * lane - 1, 0), n1 = min(4 * lane + 3, NCMP - 1);
            for (int n = n0; n <= n1; ++n) imp += P[n] + P[256 + n] + P[512 + n] + P[768 + n]; }
        const int cur = t >> 6; const bool valid = lane <= cur; const bool forced = (lane == 0) || (lane == cur) || (lane == cur - 1);
        const float val = forced ? INFINITY : (valid ? imp : -INFINITY);
        imps[lane] = val;
        __builtin_amdgcn_wave_barrier();
        int rank = 0;
        for (int j = 0; j < 64; ++j) { const float o = imps[j]; rank += (o > val || (o == val && j < lane)) ? 1 : 0; }
        const unsigned long long mask = __ballot((rank < NSEL) && valid);
        if (lane == 0) SEL[(size_t)(b * NG + g) * NT + t] = mask;
        __builtin_amdgcn_wave_barrier();
    }
}
__device__ __forceinline__ void attn_block(const f16_t* Kb, const f16_t* Vb, int pos0, int lo, int t, int lane, const LAS float* qs, LAS float* pl, float (&mx)[4], float (&ls)[4], float (&o)[4]) {
    const int pos = pos0 + lane; const bool ok = (pos <= t) && (pos >= lo);
    float s[4] = {-INFINITY, -INFINITY, -INFINITY, -INFINITY};
    if (ok) { const u32x4_t* kp = (const u32x4_t*)(Kb + (size_t)pos * 640); float a0 = 0.f, a1 = 0.f, a2 = 0.f, a3 = 0.f;
#pragma unroll
        for (int c8 = 0; c8 < 8; ++c8) { const u32x4_t kv = kp[c8]; const unsigned ku[4] = {kv.x, kv.y, kv.z, kv.w};
#pragma unroll
            for (int e = 0; e < 4; ++e) { const float k0 = hlo(ku[e]), k1 = hhi(ku[e]); const int d = c8 * 8 + e * 2;
                a0 += qs[d] * k0 + qs[d + 1] * k1; a1 += qs[64 + d] * k0 + qs[64 + d + 1] * k1; a2 += qs[128 + d] * k0 + qs[128 + d + 1] * k1; a3 += qs[192 + d] * k0 + qs[192 + d + 1] * k1; } }
        s[0] = a0; s[1] = a1; s[2] = a2; s[3] = a3; }
    float al[4];
#pragma unroll
    for (int r = 0; r < 4; ++r) { const float bm = wave_max(s[r]); const float mn = fmaxf(mx[r], bm);
        al[r] = (mn == -INFINITY) ? 1.f : __expf(mx[r] - mn); const float pp = ok ? __expf(s[r] - mn) : 0.f; mx[r] = mn;
        ls[r] = ls[r] * al[r] + wave_sum(pp); pl[r * 64 + lane] = pp; o[r] *= al[r]; }
    __builtin_amdgcn_wave_barrier();
    const int kmax = min(64, t - pos0 + 1);
    for (int k = 0; k < kmax; ++k) { const float v = h2f(Vb[(size_t)(pos0 + k) * 640 + lane]);
        o[0] += pl[k] * v; o[1] += pl[64 + k] * v; o[2] += pl[128 + k] * v; o[3] += pl[192 + k] * v; }
    __builtin_amdgcn_wave_barrier();
}
__device__ __forceinline__ void phase_selwin(const Ctx& C, const float* QN32, const f16_t* KV16, const float* GR32, const float* OACC, const unsigned long long* SEL, const float* ng, f16_t* Y) {
    const int lane = C.lane;
    LAS float* qs = (LAS float*)C.lds + C.wave * 512; LAS float* pl = qs + 256;
    for (int id = C.gw; id < NB * NG * NT; id += C.NGW) {
        const int t = id % NT, g = (id / NT) % NG, b = id / (NT * NG); const size_t m = (size_t)b * NT + t;
#pragma unroll
        for (int r = 0; r < 4; ++r) qs[r * 64 + lane] = QN32[m * 512 + (g * 4 + r) * 64 + lane] * 0.125f;
        __builtin_amdgcn_wave_barrier();
        const f16_t* base = KV16 + (size_t)b * NT * 640 + g * 64;
        const f16_t *Ks = base + 128, *Vs = base + 256, *Kw = base + 384, *Vw = base + 512;
        const unsigned long long mask = SEL[(size_t)(b * NG + g) * NT + t];
        float mx[4], ls[4], o[4], osel[4];
#pragma unroll
        for (int r = 0; r < 4; ++r) { mx[r] = -INFINITY; ls[r] = 0.f; o[r] = 0.f; }
        const int cur = t >> 6;
        for (int j = 0; j <= cur; ++j) if ((mask >> j) & 1ull) attn_block(Ks, Vs, 64 * j, 0, t, lane, qs, pl, mx, ls, o);
#pragma unroll
        for (int r = 0; r < 4; ++r) { osel[r] = o[r] / fmaxf(ls[r], 1e-30f); mx[r] = -INFINITY; ls[r] = 0.f; o[r] = 0.f; }
        const int lo = max(t - WIN + 1, 0);
        for (int j = lo >> 6; j <= cur; ++j) attn_block(Kw, Vw, 64 * j, lo, t, lane, qs, pl, mx, ls, o);
#pragma unroll
        for (int r = 0; r < 4; ++r) { const int hq = g * 4 + r; const float* gr = GR32 + m * 24 + hq * 3;
            float v = OACC[m * 512 + hq * 64 + lane] + sigmf(gr[1]) * osel[r] + sigmf(gr[2]) * (o[r] / fmaxf(ls[r], 1e-30f));
            const float ss = wave_sum(v * v); v = v * rsqrtf(ss * (1.f / 64.f) + EPS) * ng[lane];
            Y[m * DM + 512 + hq * 64 + lane] = f2h(v); }
        __builtin_amdgcn_wave_barrier();
    }
}
__device__ __forceinline__ void phase_scan_simple(const Ctx& C, const f16_t* GQ, const f16_t* GK, const f16_t* GV, const float* Gg, const float* Gb, float* OG) {
    if (C.wave != 0) return;
    LAS float* qs = (LAS float*)C.lds; LAS float* ks = qs + 32 * 128; LAS float* ab = ks + 32 * 128;
    const int lane = C.lane;
    for (int job = C.bid; job < NB * GH * 2; job += C.G) {
        const int bh = job >> 1, dv = (job & 1) * 64 + lane, b = bh / GH, h = bh % GH;
        float S[128];
#pragma unroll
        for (int i = 0; i < 128; ++i) S[i] = 0.f;
        const f16_t* q = GQ + (size_t)bh * NT * GD; const f16_t* k = GK + (size_t)bh * NT * GD; const f16_t* v = GV + (size_t)bh * NT * GD;
        for (int t0 = 0; t0 < NT; t0 += 32) {
            __builtin_amdgcn_wave_barrier();
            for (int i = lane; i < 32 * 64; i += 64) { const int tt = i >> 6, c = (i & 63) * 2; const unsigned qv = *(const unsigned*)(q + (size_t)(t0 + tt) * GD + c), kv = *(const unsigned*)(k + (size_t)(t0 + tt) * GD + c);
                qs[tt * 128 + c] = hlo(qv); qs[tt * 128 + c + 1] = hhi(qv); ks[tt * 128 + c] = hlo(kv); ks[tt * 128 + c + 1] = hhi(kv); }
            if (lane < 32) { ab[lane] = __expf(Gg[(size_t)bh * NT + t0 + lane]); ab[32 + lane] = Gb[(size_t)bh * NT + t0 + lane]; }
            __builtin_amdgcn_wave_barrier();
            for (int tt = 0; tt < 32; ++tt) {
                const float a = ab[tt], beta = ab[32 + tt]; const float vv = h2f(v[(size_t)(t0 + tt) * GD + dv]);
                float kS = 0.f;
#pragma unroll
                for (int i = 0; i < 128; ++i) kS += ks[tt * 128 + i] * S[i];
                const float vn = beta * (vv - a * kS);
                float oo = 0.f;
#pragma unroll
                for (int i = 0; i < 128; ++i) { S[i] = a * S[i] + ks[tt * 128 + i] * vn; oo += qs[tt * 128 + i] * S[i]; }
                OG[((size_t)b * NT + t0 + tt) * GW + h * GD + dv] = oo;
            }
        }
    }
}
__device__ __forceinline__ void phase_gdn_out(const Ctx& C, const float* OG, const f16_t* Z16, const float* ng, f16_t* Y) {
    const int lane = C.lane;
    for (int wv = C.gw; wv < MR * GH; wv += C.NGW) {
        const int m = wv >> 2, h = wv & 3;
        const f32x2_t o = *(const f32x2_t*)(OG + (size_t)m * GW + h * GD + 2 * lane);
        const float r = rsqrtf(wave_sum(o.x * o.x + o.y * o.y) * (1.f / GD) + EPS);
        const unsigned z = *(const unsigned*)(Z16 + (size_t)m * GW + h * GD + 2 * lane);
        *(unsigned*)(Y + (size_t)m * DM + h * GD + 2 * lane) = pkh(o.x * r * ng[2 * lane] * siluf(hlo(z)), o.y * r * ng[2 * lane + 1] * siluf(hhi(z)));
    }
}

typedef _Float16 h8_t __attribute__((ext_vector_type(8)));
typedef _Float16 h4_t __attribute__((ext_vector_type(4)));
typedef float f32x16_t __attribute__((ext_vector_type(16)));
__device__ __forceinline__ h8_t ldfrag_perm(const f16_t* p16, int h) {
    const h4_t a = *(const h4_t*)(p16 + 4 * h), b = *(const h4_t*)(p16 + 8 + 4 * h);
    return (h8_t){a[0], a[1], a[2], a[3], b[0], b[1], b[2], b[3]};
}
__device__ __forceinline__ h8_t acc2frag(const f32x16_t& x, int s) {
    u32x4_t w; w.x = pkh(x[8 * s + 0], x[8 * s + 1]); w.y = pkh(x[8 * s + 2], x[8 * s + 3]); w.z = pkh(x[8 * s + 4], x[8 * s + 5]); w.w = pkh(x[8 * s + 6], x[8 * s + 7]);
    return __builtin_bit_cast(h8_t, w);
}
__device__ __forceinline__ int crow16(int reg, int h) { return (reg & 3) + 8 * (reg >> 2) + 4 * h; }

__device__ __forceinline__ void phase_gdn_chunk(const Ctx& C, f16_t* GQ, f16_t* GK, f16_t* GV, const float* Gg, const float* Gb, f16_t* UIMG, f16_t* ATT, float* DL) {
    const int hb = C.tid >> 8, th = C.tid & 255, lane = C.lane, hw = C.wave & 3, r = lane & 31, h = lane >> 5;
    LAS unsigned char* base = C.lds + hb * 65536;
    LAS f16_t* Kt = (LAS f16_t*)base;
    LAS f16_t* Qt = (LAS f16_t*)(base + 17408);
    LAS float* Lm = (LAS float*)(base + 34816);
    LAS float* gcs = (LAS float*)(base + 51200);
    for (int u = C.bid * 2 + hb; u < NB * GH * 64; u += C.G * 2) {
        const int bh = u >> 6, n = u & 63; const size_t row0 = (size_t)bh * NT + 64 * n;
        if (hw == 0) {
            float g = Gg[row0 + lane];
#pragma unroll
            for (int o = 1; o < 64; o <<= 1) { const float t = __shfl_up(g, o); if (lane >= o) g += t; }
            const float glast = __shfl(g, 63);
            gcs[lane] = g; gcs[64 + lane] = __expf(g); gcs[128 + lane] = Gb[row0 + lane]; gcs[192 + lane] = __expf(glast - g);
            if (lane == 63) DL[u] = __expf(g);
        }
#pragma unroll
        for (int q = 0; q < 4; ++q) { const int idx = th + 256 * q, row = idx >> 4, ch = idx & 15;
            *(LAS u32x4_t*)(Kt + row * 136 + ch * 8) = *(const u32x4_t*)(GK + (row0 + row) * GD + ch * 8);
            *(LAS u32x4_t*)(Qt + row * 136 + ch * 8) = *(const u32x4_t*)(GQ + (row0 + row) * GD + ch * 8); }
        __syncthreads();
        { const int ti = hw >> 1, tj = hw & 1;
          f32x16_t kk = {}, qk = {};
          if (ti >= tj) {
#pragma unroll
              for (int s = 0; s < 8; ++s) {
                  const h8_t bk = *(const LAS h8_t*)(Kt + (32 * tj + r) * 136 + 16 * s + 8 * h);
                  const h8_t ak = *(const LAS h8_t*)(Kt + (32 * ti + r) * 136 + 16 * s + 8 * h);
                  const h8_t aq = *(const LAS h8_t*)(Qt + (32 * ti + r) * 136 + 16 * s + 8 * h);
                  kk = __builtin_amdgcn_mfma_f32_32x32x16_f16(ak, bk, kk, 0, 0, 0);
                  qk = __builtin_amdgcn_mfma_f32_32x32x16_f16(aq, bk, qk, 0, 0, 0);
              }
          }
          const int sidx = 32 * tj + r; const float gs = gcs[sidx];
          f16_t* att = ATT + (size_t)u * 4096;
#pragma unroll
          for (int reg = 0; reg < 16; ++reg) { const int c = 32 * ti + crow16(reg, h);
              const float dec = (sidx <= c) ? __expf(gcs[c] - gs) : 0.f;
              Lm[c * 64 + sidx] = (sidx < c) ? gcs[128 + c] * kk[reg] * dec : 0.f;
              att[c * 64 + sidx] = f2h(qk[reg] * dec); }
        }
        __syncthreads();
        float sol[64];
        { const bool isu = th < 128; const int col = th & 127;
#pragma unroll
          for (int c = 0; c < 64; ++c) { const float bc = gcs[128 + c];
              sol[c] = isu ? bc * h2f(GV[(row0 + c) * GD + col]) : bc * gcs[64 + c] * h2f(Kt[c * 136 + col]); }
#pragma unroll
          for (int c = 1; c < 64; ++c) { float a0 = 0.f, a1 = 0.f;
#pragma unroll
              for (int s4 = 0; s4 < (c + 3) / 4; ++s4) { const f32x4_t lv = *(const LAS f32x4_t*)(Lm + c * 64 + 4 * s4);
                  if (4 * s4 + 0 < c) a0 += lv.x * sol[4 * s4 + 0];
                  if (4 * s4 + 1 < c) a1 += lv.y * sol[4 * s4 + 1];
                  if (4 * s4 + 2 < c) a0 += lv.z * sol[4 * s4 + 2];
                  if (4 * s4 + 3 < c) a1 += lv.w * sol[4 * s4 + 3]; }
              sol[c] -= a0 + a1; }
        }
        __syncthreads();
        if (th < 128) {
            const int w = th >> 5, rr = th & 31; f16_t* up = UIMG + (size_t)u * 8192 + w * 2048;
#pragma unroll
            for (int tile = 0; tile < 2; ++tile)
#pragma unroll
                for (int hh = 0; hh < 2; ++hh) { u32x4_t o0, o1;
#define SOLV(reg) sol[32 * tile + ((reg) & 3) + 8 * ((reg) >> 2) + 4 * hh]
                    o0.x = pkh(SOLV(0), SOLV(1)); o0.y = pkh(SOLV(2), SOLV(3)); o0.z = pkh(SOLV(4), SOLV(5)); o0.w = pkh(SOLV(6), SOLV(7));
                    o1.x = pkh(SOLV(8), SOLV(9)); o1.y = pkh(SOLV(10), SOLV(11)); o1.z = pkh(SOLV(12), SOLV(13)); o1.w = pkh(SOLV(14), SOLV(15));
#undef SOLV
                    u32x4_t* dst = (u32x4_t*)(up + tile * 1024 + (rr + 32 * hh) * 16); dst[0] = o0; dst[1] = o1; }
        } else { const int col = th - 128;
#pragma unroll
            for (int c = 0; c < 64; ++c) GV[(row0 + c) * GD + col] = f2h(sol[c]); }
#pragma unroll
        for (int q = 0; q < 4; ++q) { const int idx = th + 256 * q, row = idx >> 4, ch = idx & 15; const float e = gcs[64 + row];
            const h8_t v = *(const LAS h8_t*)(Qt + row * 136 + ch * 8); u32x4_t o;
            o.x = pkh((float)v[0] * e, (float)v[1] * e); o.y = pkh((float)v[2] * e, (float)v[3] * e); o.z = pkh((float)v[4] * e, (float)v[5] * e); o.w = pkh((float)v[6] * e, (float)v[7] * e);
            *(u32x4_t*)(GQ + (row0 + row) * GD + ch * 8) = o; }
        { const int dk = th & 127, ch = th >> 7; f16_t* kd = GK + row0 * GD + dk * 64 + 32 * ch;
#pragma unroll
          for (int q = 0; q < 4; ++q) { float v[8];
#pragma unroll
              for (int e = 0; e < 8; ++e) { const int c = 32 * ch + 8 * q + e; v[e] = h2f(Kt[c * 136 + dk]) * gcs[192 + c]; }
              u32x4_t o; o.x = pkh(v[0], v[1]); o.y = pkh(v[2], v[3]); o.z = pkh(v[4], v[5]); o.w = pkh(v[6], v[7]);
              *(u32x4_t*)(kd + 8 * q) = o; } }
        __syncthreads();
    }
}

__device__ __forceinline__ void phase_gdn_scan(const Ctx& C, int bh, const f16_t* QG, const f16_t* KDT, const f16_t* W, const f16_t* UIMG, const f16_t* ATT, const float* DL,
                                               const f16_t* Z16, const float* ng, f16_t* Y) {
    const int lane = C.lane, r = lane & 31, h = lane >> 5, w = C.wave, b = bh / GH, hh = bh % GH;
    LAS float* Ot = (LAS float*)C.lds;
    f32x16_t S[4];
#pragma unroll
    for (int T = 0; T < 4; ++T) S[T] = (f32x16_t){};
#pragma unroll 1
    for (int n = 0; n < 64; ++n) {
        if (w < 4) {
            const size_t row0 = (size_t)bh * NT + 64 * n; const int u = bh * 64 + n;
            const f16_t* Wp = W + row0 * GD; const f16_t* Qp = QG + row0 * GD; const f16_t* Ap = ATT + (size_t)u * 4096; const f16_t* Kp = KDT + row0 * GD;
            h8_t sf[4][2];
#pragma unroll
            for (int T = 0; T < 4; ++T) { sf[T][0] = acc2frag(S[T], 0); sf[T][1] = acc2frag(S[T], 1); }
            f32x16_t ws[2], qs[2];
#pragma unroll
            for (int ct = 0; ct < 2; ++ct) { ws[ct] = (f32x16_t){}; qs[ct] = (f32x16_t){};
#pragma unroll
                for (int T = 0; T < 4; ++T)
#pragma unroll
                    for (int s = 0; s < 2; ++s) {
                        ws[ct] = __builtin_amdgcn_mfma_f32_32x32x16_f16(ldfrag_perm(Wp + (32 * ct + r) * GD + 32 * T + 16 * s, h), sf[T][s], ws[ct], 0, 0, 0);
                        qs[ct] = __builtin_amdgcn_mfma_f32_32x32x16_f16(ldfrag_perm(Qp + (32 * ct + r) * GD + 32 * T + 16 * s, h), sf[T][s], qs[ct], 0, 0, 0);
                    } }
            h8_t vf[2][2];
#pragma unroll
            for (int ct = 0; ct < 2; ++ct) { const h8_t* up = (const h8_t*)(UIMG + (size_t)u * 8192 + w * 2048 + ct * 1024 + lane * 16); const h8_t u0 = up[0], u1 = up[1];
                f32x16_t vn;
#pragma unroll
                for (int e = 0; e < 8; ++e) { vn[e] = (float)u0[e] - ws[ct][e]; vn[8 + e] = (float)u1[e] - ws[ct][8 + e]; }
                vf[ct][0] = acc2frag(vn, 0); vf[ct][1] = acc2frag(vn, 1); }
#pragma unroll
            for (int ct = 0; ct < 2; ++ct)
#pragma unroll
                for (int c2 = 0; c2 < 2; ++c2)
#pragma unroll
                    for (int s = 0; s < 2; ++s)
                        qs[ct] = __builtin_amdgcn_mfma_f32_32x32x16_f16(ldfrag_perm(Ap + (32 * ct + r) * 64 + 32 * c2 + 16 * s, h), vf[c2][s], qs[ct], 0, 0, 0);
#pragma unroll
            for (int ct = 0; ct < 2; ++ct)
#pragma unroll
                for (int reg = 0; reg < 16; ++reg) Ot[(32 * ct + crow16(reg, h)) * 132 + 32 * w + r] = qs[ct][reg];
            const float dl = DL[u];
#pragma unroll
            for (int T = 0; T < 4; ++T) { S[T] = S[T] * dl;
#pragma unroll
                for (int c2 = 0; c2 < 2; ++c2)
#pragma unroll
                    for (int s = 0; s < 2; ++s)
                        S[T] = __builtin_amdgcn_mfma_f32_32x32x16_f16(ldfrag_perm(Kp + (32 * T + r) * 64 + 32 * c2 + 16 * s, h), vf[c2][s], S[T], 0, 0, 0); }
        }
        __syncthreads();
#pragma unroll
        for (int i = 0; i < 8; ++i) { const int c = 8 * w + i; const size_t m = (size_t)b * NT + 64 * n + c;
            const f32x2_t o = *(const LAS f32x2_t*)(Ot + c * 132 + 2 * lane);
            const float rr = rsqrtf(wave_sum(o.x * o.x + o.y * o.y) * (1.f / GD) + EPS);
            const unsigned z = *(const unsigned*)(Z16 + m * GW + hh * GD + 2 * lane);
            *(unsigned*)(Y + m * DM + hh * GD + 2 * lane) = pkh(o.x * rr * ng[2 * lane] * siluf(hlo(z)), o.y * rr * ng[2 * lane + 1] * siluf(hhi(z))); }
        __syncthreads();
    }
}

constexpr float QSCALE = 0.125f * 1.4426950408889634f;
__device__ __forceinline__ void phase_nsa_prep(const Ctx& C, const int* positions, const float* QN32, const float* KC32, const f16_t* KV16,
                                               f16_t* Q16, f16_t* KCR, f16_t* KSR, f16_t* KWR, f16_t* VC16) {
    const int lane = C.lane;
    for (int m = C.gw; m < MR; m += C.NGW) {
        const int b = m / NT, t = m % NT;
        float cs = 1.f, sn = 0.f;
        { const int i = lane & 7; const float ang = (float)positions[m] * powf(500000.0f, -(float)i * 0.125f); cs = cosf(ang); sn = sinf(ang); }
        float cv[8], sv[8];
#pragma unroll
        for (int e = 0; e < 8; ++e) { cv[e] = __shfl(cs, e); sv[e] = __shfl(sn, e); }
        const int oct = lane & 7;
        { const f32x4_t* src = (const f32x4_t*)(QN32 + (size_t)m * 512 + lane * 8); const f32x4_t a = src[0], c4 = src[1];
          float v[8] = {a.x, a.y, a.z, a.w, c4.x, c4.y, c4.z, c4.w}, o[8];
#pragma unroll
          for (int e = 0; e < 8; ++e) { const float pv = __shfl_xor(v[e], 1); o[e] = (oct == 0) ? (v[e] * cv[e] - pv * sv[e]) : (oct == 1) ? (v[e] * cv[e] + pv * sv[e]) : v[e]; o[e] *= QSCALE; }
          u32x4_t w; w.x = pkh(o[0], o[1]); w.y = pkh(o[2], o[3]); w.z = pkh(o[4], o[5]); w.w = pkh(o[6], o[7]);
          *(u32x4_t*)(Q16 + (size_t)m * 512 + lane * 8) = w; }
        { const int seg = lane >> 4, g = (lane >> 3) & 1; float v[8];
          if (seg == 0) { const f32x4_t* src = (const f32x4_t*)(KC32 + (size_t)m * 128 + (lane & 15) * 8); const f32x4_t a = src[0], c4 = src[1];
              v[0] = a.x; v[1] = a.y; v[2] = a.z; v[3] = a.w; v[4] = c4.x; v[5] = c4.y; v[6] = c4.z; v[7] = c4.w; }
          else { const int coff = (seg == 1) ? 128 : (seg == 2) ? 384 : 0; const h8_t hv = *(const h8_t*)(KV16 + (size_t)m * 640 + coff + (lane & 15) * 8);
#pragma unroll
              for (int e = 0; e < 8; ++e) v[e] = (float)hv[e]; }
          float o[8];
#pragma unroll
          for (int e = 0; e < 8; ++e) { const float pv = __shfl_xor(v[e], 1); o[e] = (seg == 3) ? v[e] : (oct == 0) ? (v[e] * cv[e] - pv * sv[e]) : (oct == 1) ? (v[e] * cv[e] + pv * sv[e]) : v[e]; }
          u32x4_t w; w.x = pkh(o[0], o[1]); w.y = pkh(o[2], o[3]); w.z = pkh(o[4], o[5]); w.w = pkh(o[6], o[7]);
          f16_t* dst = (seg == 0 ? KCR : seg == 1 ? KSR : seg == 2 ? KWR : VC16) + ((size_t)(b * NG + g) * NT + t) * HD + oct * 8;
          *(u32x4_t*)dst = w; }
    }
}
__device__ __forceinline__ void phase_nsa_vtrans(const Ctx& C, const f16_t* KV16, f16_t* VST, f16_t* VWT) {
    const int lane = C.lane;
    for (int it = C.gw; it < NB * NG * (NT / 64) * 2; it += C.NGW) {
        const int which = it & 1, tile = (it >> 1) % (NT / 64), bg = (it >> 1) / (NT / 64), b = bg / NG, g = bg % NG;
        const f16_t* src = KV16 + ((size_t)b * NT + tile * 64 + lane) * 640 + (which ? 512 : 256) + g * 64;
        f16_t* dst = (which ? VWT : VST) + (size_t)bg * HD * NT + tile * 64 + lane;
#pragma unroll
        for (int c8 = 0; c8 < 8; ++c8) { const u32x4_t w = *(const u32x4_t*)(src + c8 * 8); const unsigned ws[4] = {w.x, w.y, w.z, w.w};
#pragma unroll
            for (int i = 0; i < 4; ++i) { dst[(size_t)(c8 * 8 + 2 * i) * NT] = (f16_t)(ws[i] & 0xffffu); dst[(size_t)(c8 * 8 + 2 * i + 1) * NT] = (f16_t)(ws[i] >> 16); } }
    }
}

__device__ __forceinline__ void phase_cmp_weights(const Ctx& C, f16_t* W1C, f16_t* W2C, float* C1) {
    LAS float* scr = (LAS float*)(C.lds + 32768) + C.wave * (64 * 33);
    constexpr int I1 = 32 * 4;
    for (int it = C.gw; it < 4 * I1; it += C.NGW) { const int mi = it / I1, q = it % I1, kb = q / 4, nb = q % 4, l = mi >> 1, w = mi & 1;
        wconv_item((w ? PA(w1_v) : PA(w1_k)) + (size_t)l * 2048 * 128, 2048, 128, W1C + (size_t)mi * 128 * 2048, 64 * kb, 32 * nb, 32 * nb, scr, C.lane); }
    for (int i = C.bid * NTHR + C.tid; i < 4 * 64 * 128; i += C.G * NTHR) { const int mi = i / 8192, d = (i % 8192) / 128, hd = i % 128, l = mi >> 1, w = mi & 1;
        W2C[i] = f2h(((w ? PA(w2_v) : PA(w2_k)) + (size_t)l * 128 * 64)[hd * 64 + d]); }
    for (int i = C.bid * NTHR + C.tid; i < 4 * 128; i += C.G * NTHR) { const int mi = i / 128, j = i % 128, l = mi >> 1, w = mi & 1;
        const float* pe = (w ? PA(pe_v) : PA(pe_k)) + (size_t)l * 2048; const float* w1 = (w ? PA(w1_v) : PA(w1_k)) + (size_t)l * 2048 * 128;
        float a = 0.f; for (int k = 0; k < 2048; ++k) a += pe[k] * w1[(size_t)k * 128 + j];
        C1[i] = a; }
}

__device__ __forceinline__ void phase_compress_mfma(const Ctx& C, int lastfirst, const f16_t* KCR, const f16_t* VC16, const f16_t* W1C, const f16_t* W2C, const float* C1, f16_t* KCMP16, f16_t* VCMPT) {
    const int lane = C.lane, r = lane & 31, h = lane >> 5;
    const int nw = C.NGW, myw = nw - 1 - C.gw;
    (void)lastfirst;
    for (int unit = myw; unit < 2 * NB * NG * 8; unit += nw) {
        const int rt = unit & 7, bg = (unit >> 3) % (NB * NG), which = unit / (8 * NB * NG);
        const f16_t* src = (which ? VC16 : KCR) + (size_t)bg * NT * HD + (size_t)(32 * rt + r) * 1024;
        const f16_t* w1 = W1C + (size_t)which * 128 * 2048;
        f32x16_t acc[4];
#pragma unroll
        for (int ht = 0; ht < 4; ++ht) acc[ht] = (f32x16_t){};
#pragma unroll 4
        for (int ks = 0; ks < 128; ++ks) {
            const h8_t bf = *(const h8_t*)(src + 16 * ks + 8 * h);
#pragma unroll
            for (int ht = 0; ht < 4; ++ht) acc[ht] = __builtin_amdgcn_mfma_f32_32x32x16_f16(*(const h8_t*)(w1 + (size_t)(32 * ht + r) * 2048 + 16 * ks + 8 * h), bf, acc[ht], 0, 0, 0);
        }
        h8_t hf[4][2];
#pragma unroll
        for (int ht = 0; ht < 4; ++ht) {
#pragma unroll
            for (int reg = 0; reg < 16; ++reg) acc[ht][reg] = siluf(acc[ht][reg] + C1[which * 128 + 32 * ht + crow16(reg, h)]);
            hf[ht][0] = acc2frag(acc[ht], 0); hf[ht][1] = acc2frag(acc[ht], 1); }
        const f16_t* w2 = W2C + (size_t)which * 64 * 128;
        f32x16_t o[2];
#pragma unroll
        for (int dt = 0; dt < 2; ++dt) { o[dt] = (f32x16_t){};
#pragma unroll
            for (int ht = 0; ht < 4; ++ht)
#pragma unroll
                for (int s = 0; s < 2; ++s) o[dt] = __builtin_amdgcn_mfma_f32_32x32x16_f16(ldfrag_perm(w2 + (32 * dt + r) * 128 + 32 * ht + 16 * s, h), hf[ht][s], o[dt], 0, 0, 0); }
        const int n = 32 * rt + r; const bool live = n < NCMP;
        if (which == 0) {
#pragma unroll
            for (int dt = 0; dt < 2; ++dt)
#pragma unroll
                for (int q = 0; q < 4; ++q) { u32x2_t w; w.x = live ? pkh(o[dt][4 * q], o[dt][4 * q + 1]) : 0u; w.y = live ? pkh(o[dt][4 * q + 2], o[dt][4 * q + 3]) : 0u;
                    *(u32x2_t*)(KCMP16 + ((size_t)bg * 256 + n) * HD + 32 * dt + 8 * q + 4 * h) = w; }
        } else {
#pragma unroll
            for (int dt = 0; dt < 2; ++dt)
#pragma unroll
                for (int reg = 0; reg < 16; ++reg) VCMPT[((size_t)bg * HD + 32 * dt + crow16(reg, h)) * 256 + n] = live ? f2h(o[dt][reg]) : (f16_t)0;
        }
    }
}

struct AttnState { f32x16_t o[2]; float m, l; };
template <int MODE> __device__ __forceinline__ void nsa_tile(AttnState& st, const f16_t* Kp, const f16_t* Vtp, int key0, const h8_t (&qf)[4], bool rowsel, int tlo, int thi, int r, int h) {
    f32x16_t p[2];
#pragma unroll
    for (int kt = 0; kt < 2; ++kt) { p[kt] = (f32x16_t){};
#pragma unroll
        for (int s = 0; s < 4; ++s) p[kt] = __builtin_amdgcn_mfma_f32_32x32x16_f16(*(const h8_t*)(Kp + (size_t)(key0 + 32 * kt + r) * HD + 16 * s + 8 * h), qf[s], p[kt], 0, 0, 0); }
    float tm = -INFINITY;
#pragma unroll
    for (int kt = 0; kt < 2; ++kt)
#pragma unroll
        for (int reg = 0; reg < 16; ++reg) {
            if (MODE != 0) { const int key = key0 + 32 * kt + crow16(reg, h); const bool ok = (MODE == 1) ? (rowsel && key <= thi) : (key >= tlo && key <= thi); if (!ok) p[kt][reg] = -INFINITY; }
            tm = fmaxf(tm, p[kt][reg]); }
    tm = fmaxf(tm, __shfl_xor(tm, 32));
    if (__any(tm > st.m + 8.f)) {
        const float mn = fmaxf(st.m, tm); const float al = (mn == -INFINITY) ? 1.f : exp2f(st.m - mn);
        st.o[0] = st.o[0] * al; st.o[1] = st.o[1] * al; st.l *= al; st.m = mn;
    }
    float ps = 0.f;
#pragma unroll
    for (int kt = 0; kt < 2; ++kt)
#pragma unroll
        for (int reg = 0; reg < 16; ++reg) { const float e = (p[kt][reg] == -INFINITY) ? 0.f : exp2f(p[kt][reg] - st.m); p[kt][reg] = e; ps += e; }
    st.l += ps;
#pragma unroll
    for (int kt = 0; kt < 2; ++kt)
#pragma unroll
        for (int s = 0; s < 2; ++s) { const h8_t pf = acc2frag(p[kt], s);
#pragma unroll
            for (int dt = 0; dt < 2; ++dt) st.o[dt] = __builtin_amdgcn_mfma_f32_32x32x16_f16(ldfrag_perm(Vtp + (size_t)(32 * dt + r) * NT + key0 + 32 * kt + 16 * s, h), pf, st.o[dt], 0, 0, 0); }
}

__device__ __forceinline__ void nsa_unit(int q, LAS float* wl, int lane, const f16_t* Q16, const f16_t* KCMP16, const f16_t* VCMPT, const f16_t* KSR, const f16_t* VST, const f16_t* KWR, const f16_t* VWT,
                                         const float* GR32, const float* ng, f16_t* Y) {
    asm volatile("" : "+v"(lane));
    const int r = lane & 31, h = lane >> 5, tau = r & 7, a = r >> 3;
    const int cur = 63 - (q >> 6), qq = q & 63, b = qq >> 4, g = (qq >> 3) & 1, t0 = 64 * cur + 8 * (qq & 7), bg = b * NG + g, tr = t0 + tau, hq = 4 * g + a;
    const size_t mrow = (size_t)b * NT + tr;
    LAS float* impL = wl; LAS unsigned* maskL = (LAS unsigned*)(wl + 512);
    h8_t qf[4];
#pragma unroll
    for (int s = 0; s < 4; ++s) qf[s] = *(const h8_t*)(Q16 + mrow * 512 + hq * HD + 16 * s + 8 * h);
    const float* gr = GR32 + mrow * 24 + hq * 3;
    const float g0 = sigmf(gr[0]), g1 = sigmf(gr[1]), g2 = sigmf(gr[2]);
    LAS float* finL = wl + 640 + lane * 33;
    {
        const int nvr = (tr >= 31) ? (tr - 31) / 16 + 1 : 0;
        const int nvmax = (t0 + 7 >= 31) ? (t0 + 7 - 31) / 16 + 1 : 0; const int ntl = (nvmax + 31) >> 5;
        const f16_t* kc = KCMP16 + (size_t)bg * 256 * HD; const f16_t* vt = VCMPT + (size_t)bg * HD * 256;
        float mx = -INFINITY, sum = 0.f;
#pragma unroll 1
        for (int nt = 0; nt < ntl; ++nt) { f32x16_t sc = (f32x16_t){};
#pragma unroll
            for (int s = 0; s < 4; ++s) sc = __builtin_amdgcn_mfma_f32_32x32x16_f16(*(const h8_t*)(kc + (size_t)(32 * nt + r) * HD + 16 * s + 8 * h), qf[s], sc, 0, 0, 0);
#pragma unroll
            for (int reg = 0; reg < 16; ++reg) if (32 * nt + crow16(reg, h) < nvr) mx = fmaxf(mx, sc[reg]); }
        mx = fmaxf(mx, __shfl_xor(mx, 32));
#pragma unroll 1
        for (int nt = 0; nt < ntl; ++nt) { f32x16_t sc = (f32x16_t){};
#pragma unroll
            for (int s = 0; s < 4; ++s) sc = __builtin_amdgcn_mfma_f32_32x32x16_f16(*(const h8_t*)(kc + (size_t)(32 * nt + r) * HD + 16 * s + 8 * h), qf[s], sc, 0, 0, 0);
#pragma unroll
            for (int reg = 0; reg < 16; ++reg) if (32 * nt + crow16(reg, h) < nvr) sum += exp2f(sc[reg] - mx); }
        sum += __shfl_xor(sum, 32);
        const float inv = 1.f / fmaxf(sum, 1e-30f);
        if (a == 0) {
#pragma unroll
            for (int gi = 0; gi < 32; ++gi) { const int j = 2 * gi + h; const bool valid = j <= cur, forced = (j == 0) || (j == cur) || (j == cur - 1);
                impL[tau * 64 + j] = forced ? INFINITY : (valid ? 0.f : -INFINITY); }
        }
        f32x16_t oc[2]; oc[0] = (f32x16_t){}; oc[1] = (f32x16_t){};
        float carry = 0.f;
#pragma unroll 1
        for (int nt = 0; nt < ntl; ++nt) { f32x16_t sc = (f32x16_t){};
#pragma unroll
            for (int s = 0; s < 4; ++s) sc = __builtin_amdgcn_mfma_f32_32x32x16_f16(*(const h8_t*)(kc + (size_t)(32 * nt + r) * HD + 16 * s + 8 * h), qf[s], sc, 0, 0, 0);
#pragma unroll
            for (int reg = 0; reg < 16; ++reg) sc[reg] = (32 * nt + crow16(reg, h) < nvr) ? exp2f(sc[reg] - mx) * inv : 0.f;
#pragma unroll
            for (int s = 0; s < 2; ++s) { const h8_t pf = acc2frag(sc, s);
#pragma unroll
                for (int dt = 0; dt < 2; ++dt) oc[dt] = __builtin_amdgcn_mfma_f32_32x32x16_f16(ldfrag_perm(vt + (size_t)(32 * dt + r) * 256 + 32 * nt + 16 * s, h), pf, oc[dt], 0, 0, 0); }
#pragma unroll
            for (int qd = 0; qd < 4; ++qd) {
                const float G = (sc[4 * qd] + sc[4 * qd + 1]) + (sc[4 * qd + 2] + sc[4 * qd + 3]);
                const float ol = __shfl_xor(sc[4 * qd + 3], 32);
                const float ol2 = __shfl_xor(qd == 0 ? carry : sc[4 * qd - 1], 32);
                float v = G + ((h == 1) ? ol : ol2);
                v += __shfl_xor(v, 8); v += __shfl_xor(v, 16);
                const int j = 2 * (4 * nt + qd) + h; const bool valid = j <= cur, forced = (j == 0) || (j == cur) || (j == cur - 1);
                if (a == 0) impL[tau * 64 + j] = forced ? INFINITY : (valid ? v : -INFINITY); }
            carry = sc[15];
        }
#pragma unroll
        for (int dt = 0; dt < 2; ++dt)
#pragma unroll
            for (int reg = 0; reg < 16; ++reg) finL[16 * dt + reg] = oc[dt][reg] * g0;
        __builtin_amdgcn_wave_barrier();
        { const int tk = lane >> 3, part = lane & 7; float mine[8]; int rank[8];
#pragma unroll
          for (int e = 0; e < 8; ++e) { mine[e] = impL[tk * 64 + 8 * part + e]; rank[e] = 0; }
          for (int j4 = 0; j4 < 16; ++j4) { const f32x4_t o4 = *(const LAS f32x4_t*)(impL + tk * 64 + 4 * j4); const float ov[4] = {o4.x, o4.y, o4.z, o4.w};
#pragma unroll
              for (int c = 0; c < 4; ++c) { const int jj = 4 * j4 + c;
#pragma unroll
                  for (int e = 0; e < 8; ++e) rank[e] += (ov[c] > mine[e] || (ov[c] == mine[e] && jj < 8 * part + e)) ? 1 : 0; } }
          unsigned bits = 0;
#pragma unroll
          for (int e = 0; e < 8; ++e) bits |= ((rank[e] < NSEL) && (8 * part + e <= cur)) ? (1u << e) : 0u;
          unsigned lo = (part < 4) ? (bits << (8 * part)) : 0u, hi = (part >= 4) ? (bits << (8 * (part - 4))) : 0u;
#pragma unroll
          for (int o = 1; o < 8; o <<= 1) { lo |= __shfl_xor(lo, o); hi |= __shfl_xor(hi, o); }
          if (part == 0) { maskL[2 * tk] = lo; maskL[2 * tk + 1] = hi; } }
        __builtin_amdgcn_wave_barrier();
    }
    {
        unsigned ulo = 0, uhi = 0;
#pragma unroll
        for (int e = 0; e < 8; ++e) { ulo |= maskL[2 * e]; uhi |= maskL[2 * e + 1]; }
        ulo = __builtin_amdgcn_readfirstlane(ulo); uhi = __builtin_amdgcn_readfirstlane(uhi);
        const unsigned mlo = maskL[2 * tau], mhi = maskL[2 * tau + 1];
        const unsigned long long rowmask = ((unsigned long long)mhi << 32) | mlo; unsigned long long um = ((unsigned long long)uhi << 32) | ulo;
        AttnState st; st.o[0] = (f32x16_t){}; st.o[1] = (f32x16_t){}; st.m = -INFINITY; st.l = 0.f;
        const f16_t* Kp = KSR + (size_t)bg * NT * HD; const f16_t* Vp = VST + (size_t)bg * HD * NT;
        while (um) { const int j = __builtin_ctzll(um); um &= um - 1;
            nsa_tile<1>(st, Kp, Vp, 64 * j, qf, (rowmask >> j) & 1ull, 0, tr, r, h); }
        const float lt = st.l + __shfl_xor(st.l, 32); const float sc1 = g1 / fmaxf(lt, 1e-30f);
#pragma unroll
        for (int dt = 0; dt < 2; ++dt)
#pragma unroll
            for (int reg = 0; reg < 16; ++reg) finL[16 * dt + reg] += st.o[dt][reg] * sc1;
    }
    f32x16_t fin[2];
    {
        AttnState st; st.o[0] = (f32x16_t){}; st.o[1] = (f32x16_t){}; st.m = -INFINITY; st.l = 0.f;
        const f16_t* Kp = KWR + (size_t)bg * NT * HD; const f16_t* Vp = VWT + (size_t)bg * HD * NT;
        const int lo = max(tr - WIN + 1, 0), j0 = max(t0 - WIN + 1, 0) >> 6;
        for (int j = j0; j <= cur; ++j) {
            if (j <= j0 + 1 || j == cur) nsa_tile<2>(st, Kp, Vp, 64 * j, qf, true, lo, tr, r, h);
            else nsa_tile<0>(st, Kp, Vp, 64 * j, qf, true, lo, tr, r, h); }
        const float lt = st.l + __shfl_xor(st.l, 32); const float sc2 = g2 / fmaxf(lt, 1e-30f);
        fin[0] = st.o[0] * sc2; fin[1] = st.o[1] * sc2;
#pragma unroll
        for (int dt = 0; dt < 2; ++dt)
#pragma unroll
            for (int reg = 0; reg < 16; ++reg) fin[dt][reg] += finL[16 * dt + reg];
    }
    float ss = 0.f;
#pragma unroll
    for (int dt = 0; dt < 2; ++dt)
#pragma unroll
        for (int reg = 0; reg < 16; ++reg) ss += fin[dt][reg] * fin[dt][reg];
    ss += __shfl_xor(ss, 32);
    const float rs = rsqrtf(ss * (1.f / HD) + EPS);
    f16_t* yp = Y + mrow * DM + 512 + hq * HD;
#pragma unroll
    for (int dt = 0; dt < 2; ++dt)
#pragma unroll
        for (int qd = 0; qd < 4; ++qd) { const int d = 32 * dt + 8 * qd + 4 * h; const f32x4_t gv = *(const f32x4_t*)(ng + d);
            u32x2_t w; w.x = pkh(fin[dt][4 * qd] * rs * gv.x, fin[dt][4 * qd + 1] * rs * gv.y); w.y = pkh(fin[dt][4 * qd + 2] * rs * gv.z, fin[dt][4 * qd + 3] * rs * gv.w);
            *(u32x2_t*)(yp + d) = w; }
}
__device__ __forceinline__ void phase_nsa(const Ctx& C, unsigned* counter, const f16_t* Q16, const f16_t* KCMP16, const f16_t* VCMPT, const f16_t* KSR, const f16_t* VST, const f16_t* KWR, const f16_t* VWT,
                                          const float* GR32, const float* ng, f16_t* Y) {
    LAS float* wl = (LAS float*)C.lds + C.wave * 2752;
    for (;;) {
        unsigned q = 0;
        if (C.lane == 0) q = __hip_atomic_fetch_add(counter, 1u, __ATOMIC_RELAXED, __HIP_MEMORY_SCOPE_AGENT);
        q = __builtin_amdgcn_readfirstlane(q);
        if (q >= (unsigned)(NB * NG * NT / 8)) break;
        nsa_unit((int)q, wl, C.lane, Q16, KCMP16, VCMPT, KSR, VST, KWR, VWT, GR32, ng, Y);
    }
}

__device__ __forceinline__ int my_tid(int wave_s) { return wave_s * 64 + (int)__builtin_amdgcn_mbcnt_hi(~0u, __builtin_amdgcn_mbcnt_lo(~0u, 0u)); }
template <class Epi> __device__ __forceinline__ void run_gemm(LAS unsigned char* lds, int wave_s, const f16_t* A, const f16_t* Bt, int N, int K, const Epi& E) {
    int bid = blockIdx.x, G = gridDim.x; asm volatile("" : "+s"(bid), "+s"(G));
    pg8::Gemm g{A, Bt, MR, N, K, 0}; pg8::StaticOrder S; S.init(MR, N, G, bid);
    pg8::gemm_phase<Epi, pg8::StaticOrder, true, true>(lds, g, S, E, my_tid(wave_s));
}
__device__ __forceinline__ Ctx make_ctx(LAS unsigned char* lds, int wave_s) {
    Ctx C; C.lds = lds; int t = my_tid(wave_s); asm volatile("" : "+v"(t));
    C.tid = t; C.lane = t & 63; C.wave = __builtin_amdgcn_readfirstlane(t >> 6);
    int bid = blockIdx.x, G = gridDim.x; asm volatile("" : "+s"(bid), "+s"(G));
    C.bid = bid; C.G = G; C.gw = C.bid * NWAVES + C.wave; C.NGW = C.G * NWAVES; return C;
}
#define MK_BAR(b_) XcdBarrier b_; b_.bar = WSP(unsigned, WS_CTL) + CW_BAR; { unsigned x_ = xb_xcc_id(); asm volatile("" : "+s"(x_)); b_.x = x_; } b_.st = (volatile LAS unsigned*)(lds + LDSCTL_OFF + 64)
#define GRID_BAR_FIRST() do { MK_BAR(b_); xcd_barrier(b_); } while (0)
#define GRID_BAR() do { MK_BAR(b_); xcd_barrier_fast(b_); } while (0)
#define MODL(l) (WSP(float, WS_MOD) + (size_t)(l) * NB * 9216)
template <int l> __device__ __forceinline__ void layer_body(LAS unsigned char* lds, const int wave_s) {
        { Ctx C = make_ctx(lds, wave_s); phase_norm(C, l == 0 ? PA(x) : (const float*)PA(out), PA(norm_g) + (size_t)(l * 3 + 0) * DM, MODL(l) + 0 * DM, MODL(l) + 1 * DM, WSP(f16_t, WS_HN)); }
        GRID_BAR();
        run_gemm(lds, wave_s, WSP(f16_t, WS_HN), WSP(f16_t, WS_WT1) + (size_t)(l * 2 + 0) * 2 * FF * DM, 2 * FF, DM, pg8::EpiSwiglu{WSP(f16_t, WS_ACT)});
        GRID_BAR();
        run_gemm(lds, wave_s, WSP(f16_t, WS_ACT), WSP(f16_t, WS_WT2) + (size_t)(l * 2 + 0) * DM * FF, DM, FF, pg8::EpiResidual{l == 0 ? PA(x) : (const float*)PA(out), PA(out), MODL(l) + 2 * DM, 9216, 0.5f});
        GRID_BAR();
        { Ctx C = make_ctx(lds, wave_s); phase_norm(C, PA(out), PA(norm_g) + (size_t)(l * 3 + 1) * DM, MODL(l) + 3 * DM, MODL(l) + 4 * DM, WSP(f16_t, WS_HN)); }
        GRID_BAR();
        run_gemm(lds, wave_s, WSP(f16_t, WS_HN), WSP(f16_t, WS_WTIN) + (size_t)l * NINP * DM, NINP, DM,
                 pg8::EpiInProj{WSP(f16_t, WS_C16), WSP(f16_t, WS_Z16), WSP(float, WS_AB32), WSP(float, WS_QN32), WSP(float, WS_KC32), WSP(f16_t, WS_KV16), WSP(float, WS_GR32)});
        GRID_BAR();
        { Ctx C = make_ctx(lds, wave_s); phase_gdn_prep(C, WSP(f16_t, WS_C16), PA(conv_w) + (size_t)l * 4 * 1536, WSP(float, WS_AB32), PA(a_log) + l * 4, PA(dt_bias) + l * 4,
                                                WSP(f16_t, WS_GQ), WSP(f16_t, WS_GK), WSP(f16_t, WS_GV), WSP(float, WS_GG), WSP(float, WS_GB)); }
        { Ctx C = make_ctx(lds, wave_s); phase_nsa_prep(C, PA(positions), WSP(float, WS_QN32), WSP(float, WS_KC32), WSP(f16_t, WS_KV16), WSP(f16_t, WS_Q16), WSP(f16_t, WS_KCR), WSP(f16_t, WS_KSR), WSP(f16_t, WS_KWR),
                                                WSP(f16_t, WS_VC16)); }
        GRID_BAR();
        { Ctx C = make_ctx(lds, wave_s); phase_compress_mfma(C, 0, WSP(f16_t, WS_KCR), WSP(f16_t, WS_VC16), WSP(f16_t, WS_W1C) + (size_t)l * 2 * 128 * 2048, WSP(f16_t, WS_W2C) + (size_t)l * 2 * 64 * 128,
                                                     WSP(float, WS_C1) + l * 256, WSP(f16_t, WS_KCMP16), WSP(f16_t, WS_VCMPT)); }
        { Ctx C = make_ctx(lds, wave_s); phase_nsa_vtrans(C, WSP(f16_t, WS_KV16), WSP(f16_t, WS_VST), WSP(f16_t, WS_VWT)); }
        { Ctx C = make_ctx(lds, wave_s); phase_gdn_chunk(C, WSP(f16_t, WS_GQ), WSP(f16_t, WS_GK), WSP(f16_t, WS_GV), WSP(float, WS_GG), WSP(float, WS_GB), WSP(f16_t, WS_UIMG), WSP(f16_t, WS_ATT), WSP(float, WS_DL)); }
        GRID_BAR();
        { Ctx C = make_ctx(lds, wave_s); if (C.bid < NB * GH) phase_gdn_scan(C, C.bid, WSP(f16_t, WS_GQ), WSP(f16_t, WS_GK), WSP(f16_t, WS_GV), WSP(f16_t, WS_UIMG), WSP(f16_t, WS_ATT), WSP(float, WS_DL),
                                                                          WSP(f16_t, WS_Z16), PA(gdn_ng) + l * GD, WSP(f16_t, WS_HN)); }
        { Ctx C = make_ctx(lds, wave_s); phase_nsa(C, WSP(unsigned, WS_CTL) + CW_NSA + 64 * l, WSP(f16_t, WS_Q16), WSP(f16_t, WS_KCMP16), WSP(f16_t, WS_VCMPT), WSP(f16_t, WS_KSR), WSP(f16_t, WS_VST), WSP(f16_t, WS_KWR), WSP(f16_t, WS_VWT),
                                           WSP(float, WS_GR32), PA(nsa_ng) + l * HD, WSP(f16_t, WS_HN)); }
        GRID_BAR();
        run_gemm(lds, wave_s, WSP(f16_t, WS_HN), WSP(f16_t, WS_WTOUT) + (size_t)l * DM * DM, DM, DM, pg8::EpiResidual{PA(out), PA(out), MODL(l) + 5 * DM, 9216, 1.0f});
        GRID_BAR();
        { Ctx C = make_ctx(lds, wave_s); phase_norm(C, PA(out), PA(norm_g) + (size_t)(l * 3 + 2) * DM, MODL(l) + 6 * DM, MODL(l) + 7 * DM, WSP(f16_t, WS_HN)); }
        GRID_BAR();
        run_gemm(lds, wave_s, WSP(f16_t, WS_HN), WSP(f16_t, WS_WT1) + (size_t)(l * 2 + 1) * 2 * FF * DM, 2 * FF, DM, pg8::EpiSwiglu{WSP(f16_t, WS_ACT)});
        GRID_BAR();
        run_gemm(lds, wave_s, WSP(f16_t, WS_ACT), WSP(f16_t, WS_WT2) + (size_t)(l * 2 + 1) * DM * FF, DM, FF, pg8::EpiResidual{PA(out), PA(out), MODL(l) + 8 * DM, 9216, 0.5f});
        GRID_BAR();
}
__global__ void __launch_bounds__(NTHR, 2) mega_fwd(Params p_unused) {
    extern __shared__ __attribute__((aligned(16))) unsigned char lds_raw[];
    LAS unsigned char* lds = (LAS unsigned char*)lds_raw;
    const int wave_s = __builtin_amdgcn_readfirstlane(threadIdx.x >> 6);
    for (int u = threadIdx.x; u < (LDS_BYTES - LDSCTL_OFF) / 4; u += NTHR) ((LAS unsigned*)(lds + LDSCTL_OFF))[u] = 0u;
    __syncthreads();
    (void)xcd_barrier_post(WSP(unsigned, WS_CTL) + CW_BAR, (volatile LAS unsigned*)(lds + LDSCTL_OFF + 64));
    { Ctx C = make_ctx(lds, wave_s); phase_mod(C, PA(c), PA(ada_w), PA(ada_b), WSP(float, WS_MOD)); }
    { Ctx C = make_ctx(lds, wave_s); phase_wconv(C, WSP(f16_t, WS_WT1), WSP(f16_t, WS_WT2), WSP(f16_t, WS_WTIN), WSP(f16_t, WS_WTOUT)); }
    { Ctx C = make_ctx(lds, wave_s); phase_cmp_weights(C, WSP(f16_t, WS_W1C), WSP(f16_t, WS_W2C), WSP(float, WS_C1)); }
    GRID_BAR_FIRST();
    layer_body<0>(lds, wave_s);
    layer_body<1>(lds, wave_s);
    { Ctx C = make_ctx(lds, wave_s); phase_final_norm(C, PA(out), PA(final_g)); }
}

extern "C" void kernel_launch(void* const* d_in, const int* in_sizes, int n_in, void* d_out, int out_size, void* d_ws, size_t ws_size, hipStream_t stream) {
    static int grid = 0;
    if (grid == 0) {
        if (n_in != 22 || out_size != MR * DM || ws_size < WS_END + 4096) { fprintf(stderr, "kernel_launch: unexpected shapes (n_in %d out %d ws %zu)\n", n_in, out_size, ws_size); grid = -1; return; }
        int dev = 0, cus = 0, per_cu = 0;
        if (hipGetDevice(&dev) != hipSuccess || hipDeviceGetAttribute(&cus, hipDeviceAttributeMultiprocessorCount, dev) != hipSuccess) { grid = -1; return; }
        if (hipFuncSetAttribute((const void*)mega_fwd, hipFuncAttributeMaxDynamicSharedMemorySize, LDS_BYTES) != hipSuccess) { fprintf(stderr, "kernel_launch: hipFuncSetAttribute failed\n"); grid = -1; return; }
        if (hipOccupancyMaxActiveBlocksPerMultiprocessor(&per_cu, (const void*)mega_fwd, NTHR, LDS_BYTES) != hipSuccess || per_cu < 1) { fprintf(stderr, "kernel_launch: occupancy query says %d\n", per_cu); (void)hipGetLastError(); grid = -1; return; }
        grid = cus;
    }
    if (grid < 0) return;
    (void)hipMemsetAsync((char*)d_ws + WS_CTL, 0, CTL_ZERO_BYTES, stream);
    Params p{};
    p.x = (const float*)d_in[0]; p.c = (const float*)d_in[1]; p.positions = (const int*)d_in[2]; p.ada_w = (const float*)d_in[3]; p.ada_b = (const float*)d_in[4];
    p.norm_g = (const float*)d_in[5]; p.ffn_w_in = (const float*)d_in[6]; p.ffn_w_out = (const float*)d_in[7]; p.mix_w_in = (const float*)d_in[8]; p.conv_w = (const float*)d_in[9];
    p.a_log = (const float*)d_in[10]; p.dt_bias = (const float*)d_in[11]; p.gdn_ng = (const float*)d_in[12]; p.pe_k = (const float*)d_in[13]; p.w1_k = (const float*)d_in[14];
    p.w2_k = (const float*)d_in[15]; p.pe_v = (const float*)d_in[16]; p.w1_v = (const float*)d_in[17]; p.w2_v = (const float*)d_in[18]; p.nsa_ng = (const float*)d_in[19];
    p.mix_w_out = (const float*)d_in[20]; p.final_g = (const float*)d_in[21]; p.out = (float*)d_out; p.ws = (unsigned char*)d_ws;
    hipLaunchKernelGGL(mega_fwd, dim3(grid), dim3(NTHR), LDS_BYTES, stream, p);
}
```

```cpp
#include <hip/hip_runtime.h>
#include <cstdio>
#include <cstdint>

constexpr int NB = 4, NT = 4096, DM = 1024, MR = NB * NT, FF = 2816, NIN = 3360, NINP = 3584, DEPTH = 2;
constexpr int GH = 4, GD = 128, GW = 512;
constexpr int NH = 8, NG = 2, HD = 64;
constexpr int NCMP = 255, NBLK = 64, NSEL = 16, WIN = 512;
constexpr float EPS = 1e-6f;
constexpr size_t MiB = 1u << 20;
constexpr size_t WS_CTL = 0, WS_MOD = 1 * MiB, WS_WT1 = 4 * MiB, WS_WT2 = 48 * MiB, WS_WTIN = 70 * MiB, WS_WTOUT = 84 * MiB, WS_W1C = 88 * MiB,
                 WS_HN = 90 * MiB, WS_ACT = 122 * MiB, WS_C16 = 122 * MiB, WS_UIMG = 122 * MiB, WS_ATT = 138 * MiB, WS_DL = 146 * MiB, WS_Z16 = 170 * MiB, WS_KV16 = 186 * MiB,
                 WS_QN32 = 210 * MiB, WS_KC32 = 242 * MiB, WS_AB32 = 250 * MiB, WS_GR32 = 251 * MiB, WS_GQ = 253 * MiB, WS_GK = 269 * MiB, WS_GV = 285 * MiB,
                 WS_GG = 301 * MiB, WS_GB = 301 * MiB + 512 * 1024, WS_KCMP = 302 * MiB, WS_VCMP = 302 * MiB + 512 * 1024, WS_SEL = 303 * MiB, WS_OACC = 304 * MiB, WS_END = 336 * MiB,
                 WS_W2C = 2 * MiB, WS_C1 = 2 * MiB + 128 * 1024, WS_VST = 147 * MiB, WS_VWT = 151 * MiB, WS_KCMP16 = 302 * MiB, WS_VCMPT = 302 * MiB + 512 * 1024,
                 WS_Q16 = 304 * MiB, WS_KCR = 320 * MiB, WS_KSR = 324 * MiB, WS_KWR = 328 * MiB, WS_VC16 = 332 * MiB;
constexpr size_t WS_OG16 = 210 * MiB;
constexpr int CW_NSA = 8192;

typedef unsigned short f16_t;
typedef _Float16 h2_t __attribute__((ext_vector_type(2)));
typedef float f32x2_t __attribute__((ext_vector_type(2)));
typedef float f32x4_t __attribute__((ext_vector_type(4)));
typedef unsigned u32x4_t __attribute__((ext_vector_type(4)));
typedef unsigned u32x2_t __attribute__((ext_vector_type(2)));
__device__ __forceinline__ unsigned pkh(float lo, float hi) { f32x2_t v = {lo, hi}; h2_t h = __builtin_convertvector(v, h2_t); return __builtin_bit_cast(unsigned, h); }
__device__ __forceinline__ float h2f(f16_t u) { return (float)__builtin_bit_cast(_Float16, u); }
__device__ __forceinline__ f16_t f2h(float f) { return __builtin_bit_cast(f16_t, (_Float16)f); }
__device__ __forceinline__ float hlo(unsigned u) { return h2f((f16_t)(u & 0xffffu)); }
__device__ __forceinline__ float hhi(unsigned u) { return h2f((f16_t)(u >> 16)); }
__device__ __forceinline__ float siluf(float x) { return x / (1.f + __expf(-x)); }
__device__ __forceinline__ float sigmf(float x) { return 1.f / (1.f + __expf(-x)); }
__device__ __forceinline__ float lshx(float v, int lane, int m) { return __builtin_bit_cast(float, __builtin_amdgcn_ds_bpermute((lane ^ m) << 2, __builtin_bit_cast(int, v))); }
__device__ __forceinline__ unsigned lshx(unsigned v, int lane, int m) { return (unsigned)__builtin_amdgcn_ds_bpermute((lane ^ m) << 2, (int)v); }
__device__ __forceinline__ float lshf(float v, int src) { return __builtin_bit_cast(float, __builtin_amdgcn_ds_bpermute(src << 2, __builtin_bit_cast(int, v))); }
__device__ __forceinline__ float wave_sum(float v, int lane) {
#pragma unroll
    for (int o = 1; o < 64; o <<= 1) v += lshx(v, lane, o);
    return v;
}

namespace pg8 {
#define PG8_LAS __attribute__((address_space(3)))
typedef unsigned short bf16_t;
typedef _Float16 bf16x8 __attribute__((ext_vector_type(8)));
typedef float f32x4 __attribute__((ext_vector_type(4)));
typedef unsigned u32x4 __attribute__((ext_vector_type(4)));
constexpr int BM = 256, BK = 64, HALF = 128, HTB = HALF * BK * 2  , STAGE_BYTES = 8 * HTB, NXCD = 8, WGM = 8;

__host__ __device__ __forceinline__ int lds_byte(int r, int c) { const int st = (r >> 4) * 2 + (c >> 5), rr = r & 15, cc = c & 31, ob = rr * 64 + cc * 2; return st * 1024 + (ob ^ (((ob >> 9) & 1) << 5)); }
__host__ __device__ __forceinline__ void stage_rc(int b, int& R, int& C) { const int st = b / 1024, sb = b % 1024, swz = sb ^ (((sb >> 9) & 1) << 5); R = (st >> 1) * 16 + swz / 64; C = (st & 1) * 32 + (swz % 64) / 2; }
__host__ __device__ __forceinline__ int perm32(int rho) { const int n = rho >> 4, i = rho & 15; return 8 * (i >> 2) + 4 * n + (i & 3); }

struct Unit { int pm, pn; };
struct Gemm { const bf16_t* A; const bf16_t* Bt; int M, N, K, pad; };

struct StaticOrder {
    int nM, nN, nwg, G, c;
    __host__ __device__ void init(int M, int N, int G_, int c_) { nM = M / BM; nN = N / BM; nwg = nM * nN; G = G_; c = c_; }
    __host__ __device__ bool next(int i, Unit& u) const {
        const long L = (long)i * G + c; if (L >= nwg) return false;
        int wgid = (int)L; { const int q = nwg / NXCD, r = nwg % NXCD, xcd = wgid % NXCD, off = wgid / NXCD; wgid = (xcd < r ? xcd * (q + 1) : r * (q + 1) + (xcd - r) * q) + off; }
        const int nig = WGM * nN, gid = wgid / nig, fm = gid * WGM, gsz = (nM - fm) < WGM ? (nM - fm) : WGM;
        u.pm = fm + ((wgid % nig) % gsz); u.pn = (wgid % nig) / gsz; return true;
    }
    __device__ __forceinline__ void a_ready(const Unit&) const {}
    __device__ __forceinline__ void done(const Unit&) const {}
};


template <class Epi, class Sched, bool ALIGN_EPI = false, bool SP2 = false>
__device__ __forceinline__ void gemm_phase(PG8_LAS unsigned char* lds, const Gemm g, const Sched& S, const Epi& E, int tid_) {
    asm volatile("" : "+v"(tid_));
    const int tid = tid_, wid = __builtin_amdgcn_readfirstlane(tid >> 6), lane = tid & 63, wr = wid >> 2, wc = wid & 3, fr = lane & 15, fq = lane >> 4;
    const int K = g.K, nt = K / BK;
    unsigned voffA[2], voffB[2];
#pragma unroll
    for (int i = 0; i < 2; ++i) { int R, C; stage_rc(tid * 16 + i * 8192, R, C); const int Rb = Epi::PERM ? ((R & ~31) + perm32(R & 31)) : R;
        voffA[i] = (unsigned)(R * K + C) * 2u; voffB[i] = (unsigned)(Rb * K + C) * 2u; }
    const size_t kstep = (size_t)(BK * 2);
    const size_t hstep = (size_t)HALF * K * 2;
    const size_t tstep = 2 * hstep;
    const unsigned ldsw = (unsigned)wid * 1024u;
    const int aoff = lds_byte(wr * 64 + fr, fq * 8), boff = lds_byte(wc * 32 + fr, fq * 8);
#define PG8_SA(b, h) (((b) * 2 + (h)) * HTB)
#define PG8_SB(b, h) ((4 + (b) * 2 + (h)) * HTB)
#define PG8_STAGE(bufoff, gbase, voff) do { _Pragma("unroll") for (int _i = 0; _i < 2; ++_i) \
        __builtin_amdgcn_global_load_lds((const unsigned*)((const char*)(gbase) + (voff)[_i]), (PG8_LAS unsigned*)(lds + (bufoff) + ldsw + _i * 8192), 16, 0, 0); } while (0)
#define PG8_LDA(dst, b, h) do { _Pragma("unroll") for (int m = 0; m < 4; ++m) _Pragma("unroll") for (int k = 0; k < 2; ++k) dst[m][k] = *(const PG8_LAS bf16x8*)(lds + PG8_SA(b, h) + aoff + m * 2048 + k * 1024); } while (0)
#define PG8_LDB(dst, b, h) do { _Pragma("unroll") for (int n = 0; n < 2; ++n) _Pragma("unroll") for (int k = 0; k < 2; ++k) dst[n][k] = *(const PG8_LAS bf16x8*)(lds + PG8_SB(b, h) + boff + n * 2048 + k * 1024); } while (0)
#define PG8_MMA(ai, bj, At, Bt) do { __builtin_amdgcn_s_setprio(1); _Pragma("unroll") for (int m = 0; m < 4; ++m) _Pragma("unroll") for (int n = 0; n < 2; ++n) _Pragma("unroll") for (int k = 0; k < 2; ++k) \
        acc[ai][bj][m][n] = __builtin_amdgcn_mfma_f32_16x16x32_f16(Bt[n][k], At[m][k], acc[ai][bj][m][n], 0, 0, 0); __builtin_amdgcn_s_setprio(0); } while (0)
#define PG8_WAIT_V(n) asm volatile("s_waitcnt vmcnt(" #n ")" ::: "memory")
#define PG8_WAIT_L(n) asm volatile("s_waitcnt lgkmcnt(" #n ")" ::: "memory")
#define PG8_BAR __builtin_amdgcn_s_barrier()
#define PG8_SCHED __builtin_amdgcn_sched_barrier(0)
    Unit cur, nxt; int ui = 0;
    if (!S.next(0, cur)) return;
    f32x4 acc[2][2][4][2];
#pragma unroll
    for (int a = 0; a < 2; ++a)
#pragma unroll
        for (int b = 0; b < 2; ++b)
#pragma unroll
            for (int m = 0; m < 4; ++m)
#pragma unroll
                for (int n = 0; n < 2; ++n) acc[a][b][m][n] = (f32x4){0.f, 0.f, 0.f, 0.f};
    bf16x8 At[4][2], B0[2][2], B1[2][2];
    const char* cA = (const char*)g.A + (size_t)cur.pm * tstep; const char* cB = (const char*)g.Bt + (size_t)cur.pn * tstep;
    S.a_ready(cur);
    if constexpr (SP2) {
        PG8_STAGE(PG8_SB(0, 0), cB, voffB); PG8_STAGE(PG8_SB(0, 1), cB + hstep, voffB); PG8_STAGE(PG8_SA(0, 0), cA, voffA); PG8_STAGE(PG8_SA(0, 1), cA + hstep, voffA);
        if (wr == 1) PG8_BAR;
        PG8_WAIT_V(2); PG8_BAR;
        PG8_STAGE(PG8_SB(1, 0), cB + kstep, voffB); PG8_STAGE(PG8_SA(1, 0), cA + kstep, voffA); PG8_STAGE(PG8_SB(1, 1), cB + hstep + kstep, voffB);
        PG8_WAIT_V(6); PG8_BAR;
    } else {
        PG8_STAGE(PG8_SB(0, 0), cB, voffB); PG8_STAGE(PG8_SA(0, 0), cA, voffA); PG8_STAGE(PG8_SB(0, 1), cB + hstep, voffB); PG8_STAGE(PG8_SA(0, 1), cA + hstep, voffA);
        if (wr == 1) PG8_BAR;
        PG8_WAIT_V(4); PG8_BAR;
        PG8_STAGE(PG8_SB(1, 0), cB + kstep, voffB); PG8_STAGE(PG8_SA(1, 0), cA + kstep, voffA); PG8_STAGE(PG8_SB(1, 1), cB + hstep + kstep, voffB);
        PG8_WAIT_V(6); PG8_BAR;
    }
    for (;;) {
        const bool has_next = S.next(ui + 1, nxt);
        const char* nA = has_next ? (const char*)g.A + (size_t)nxt.pm * tstep : cA; const char* nB = has_next ? (const char*)g.Bt + (size_t)nxt.pn * tstep : cB;
        for (int t = 0; t < nt; t += 2) {
            const bool last = (t == nt - 2);
            const char* a1 = cA + (size_t)(t + 1) * kstep;
            const char* a2 = last ? nA : cA + (size_t)(t + 2) * kstep; const char* b2 = last ? nB : cB + (size_t)(t + 2) * kstep;
            const char* a3 = a2 + kstep; const char* b3 = b2 + kstep;
            if (last && has_next) S.a_ready(nxt);
            if constexpr (SP2) {
            PG8_LDB(B0, 0, 0); PG8_LDB(B1, 0, 1); PG8_SCHED; PG8_LDA(At, 0, 0); PG8_STAGE(PG8_SA(1, 1), a1 + hstep, voffA);
            PG8_WAIT_V(8); PG8_WAIT_L(0); PG8_BAR; PG8_MMA(0, 0, At, B0); PG8_MMA(0, 1, At, B1); PG8_BAR; PG8_SCHED;
            PG8_LDA(At, 0, 1); PG8_STAGE(PG8_SB(0, 0), b2, voffB); PG8_STAGE(PG8_SB(0, 1), b2 + hstep, voffB); PG8_STAGE(PG8_SA(0, 0), a2, voffA);
            PG8_WAIT_V(8); PG8_WAIT_L(0); PG8_BAR; PG8_MMA(1, 0, At, B0); PG8_MMA(1, 1, At, B1); PG8_BAR; PG8_SCHED;
            PG8_LDB(B0, 1, 0); PG8_LDB(B1, 1, 1); PG8_SCHED; PG8_LDA(At, 1, 0); PG8_STAGE(PG8_SA(0, 1), a2 + hstep, voffA);
            PG8_WAIT_V(8); PG8_WAIT_L(0); PG8_BAR; PG8_MMA(0, 0, At, B0); PG8_MMA(0, 1, At, B1); PG8_BAR; PG8_SCHED;
            PG8_LDA(At, 1, 1); PG8_STAGE(PG8_SB(1, 0), b3, voffB); PG8_STAGE(PG8_SB(1, 1), b3 + hstep, voffB); PG8_STAGE(PG8_SA(1, 0), a3, voffA);
            PG8_WAIT_V(8); PG8_WAIT_L(0); PG8_BAR; PG8_MMA(1, 0, At, B0); PG8_MMA(1, 1, At, B1); PG8_BAR; PG8_SCHED;
            } else {
            PG8_LDB(B0, 0, 0); PG8_SCHED; PG8_LDA(At, 0, 0); PG8_STAGE(PG8_SA(1, 1), a1 + hstep, voffA);
            PG8_WAIT_L(8); PG8_BAR; PG8_WAIT_L(0); PG8_MMA(0, 0, At, B0); PG8_BAR; PG8_SCHED;
            PG8_LDB(B1, 0, 1); PG8_STAGE(PG8_SB(0, 0), b2, voffB);
            PG8_BAR; PG8_WAIT_L(0); PG8_MMA(0, 1, At, B1); PG8_BAR;
            PG8_LDA(At, 0, 1); PG8_STAGE(PG8_SA(0, 0), a2, voffA);
            PG8_BAR; PG8_WAIT_L(0); PG8_MMA(1, 0, At, B0); PG8_BAR; PG8_SCHED;
            PG8_STAGE(PG8_SB(0, 1), b2 + hstep, voffB);
            PG8_WAIT_V(6); PG8_BAR; PG8_MMA(1, 1, At, B1); PG8_BAR;
            PG8_LDB(B0, 1, 0); PG8_SCHED; PG8_LDA(At, 1, 0); PG8_STAGE(PG8_SA(0, 1), a2 + hstep, voffA);
            PG8_WAIT_L(8); PG8_BAR; PG8_WAIT_L(0); PG8_MMA(0, 0, At, B0); PG8_BAR; PG8_SCHED;
            PG8_LDB(B1, 1, 1); PG8_STAGE(PG8_SB(1, 0), b3, voffB);
            PG8_BAR; PG8_WAIT_L(0); PG8_MMA(0, 1, At, B1); PG8_BAR;
            PG8_LDA(At, 1, 1); PG8_STAGE(PG8_SA(1, 0), a3, voffA);
            PG8_BAR; PG8_WAIT_L(0); PG8_MMA(1, 0, At, B0); PG8_BAR; PG8_SCHED;
            PG8_STAGE(PG8_SB(1, 1), b3 + hstep, voffB);
            PG8_WAIT_V(6); PG8_BAR; PG8_MMA(1, 1, At, B1); PG8_BAR;
            }
        }
        if constexpr (ALIGN_EPI) { if (wr == 0) PG8_BAR; }
        if constexpr (!Epi::AFTER_DRAIN) { E(acc, cur, wr, wc, fr, fq); S.done(cur); }
        if (!has_next) break;
#pragma unroll
        for (int a = 0; a < 2; ++a)
#pragma unroll
            for (int b = 0; b < 2; ++b)
#pragma unroll
                for (int m = 0; m < 4; ++m)
#pragma unroll
                    for (int n = 0; n < 2; ++n) acc[a][b][m][n] = (f32x4){0.f, 0.f, 0.f, 0.f};
        cur = nxt; cA = nA; cB = nB; ++ui;
        if constexpr (ALIGN_EPI) { if (wr == 1) PG8_BAR; }
    }
    PG8_WAIT_V(0);
    if constexpr (!ALIGN_EPI) { if (wr == 0) PG8_BAR; }
    PG8_BAR;
    if constexpr (Epi::AFTER_DRAIN) { E.fused(acc, cur, wr, wc, fr, fq, lds, wid, lane); S.done(cur); }
#undef PG8_SA
#undef PG8_SB
#undef PG8_STAGE
#undef PG8_LDA
#undef PG8_LDB
#undef PG8_MMA
#undef PG8_WAIT_V
#undef PG8_WAIT_L
#undef PG8_BAR
#undef PG8_SCHED
}
}

namespace pg8 {
struct EpiSwiglu {
    static constexpr bool PERM = true, AFTER_DRAIN = false;
    f16_t* O;
    __device__ __forceinline__ void operator()(const f32x4 (&acc)[2][2][4][2], const Unit& u, int wr, int wc, int fr, int fq) const {
        const int row0 = u.pm * BM + wr * 64 + fr, col0 = u.pn * 128 + wc * 32 + 8 * fq;
#pragma unroll
        for (int ai = 0; ai < 2; ++ai)
#pragma unroll
            for (int m = 0; m < 4; ++m) {
                const f32x4 g0 = acc[ai][0][m][0], g1 = acc[ai][0][m][1], u0 = acc[ai][1][m][0], u1 = acc[ai][1][m][1];
                u32x4 w;
                w.x = pkh(siluf(g0[0]) * u0[0], siluf(g0[1]) * u0[1]); w.y = pkh(siluf(g0[2]) * u0[2], siluf(g0[3]) * u0[3]);
                w.z = pkh(siluf(g1[0]) * u1[0], siluf(g1[1]) * u1[1]); w.w = pkh(siluf(g1[2]) * u1[2], siluf(g1[3]) * u1[3]);
                *(u32x4*)(O + (size_t)(row0 + ai * HALF + m * 16) * FF + col0) = w;
            }
    }
};
struct EpiResidual {
    static constexpr bool PERM = false, AFTER_DRAIN = false;
    const float* base; float* out; const float* gate; int gstride; float coef;
    __device__ __forceinline__ void operator()(const f32x4 (&acc)[2][2][4][2], const Unit& u, int wr, int wc, int fr, int fq) const {
        const int row0 = u.pm * BM + wr * 64 + fr, col0 = u.pn * BM + wc * 32 + 4 * fq;
        const float* gp = gate + (size_t)(u.pm / (NT / BM)) * gstride + col0;
        f32x4 gv[2][2];
#pragma unroll
        for (int bj = 0; bj < 2; ++bj)
#pragma unroll
            for (int n = 0; n < 2; ++n) gv[bj][n] = *(const f32x4*)(gp + bj * HALF + n * 16) * coef;
#pragma unroll
        for (int ai = 0; ai < 2; ++ai)
#pragma unroll
            for (int m = 0; m < 4; ++m) { const size_t off = (size_t)(row0 + ai * HALF + m * 16) * DM + col0;
#pragma unroll
                for (int bj = 0; bj < 2; ++bj)
#pragma unroll
                    for (int n = 0; n < 2; ++n) { const f32x4 bs = *(const f32x4*)(base + off + bj * HALF + n * 16);
                        *(f32x4*)(out + off + bj * HALF + n * 16) = bs + gv[bj][n] * acc[ai][bj][m][n]; } }
    }
};
struct EpiInProj {
    static constexpr bool PERM = true, AFTER_DRAIN = false;
    f16_t* C16; f16_t* Z16; float* AB32; float* QN32; float* KC32; f16_t* KV16; float* GR32;
    __device__ __forceinline__ void operator()(const f32x4 (&acc)[2][2][4][2], const Unit& u, int wr, int wc, int fr, int fq) const {
        const int row0 = u.pm * BM + wr * 64 + fr;
#pragma unroll
        for (int bj = 0; bj < 2; ++bj) {
            const int c0 = u.pn * BM + bj * HALF + wc * 32 + 8 * fq;
            int kind; size_t ld; int cc; void* basep;
            if (c0 < 1536)      { kind = 0; basep = C16;  ld = 1536; cc = c0; }
            else if (c0 < 2048) { kind = 0; basep = Z16;  ld = 512;  cc = c0 - 1536; }
            else if (c0 < 2056) { kind = 1; basep = AB32; ld = 8;    cc = 0; }
            else if (c0 < 2568) { kind = 1; basep = QN32; ld = 512;  cc = c0 - 2056; }
            else if (c0 < 2696) { kind = 1; basep = KC32; ld = 128;  cc = c0 - 2568; }
            else if (c0 < 3336) { kind = 0; basep = KV16; ld = 640;  cc = c0 - 2696; }
            else if (c0 < 3360) { kind = 1; basep = GR32; ld = 24;   cc = c0 - 3336; }
            else continue;
#pragma unroll
            for (int ai = 0; ai < 2; ++ai)
#pragma unroll
                for (int m = 0; m < 4; ++m) {
                    const size_t row = (size_t)(row0 + ai * HALF + m * 16);
                    const f32x4 v0 = acc[ai][bj][m][0], v1 = acc[ai][bj][m][1];
                    if (kind == 0) { u32x4 w; w.x = pkh(v0[0], v0[1]); w.y = pkh(v0[2], v0[3]); w.z = pkh(v1[0], v1[1]); w.w = pkh(v1[2], v1[3]);
                        *(u32x4*)((f16_t*)basep + row * ld + cc) = w; }
                    else { float* p = (float*)basep + row * ld + cc; *(f32x4*)p = v0; *(f32x4*)(p + 4) = v1; }
                }
        }
    }
};
}

#define GAS __attribute__((address_space(1)))
#define LAS __attribute__((address_space(3)))
typedef GAS unsigned gu32;
#define RLX_AGENT __ATOMIC_RELAXED, __HIP_MEMORY_SCOPE_AGENT
#define XB_TMO      128
#define XB_XCNT(j)  (256  + 64 * (j))
#define XB_XSUB(j)  (1280 + 64 * (j))
#define XB_XGEN(j)  (2304 + 64 * (j))
#define XB_TOP      3328
#define XB_TOPGEN   3392
#define XCD_BAR_WORDS 3456
#define XB_SPIN_CAP (1u << 18)

__device__ __forceinline__ unsigned xb_ld(unsigned* p)              { return __hip_atomic_load(p, __ATOMIC_RELAXED, __HIP_MEMORY_SCOPE_AGENT); }
__device__ __forceinline__ unsigned xb_add(unsigned* p, unsigned v) { return __hip_atomic_fetch_add(p, v, __ATOMIC_RELAXED, __HIP_MEMORY_SCOPE_AGENT); }
__device__ __forceinline__ unsigned xb_xcc_id() { return (unsigned)__builtin_amdgcn_s_getreg((3 << 11) | 20) & 0xFu; }
#define XB_SPIN(cond, bar) do { unsigned _sp = 0; while (cond) { __builtin_amdgcn_s_sleep(1); \
    if ((++_sp & 255u) == 0u) { if (xb_ld(&(bar)[XB_TMO])) break; if (_sp > XB_SPIN_CAP) { atomicAdd(&(bar)[XB_TMO], 1u); break; } } } } while (0)

struct XcdBarrier {
    unsigned* bar; unsigned x;
    volatile LAS unsigned* st;
};

__device__ __forceinline__ XcdBarrier xcd_barrier_post(unsigned* bar, volatile LAS unsigned* st) {
    XcdBarrier b; b.bar = bar; b.x = xb_xcc_id(); b.st = st;
    if (threadIdx.x == 0) (void)xb_add(&bar[XB_XCNT(b.x)], 1u);
    return b;
}
__device__ __forceinline__ void xcd_barrier_complete(unsigned* bar, unsigned x, unsigned& nloc, unsigned& nx) {
    const unsigned G = gridDim.x * gridDim.y * gridDim.z;
    unsigned sum, cnt, mine, sp = 0u;
    for (;;) {
        sum = 0u; cnt = 0u; mine = 0u;
#pragma unroll
        for (unsigned j = 0; j < 16; ++j) { const unsigned c = xb_ld(&bar[XB_XCNT(j)]); sum += c; cnt += (c > 0u) ? 1u : 0u; mine = (j == x) ? c : mine; }
        if (sum == G) break;
        __builtin_amdgcn_s_sleep(1);
        if ((++sp & 255u) == 0u) { if (xb_ld(&bar[XB_TMO])) break; if (sp > XB_SPIN_CAP) { atomicAdd(&bar[XB_TMO], 1u); break; } }
    }
    nloc = mine > 0u ? mine : 1u; nx = cnt > 0u ? cnt : 1u;
}

__device__ __forceinline__ void xcd_barrier(const XcdBarrier& b) {
    asm volatile("s_waitcnt vmcnt(0)" ::: "memory");
    __syncthreads();
    if (threadIdx.x == 0) {
        unsigned* bar = b.bar;
        __builtin_amdgcn_s_waitcnt(0);
        unsigned nloc = b.st[0], nx = b.st[1];
        if (nloc == 0u) { xcd_barrier_complete(bar, b.x, nloc, nx); b.st[0] = nloc; b.st[1] = nx; }
        const unsigned old = xb_add(&bar[XB_XSUB(b.x)], 1u);
        const unsigned gen = old / nloc;
        if (old + 1u == (gen + 1u) * nloc) {
            __builtin_amdgcn_fence(__ATOMIC_RELEASE, "agent");
            asm volatile("s_waitcnt vmcnt(0)" ::: "memory");
            const unsigned og = xb_add(&bar[XB_TOP], 1u);
            const unsigned tg = og / nx;
            if (og + 1u == (tg + 1u) * nx) xb_add(&bar[XB_TOPGEN], 1u);
            else XB_SPIN(xb_ld(&bar[XB_TOPGEN]) == tg, bar);
            __builtin_amdgcn_fence(__ATOMIC_ACQUIRE, "agent");
            xb_add(&bar[XB_XGEN(b.x)], 1u);
            asm volatile("s_waitcnt vmcnt(0)" ::: "memory");
        } else {
            XB_SPIN(xb_ld(&bar[XB_XGEN(b.x)]) == gen, bar);
            __builtin_amdgcn_fence(__ATOMIC_ACQUIRE, "agent");
            asm volatile("s_waitcnt vmcnt(0)" ::: "memory");
        }
    }
    __syncthreads();
}

__device__ __forceinline__ void xcd_barrier_fast(const XcdBarrier& b) {
    asm volatile("s_waitcnt vmcnt(0)" ::: "memory");
    __syncthreads();
    if (threadIdx.x == 0) {
        unsigned* bar = b.bar;
        __builtin_amdgcn_s_waitcnt(0);
        unsigned nloc = b.st[0], nx = b.st[1];
        const unsigned old = xb_add(&bar[XB_XSUB(b.x)], 1u);
        const unsigned gen = old / nloc;
        if (old + 1u == (gen + 1u) * nloc) {
            __builtin_amdgcn_fence(__ATOMIC_RELEASE, "agent");
            asm volatile("s_waitcnt vmcnt(0)" ::: "memory");
            const unsigned og = xb_add(&bar[XB_TOP], 1u);
            const unsigned tg = og / nx;
            if (og + 1u == (tg + 1u) * nx) xb_add(&bar[XB_TOPGEN], 1u);
            else XB_SPIN(xb_ld(&bar[XB_TOPGEN]) == tg, bar);
            __builtin_amdgcn_fence(__ATOMIC_ACQUIRE, "agent");
            xb_add(&bar[XB_XGEN(b.x)], 1u);
            asm volatile("s_waitcnt vmcnt(0)" ::: "memory");
        } else {
            XB_SPIN(xb_ld(&bar[XB_XGEN(b.x)]) == gen, bar);
            __builtin_amdgcn_fence(__ATOMIC_ACQUIRE, "agent");
            asm volatile("s_waitcnt vmcnt(0)" ::: "memory");
        }
    }
    __syncthreads();
}

constexpr int NWAVES = 8, NTHR = 512;
constexpr int RING_BYTES = 147456, LDSCTL_OFF = RING_BYTES, LDS_BYTES = 148480;
constexpr int CW_BAR = 4096;
constexpr size_t CTL_ZERO_BYTES = 64 * 1024;

struct Params {
    const float *x, *c; const int* positions; const float *ada_w, *ada_b, *norm_g, *ffn_w_in, *ffn_w_out, *mix_w_in, *conv_w, *a_log, *dt_bias, *gdn_ng,
                *pe_k, *w1_k, *w2_k, *pe_v, *w1_v, *w2_v, *nsa_ng, *mix_w_out, *final_g;
    float* out; unsigned char* ws;
};
struct Ctx { LAS unsigned char* lds; int tid, lane, wave, bid, G, gw, NGW; };
__device__ __forceinline__ const __attribute__((address_space(4))) Params* kargs() {
    const __attribute__((address_space(4))) Params* q = (const __attribute__((address_space(4))) Params*)__builtin_amdgcn_kernarg_segment_ptr();
    asm volatile("" : "+s"(q)); return q;
}
#define PA(f) (kargs()->f)
#define WSP(T, off) ((T*)(PA(ws) + (off)))

__device__ __forceinline__ void phase_mod(const Ctx& C, const float* c, const float* ada_w, const float* ada_b, float* mod) {
    LAS float* cond = (LAS float*)C.lds; LAS float* part = (LAS float*)(C.lds + 16384);
    for (int i = C.tid; i < NB * DM; i += NTHR) cond[i] = siluf(c[i]);
    __syncthreads();
    for (int item = C.bid; item < 2 * 9216 / 64; item += C.G) {
        const int col = item * 64 + C.lane, l = col / 9216, j = col % 9216;
        const float* w = ada_w + (size_t)l * DM * 9216 + j; const int k0 = C.wave * 128;
        float a0 = 0.f, a1 = 0.f, a2 = 0.f, a3 = 0.f;
#pragma unroll 8
        for (int k = k0; k < k0 + 128; ++k) { const float wv = w[(size_t)k * 9216]; a0 += cond[k] * wv; a1 += cond[DM + k] * wv; a2 += cond[2 * DM + k] * wv; a3 += cond[3 * DM + k] * wv; }
        part[(C.wave * 4 + 0) * 64 + C.lane] = a0; part[(C.wave * 4 + 1) * 64 + C.lane] = a1; part[(C.wave * 4 + 2) * 64 + C.lane] = a2; part[(C.wave * 4 + 3) * 64 + C.lane] = a3;
        __syncthreads();
        if (C.wave < 4) { float s = ada_b[l * 9216 + j];
#pragma unroll
            for (int w8 = 0; w8 < 8; ++w8) s += part[(w8 * 4 + C.wave) * 64 + C.lane];
            mod[((size_t)l * NB + C.wave) * 9216 + j] = s; }
        __syncthreads();
    }
}
__device__ __forceinline__ void wconv_item(const float* W, int K, int N, f16_t* WT, int k0, int n0, int r0, LAS float* scr, int lane) {
#pragma unroll 8
    for (int i = 0; i < 32; ++i) { const int kk = 2 * i + (lane >> 5); scr[kk * 33 + (lane & 31)] = W[(size_t)(k0 + kk) * N + n0 + (lane & 31)]; }
    __builtin_amdgcn_wave_barrier();
    const int c = lane & 7;
#pragma unroll
    for (int j = 0; j < 4; ++j) { const int n = (lane >> 3) + 8 * j; const LAS float* s = scr + (8 * c) * 33 + n;
        u32x4_t o; o.x = pkh(s[0 * 33], s[1 * 33]); o.y = pkh(s[2 * 33], s[3 * 33]); o.z = pkh(s[4 * 33], s[5 * 33]); o.w = pkh(s[6 * 33], s[7 * 33]);
        *(u32x4_t*)(WT + (size_t)(r0 + n) * K + k0 + 8 * c) = o; }
    __builtin_amdgcn_wave_barrier();
}
__device__ __forceinline__ void phase_wconv(const Ctx& C, f16_t* WT1, f16_t* WT2, f16_t* WTIN, f16_t* WTOUT) {
    LAS float* scr = (LAS float*)(C.lds + 32768) + C.wave * (64 * 33);
    constexpr int I1 = 16 * 176, I2 = 44 * 32, I3 = 16 * 105, I4 = 16 * 32, T1 = 4 * I1, T2 = 4 * I2, T3 = 2 * I3, T4 = 2 * I4;
    for (int it = C.gw; it < T1 + T2 + T3 + T4; it += C.NGW) {
        int r = it;
        if (r < T1) { const int mi = r / I1, q = r % I1, kb = q / 176, nb = q % 176, n0 = 32 * nb, half = n0 / FF, jj = n0 % FF;
            wconv_item(PA(ffn_w_in) + (size_t)mi * DM * 2 * FF, DM, 2 * FF, WT1 + (size_t)mi * 2 * FF * DM, 64 * kb, n0, 256 * (jj / 128) + 128 * half + (jj % 128), scr, C.lane); continue; }
        r -= T1;
        if (r < T2) { const int mi = r / I2, q = r % I2, kb = q / 32, nb = q % 32;
            wconv_item(PA(ffn_w_out) + (size_t)mi * FF * DM, FF, DM, WT2 + (size_t)mi * DM * FF, 64 * kb, 32 * nb, 32 * nb, scr, C.lane); continue; }
        r -= T2;
        if (r < T3) { const int mi = r / I3, q = r % I3, kb = q / 105, nb = q % 105;
            wconv_item(PA(mix_w_in) + (size_t)mi * DM * NIN, DM, NIN, WTIN + (size_t)mi * NINP * DM, 64 * kb, 32 * nb, 32 * nb, scr, C.lane); continue; }
        r -= T3;
        { const int mi = r / I4, q = r % I4, kb = q / 32, nb = q % 32;
            wconv_item(PA(mix_w_out) + (size_t)mi * DM * DM, DM, DM, WTOUT + (size_t)mi * DM * DM, 64 * kb, 32 * nb, 32 * nb, scr, C.lane); }
    }
    constexpr int PADV = (NINP - NIN) * DM * 2 / 16;
    for (int i = C.bid * NTHR + C.tid; i < 2 * PADV; i += C.G * NTHR) { const int l = i / PADV, q = i % PADV;
        ((u32x4_t*)(WTIN + ((size_t)l * NINP + NIN) * DM))[q] = (u32x4_t){0u, 0u, 0u, 0u}; }
}
__device__ __forceinline__ void phase_norm(const Ctx& C, const float* x, const float* g, const float* shift, const float* scale, f16_t* hn) {
    for (int m = C.gw; m < MR; m += C.NGW) {
        const int b = m / NT; const f32x4_t* xr = (const f32x4_t*)(x + (size_t)m * DM) + C.lane;
        f32x4_t v[4]; float s = 0.f;
#pragma unroll
        for (int j = 0; j < 4; ++j) { v[j] = xr[64 * j]; s += v[j].x * v[j].x + v[j].y * v[j].y + v[j].z * v[j].z + v[j].w * v[j].w; }
        const float rstd = rsqrtf(wave_sum(s, C.lane) * (1.f / DM) + EPS);
        u32x2_t* o = (u32x2_t*)(hn + (size_t)m * DM) + C.lane;
#pragma unroll
        for (int j = 0; j < 4; ++j) {
            const f32x4_t gg = ((const f32x4_t*)g)[C.lane + 64 * j], sh = ((const f32x4_t*)(shift + (size_t)b * 9216))[C.lane + 64 * j], sc = ((const f32x4_t*)(scale + (size_t)b * 9216))[C.lane + 64 * j];
            const f32x4_t h = v[j] * rstd * gg * (sc + 1.f) + sh;
            u32x2_t w; w.x = pkh(h.x, h.y); w.y = pkh(h.z, h.w); o[64 * j] = w;
        }
    }
}
__device__ __forceinline__ void phase_final_norm(const Ctx& C, float* x, const float* g) {
    for (int m = C.gw; m < MR; m += C.NGW) {
        f32x4_t* xr = (f32x4_t*)(x + (size_t)m * DM) + C.lane;
        f32x4_t v[4]; float s = 0.f;
#pragma unroll
        for (int j = 0; j < 4; ++j) { v[j] = xr[64 * j]; s += v[j].x * v[j].x + v[j].y * v[j].y + v[j].z * v[j].z + v[j].w * v[j].w; }
        const float rstd = rsqrtf(wave_sum(s, C.lane) * (1.f / DM) + EPS);
#pragma unroll
        for (int j = 0; j < 4; ++j) xr[64 * j] = v[j] * rstd * ((const f32x4_t*)g)[C.lane + 64 * j];
    }
}
__device__ __forceinline__ void phase_gdn_prep(const Ctx& C, const f16_t* C16, const float* convw, const float* AB32, const float* a_log, const float* dt_bias,
                                               f16_t* GQ, f16_t* GK, f16_t* GV, float* Gg, float* Gb) {
    const int lane = C.lane;
    for (int it = C.gw; it < (MR / 8) * 12; it += C.NGW) {
        const int hs = it % 12, m0 = (it / 12) * 8, b = m0 / NT, t0 = m0 % NT; const int c = hs * 128 + 2 * lane;
        unsigned xv[11];
#pragma unroll
        for (int i = 0; i < 11; ++i) xv[i] = (t0 - 3 + i >= 0) ? *(const unsigned*)(C16 + (size_t)(m0 - 3 + i) * 1536 + c) : 0u;
        float w0[4], w1[4];
#pragma unroll
        for (int i = 0; i < 4; ++i) { w0[i] = convw[i * 1536 + c]; w1[i] = convw[i * 1536 + c + 1]; }
        const int which = hs >> 2, h = hs & 3;
        f16_t* dst = (which == 0 ? GQ : which == 1 ? GK : GV) + ((size_t)(b * GH + h) * NT + t0) * GD + 2 * lane;
#pragma unroll
        for (int j = 0; j < 8; ++j) {
            float y0 = 0.f, y1 = 0.f;
#pragma unroll
            for (int i = 0; i < 4; ++i) { y0 += hlo(xv[j + i]) * w0[i]; y1 += hhi(xv[j + i]) * w1[i]; }
            y0 = siluf(y0); y1 = siluf(y1);
            if (which < 2) { const float ss = wave_sum(y0 * y0 + y1 * y1, lane); float r = rsqrtf(ss + EPS); if (which == 0) r *= 0.08838834764831845f; y0 *= r; y1 *= r; }
            *(unsigned*)(dst + (size_t)j * GD) = pkh(y0, y1);
        }
        if (hs == 8 && lane < 32) { const int j = lane >> 2, hd = lane & 3; const size_t m = (size_t)m0 + j;
            const float braw = AB32[m * 8 + hd], araw = AB32[m * 8 + 4 + hd];
            const float xx = araw + dt_bias[hd]; const float sp = (xx > 20.f) ? xx : log1pf(__expf(xx));
            Gg[(size_t)(b * GH + hd) * NT + t0 + j] = -__expf(a_log[hd]) * sp;
            Gb[(size_t)(b * GH + hd) * NT + t0 + j] = sigmf(braw);
        }
    }
}
typedef _Float16 h8_t __attribute__((ext_vector_type(8)));
typedef _Float16 h4_t __attribute__((ext_vector_type(4)));
typedef float f32x16_t __attribute__((ext_vector_type(16)));
__device__ __forceinline__ h8_t ldfrag_perm(const f16_t* p16, int h) {
    const h4_t a = *(const h4_t*)(p16 + 4 * h), b = *(const h4_t*)(p16 + 8 + 4 * h);
    return (h8_t){a[0], a[1], a[2], a[3], b[0], b[1], b[2], b[3]};
}
__device__ __forceinline__ h8_t acc2frag(const f32x16_t& x, int s) {
    u32x4_t w; w.x = pkh(x[8 * s + 0], x[8 * s + 1]); w.y = pkh(x[8 * s + 2], x[8 * s + 3]); w.z = pkh(x[8 * s + 4], x[8 * s + 5]); w.w = pkh(x[8 * s + 6], x[8 * s + 7]);
    return __builtin_bit_cast(h8_t, w);
}
__device__ __forceinline__ int crow16(int reg, int h) { return (reg & 3) + 8 * (reg >> 2) + 4 * h; }

__device__ __forceinline__ void phase_gdn_chunk(const Ctx& C, f16_t* GQ, f16_t* GK, f16_t* GV, const float* Gg, const float* Gb, f16_t* UIMG, f16_t* ATT, float* DL) {
    const int hb = C.tid >> 8, th = C.tid & 255, lane = C.lane, hw = C.wave & 3, r = lane & 31, h = lane >> 5;
    LAS unsigned char* base = C.lds + hb * 65536;
    LAS f16_t* Kt = (LAS f16_t*)base;
    LAS f16_t* Qt = (LAS f16_t*)(base + 17408);
    LAS float* Lm = (LAS float*)(base + 34816);
    LAS float* gcs = (LAS float*)(base + 51200);
    for (int u = C.bid * 2 + hb; u < NB * GH * 64; u += C.G * 2) {
        const int bh = u >> 6, n = u & 63; const size_t row0 = (size_t)bh * NT + 64 * n;
        if (hw == 0) {
            float g = Gg[row0 + lane];
#pragma unroll
            for (int o = 1; o < 64; o <<= 1) { const float t = lshf(g, lane - o); if (lane >= o) g += t; }
            const float glast = lshf(g, 63);
            gcs[lane] = g; gcs[64 + lane] = __expf(g); gcs[128 + lane] = Gb[row0 + lane]; gcs[192 + lane] = __expf(glast - g);
            if (lane == 63) DL[u] = __expf(g);
        }
#pragma unroll
        for (int q = 0; q < 4; ++q) { const int idx = th + 256 * q, row = idx >> 4, ch = idx & 15;
            *(LAS u32x4_t*)(Kt + row * 136 + ch * 8) = *(const u32x4_t*)(GK + (row0 + row) * GD + ch * 8);
            *(LAS u32x4_t*)(Qt + row * 136 + ch * 8) = *(const u32x4_t*)(GQ + (row0 + row) * GD + ch * 8); }
        __syncthreads();
        { const int ti = hw >> 1, tj = hw & 1;
          f32x16_t kk = {}, qk = {};
          if (ti >= tj) {
#pragma unroll
              for (int s = 0; s < 8; ++s) {
                  const h8_t bk = *(const LAS h8_t*)(Kt + (32 * tj + r) * 136 + 16 * s + 8 * h);
                  const h8_t ak = *(const LAS h8_t*)(Kt + (32 * ti + r) * 136 + 16 * s + 8 * h);
                  const h8_t aq = *(const LAS h8_t*)(Qt + (32 * ti + r) * 136 + 16 * s + 8 * h);
                  kk = __builtin_amdgcn_mfma_f32_32x32x16_f16(ak, bk, kk, 0, 0, 0);
                  qk = __builtin_amdgcn_mfma_f32_32x32x16_f16(aq, bk, qk, 0, 0, 0);
              }
          }
          const int sidx = 32 * tj + r; const float gs = gcs[sidx];
          f16_t* att = ATT + (size_t)u * 4096;
#pragma unroll
          for (int reg = 0; reg < 16; ++reg) { const int c = 32 * ti + crow16(reg, h);
              const float dec = (sidx <= c) ? __expf(gcs[c] - gs) : 0.f;
              Lm[c * 64 + sidx] = (sidx < c) ? gcs[128 + c] * kk[reg] * dec : 0.f;
              att[c * 64 + sidx] = f2h(qk[reg] * dec); }
        }
        __syncthreads();
        float sol[64];
        { const bool isu = th < 128; const int col = th & 127;
#pragma unroll
          for (int c = 0; c < 64; ++c) { const float bc = gcs[128 + c];
              sol[c] = isu ? bc * h2f(GV[(row0 + c) * GD + col]) : bc * gcs[64 + c] * h2f(Kt[c * 136 + col]); }
#pragma unroll
          for (int c = 1; c < 64; ++c) { float a0 = 0.f, a1 = 0.f;
#pragma unroll
              for (int s4 = 0; s4 < (c + 3) / 4; ++s4) { const f32x4_t lv = *(const LAS f32x4_t*)(Lm + c * 64 + 4 * s4);
                  if (4 * s4 + 0 < c) a0 += lv.x * sol[4 * s4 + 0];
                  if (4 * s4 + 1 < c) a1 += lv.y * sol[4 * s4 + 1];
                  if (4 * s4 + 2 < c) a0 += lv.z * sol[4 * s4 + 2];
                  if (4 * s4 + 3 < c) a1 += lv.w * sol[4 * s4 + 3]; }
              sol[c] -= a0 + a1; }
        }
        __syncthreads();
        if (th < 128) {
            const int w = th >> 5, rr = th & 31; f16_t* up = UIMG + (size_t)u * 8192 + w * 2048;
#pragma unroll
            for (int tile = 0; tile < 2; ++tile)
#pragma unroll
                for (int hh = 0; hh < 2; ++hh) { u32x4_t o0, o1;
#define SOLV(reg) sol[32 * tile + ((reg) & 3) + 8 * ((reg) >> 2) + 4 * hh]
                    o0.x = pkh(SOLV(0), SOLV(1)); o0.y = pkh(SOLV(2), SOLV(3)); o0.z = pkh(SOLV(4), SOLV(5)); o0.w = pkh(SOLV(6), SOLV(7));
                    o1.x = pkh(SOLV(8), SOLV(9)); o1.y = pkh(SOLV(10), SOLV(11)); o1.z = pkh(SOLV(12), SOLV(13)); o1.w = pkh(SOLV(14), SOLV(15));
#undef SOLV
                    u32x4_t* dst = (u32x4_t*)(up + tile * 1024 + (rr + 32 * hh) * 16); dst[0] = o0; dst[1] = o1; }
        } else { const int col = th - 128;
#pragma unroll
            for (int c = 0; c < 64; ++c) GV[(row0 + c) * GD + col] = f2h(sol[c]); }
#pragma unroll
        for (int q = 0; q < 4; ++q) { const int idx = th + 256 * q, row = idx >> 4, ch = idx & 15; const float e = gcs[64 + row];
            const h8_t v = *(const LAS h8_t*)(Qt + row * 136 + ch * 8); u32x4_t o;
            o.x = pkh((float)v[0] * e, (float)v[1] * e); o.y = pkh((float)v[2] * e, (float)v[3] * e); o.z = pkh((float)v[4] * e, (float)v[5] * e); o.w = pkh((float)v[6] * e, (float)v[7] * e);
            *(u32x4_t*)(GQ + (row0 + row) * GD + ch * 8) = o; }
        { const int dk = th & 127, ch = th >> 7; f16_t* kd = GK + row0 * GD + dk * 64 + 32 * ch;
#pragma unroll
          for (int q = 0; q < 4; ++q) { float v[8];
#pragma unroll
              for (int e = 0; e < 8; ++e) { const int c = 32 * ch + 8 * q + e; v[e] = h2f(Kt[c * 136 + dk]) * gcs[192 + c]; }
              u32x4_t o; o.x = pkh(v[0], v[1]); o.y = pkh(v[2], v[3]); o.z = pkh(v[4], v[5]); o.w = pkh(v[6], v[7]);
              *(u32x4_t*)(kd + 8 * q) = o; } }
        __syncthreads();
    }
}

constexpr int SC_W = 0, SC_Q = 16384, SC_K = 32768, SC_A = 49152, SC_U = 57344, SC_BUF = 73728;
__device__ __forceinline__ h8_t lds_fragx(const LAS unsigned char* base, int rowoff, int xs, int c) {
    const h4_t a = *(const LAS h4_t*)(base + rowoff + ((c << 4) ^ xs)), b = *(const LAS h4_t*)(base + rowoff + (((c + 1) << 4) ^ xs));
    return (h8_t){a[0], a[1], a[2], a[3], b[0], b[1], b[2], b[3]};
}
__device__ __forceinline__ void scan_stage(const Ctx& C, LAS unsigned char* buf, const f16_t* Wg, const f16_t* Qg, const f16_t* Kg, const f16_t* Ag, const f16_t* Ug) {
    const int L = C.tid - 256;
    u32x4_t w[4], q[4], k[4], a[2], u[4];
#pragma unroll
    for (int i = 0; i < 4; ++i) { const int x = L + 256 * i; w[i] = ((const u32x4_t*)Wg)[x]; q[i] = ((const u32x4_t*)Qg)[x]; k[i] = ((const u32x4_t*)Kg)[x]; u[i] = ((const u32x4_t*)Ug)[x]; }
#pragma unroll
    for (int i = 0; i < 2; ++i) a[i] = ((const u32x4_t*)Ag)[L + 256 * i];
#pragma unroll
    for (int i = 0; i < 4; ++i) { const int x = L + 256 * i;
        { const int R = x >> 4, c = x & 15; *(LAS u32x4_t*)(buf + SC_W + R * 256 + ((c ^ (R & 15)) << 4)) = w[i]; *(LAS u32x4_t*)(buf + SC_Q + R * 256 + ((c ^ (R & 15)) << 4)) = q[i]; }
        { const int R = x >> 3, c = x & 7; *(LAS u32x4_t*)(buf + SC_K + R * 128 + ((c ^ ((R >> 1) & 7)) << 4)) = k[i]; }
        *(LAS u32x4_t*)(buf + SC_U + x * 16) = u[i]; }
#pragma unroll
    for (int i = 0; i < 2; ++i) { const int x = L + 256 * i, R = x >> 3, c = x & 7; *(LAS u32x4_t*)(buf + SC_A + R * 128 + ((c ^ ((R >> 1) & 7)) << 4)) = a[i]; }
}
__device__ __forceinline__ void phase_gdn_scan(const Ctx& C, int bh, const f16_t* QG, const f16_t* KDT, const f16_t* W, const f16_t* UIMG, const f16_t* ATT, const float* DL, f16_t* OG16) {
    const int lane = C.lane, r = lane & 31, h = lane >> 5, w = C.wave, b = bh / GH, hh = bh % GH;
    f32x16_t S[4];
#pragma unroll
    for (int T = 0; T < 4; ++T) S[T] = (f32x16_t){};
    __syncthreads();
    if (w >= 4) { const size_t row0 = (size_t)bh * NT; scan_stage(C, C.lds, W + row0 * GD, QG + row0 * GD, KDT + row0 * GD, ATT + (size_t)(bh * 64) * 4096, UIMG + (size_t)(bh * 64) * 8192); }
    __syncthreads();
#pragma unroll 1
    for (int n = 0; n < 64; ++n) {
        LAS unsigned char* cur = C.lds + (n & 1) * SC_BUF;
        if (w >= 4) {
            if (n + 1 < 64) { const size_t row0 = (size_t)bh * NT + 64 * (n + 1); const int u = bh * 64 + n + 1;
                scan_stage(C, C.lds + ((n + 1) & 1) * SC_BUF, W + row0 * GD, QG + row0 * GD, KDT + row0 * GD, ATT + (size_t)u * 4096, UIMG + (size_t)u * 8192); }
        } else {
            const int u = bh * 64 + n;
            const float dl = DL[u];
            int x256 = (r & 15) << 4, x128 = ((r >> 1) & 7) << 4, ro256 = r * 256 + 8 * h, ro128 = r * 128 + 8 * h;
            asm volatile("" : "+v"(x256), "+v"(x128), "+v"(ro256), "+v"(ro128));
            h8_t sf[4][2];
#pragma unroll
            for (int T = 0; T < 4; ++T) { sf[T][0] = acc2frag(S[T], 0); sf[T][1] = acc2frag(S[T], 1); }
            f32x16_t ws[2], qs[2];
#pragma unroll
            for (int ct = 0; ct < 2; ++ct) { ws[ct] = (f32x16_t){}; qs[ct] = (f32x16_t){};
#pragma unroll
                for (int T = 0; T < 4; ++T)
#pragma unroll
                    for (int s = 0; s < 2; ++s) {
                        ws[ct] = __builtin_amdgcn_mfma_f32_32x32x16_f16(lds_fragx(cur + SC_W + ct * 8192, ro256, x256, 4 * T + 2 * s), sf[T][s], ws[ct], 0, 0, 0);
                        qs[ct] = __builtin_amdgcn_mfma_f32_32x32x16_f16(lds_fragx(cur + SC_Q + ct * 8192, ro256, x256, 4 * T + 2 * s), sf[T][s], qs[ct], 0, 0, 0);
                        __builtin_amdgcn_sched_barrier(0);
                    } }
            h8_t vf[2][2];
#pragma unroll
            for (int ct = 0; ct < 2; ++ct) { const LAS h8_t* up = (const LAS h8_t*)(cur + SC_U + (w * 2048 + ct * 1024 + lane * 16) * 2); const h8_t u0 = up[0], u1 = up[1];
                f32x16_t vn;
#pragma unroll
                for (int e = 0; e < 8; ++e) { vn[e] = (float)u0[e] - ws[ct][e]; vn[8 + e] = (float)u1[e] - ws[ct][8 + e]; }
                vf[ct][0] = acc2frag(vn, 0); vf[ct][1] = acc2frag(vn, 1); }
#pragma unroll
            for (int ct = 0; ct < 2; ++ct)
#pragma unroll
                for (int c2 = 0; c2 < 2; ++c2)
#pragma unroll
                    for (int s = 0; s < 2; ++s)
                    { qs[ct] = __builtin_amdgcn_mfma_f32_32x32x16_f16(lds_fragx(cur + SC_A + ct * 4096, ro128, x128, 4 * c2 + 2 * s), vf[c2][s], qs[ct], 0, 0, 0); __builtin_amdgcn_sched_barrier(0); }
            { f16_t* op = OG16 + ((size_t)b * NT + 64 * n) * GW + hh * GD + 32 * w + r;
#pragma unroll
              for (int ct = 0; ct < 2; ++ct)
#pragma unroll
                  for (int reg = 0; reg < 16; ++reg) op[(size_t)(32 * ct + crow16(reg, h)) * GW] = f2h(qs[ct][reg]); }
#pragma unroll
            for (int T = 0; T < 4; ++T) { S[T] = S[T] * dl;
#pragma unroll
                for (int c2 = 0; c2 < 2; ++c2)
#pragma unroll
                    for (int s = 0; s < 2; ++s)
                    { S[T] = __builtin_amdgcn_mfma_f32_32x32x16_f16(lds_fragx(cur + SC_K + T * 4096, ro128, x128, 4 * c2 + 2 * s), vf[c2][s], S[T], 0, 0, 0); __builtin_amdgcn_sched_barrier(0); } }
        }
        __syncthreads();
    }
}
__device__ __forceinline__ void phase_gdn_out16(const Ctx& C, const f16_t* OG16, const f16_t* Z16, const float* ng, f16_t* Y) {
    const int lane = C.lane;
    for (int wv0 = C.gw * 4; wv0 < MR * GH; wv0 += C.NGW * 4) {
        unsigned ov[4], zv[4];
#pragma unroll
        for (int i = 0; i < 4; ++i) { const int wv = wv0 + i, m = wv >> 2, hd = wv & 3; ov[i] = *(const unsigned*)(OG16 + (size_t)m * GW + hd * GD + 2 * lane); zv[i] = *(const unsigned*)(Z16 + (size_t)m * GW + hd * GD + 2 * lane); }
        const float g0 = ng[2 * lane], g1 = ng[2 * lane + 1];
#pragma unroll
        for (int i = 0; i < 4; ++i) { const int wv = wv0 + i, m = wv >> 2, hd = wv & 3; const float ox = hlo(ov[i]), oy = hhi(ov[i]);
            const float rr = rsqrtf(wave_sum(ox * ox + oy * oy, lane) * (1.f / GD) + EPS);
            *(unsigned*)(Y + (size_t)m * DM + hd * GD + 2 * lane) = pkh(ox * rr * g0 * siluf(hlo(zv[i])), oy * rr * g1 * siluf(hhi(zv[i]))); }
    }
}

constexpr float QSCALE = 0.125f * 1.4426950408889634f;
__device__ __forceinline__ void phase_nsa_prep(const Ctx& C, const int* positions, const float* QN32, const float* KC32, const f16_t* KV16,
                                               f16_t* Q16, f16_t* KCR, f16_t* KSR, f16_t* KWR, f16_t* VC16) {
    const int lane = C.lane, oct = lane & 7, seg = lane >> 4, g = (lane >> 3) & 1;
    const float invf = powf(500000.0f, -(float)oct * 0.125f);
    const int coff = (seg == 1) ? 128 : (seg == 2) ? 384 : 0;
    for (int m0 = C.gw * 4; m0 < MR; m0 += C.NGW * 4) {
        f32x4_t qa[4], qb[4], ka[4], kb[4]; u32x4_t kh[4]; float pos[4];
#pragma unroll
        for (int j = 0; j < 4; ++j) { const size_t m = (size_t)m0 + j; pos[j] = (float)positions[m];
            const f32x4_t* src = (const f32x4_t*)(QN32 + m * 512 + lane * 8); qa[j] = src[0]; qb[j] = src[1];
            if (seg == 0) { const f32x4_t* ks = (const f32x4_t*)(KC32 + m * 128 + (lane & 15) * 8); ka[j] = ks[0]; kb[j] = ks[1]; }
            else kh[j] = *(const u32x4_t*)(KV16 + m * 640 + coff + (lane & 15) * 8); }
#pragma unroll
        for (int j = 0; j < 4; ++j) { const int m = m0 + j, b = m / NT, t = m % NT;
            const float ang = pos[j] * invf; const float cs = cosf(ang), sn = sinf(ang);
            float cv[8], sv[8];
#pragma unroll
            for (int e = 0; e < 8; ++e) { cv[e] = lshf(cs, e); sv[e] = lshf(sn, e); }
            { const float v[8] = {qa[j].x, qa[j].y, qa[j].z, qa[j].w, qb[j].x, qb[j].y, qb[j].z, qb[j].w}; float o[8];
#pragma unroll
              for (int e = 0; e < 8; ++e) { const float pv = lshx(v[e], lane, 1); o[e] = (oct == 0) ? (v[e] * cv[e] - pv * sv[e]) : (oct == 1) ? (v[e] * cv[e] + pv * sv[e]) : v[e]; o[e] *= QSCALE; }
              u32x4_t w; w.x = pkh(o[0], o[1]); w.y = pkh(o[2], o[3]); w.z = pkh(o[4], o[5]); w.w = pkh(o[6], o[7]);
              *(u32x4_t*)(Q16 + (size_t)m * 512 + lane * 8) = w; }
            { float v[8];
              if (seg == 0) { v[0] = ka[j].x; v[1] = ka[j].y; v[2] = ka[j].z; v[3] = ka[j].w; v[4] = kb[j].x; v[5] = kb[j].y; v[6] = kb[j].z; v[7] = kb[j].w; }
              else { const unsigned ku[4] = {kh[j].x, kh[j].y, kh[j].z, kh[j].w};
#pragma unroll
                  for (int e = 0; e < 4; ++e) { v[2 * e] = hlo(ku[e]); v[2 * e + 1] = hhi(ku[e]); } }
              float o[8];
#pragma unroll
              for (int e = 0; e < 8; ++e) { const float pv = lshx(v[e], lane, 1); o[e] = (seg == 3) ? v[e] : (oct == 0) ? (v[e] * cv[e] - pv * sv[e]) : (oct == 1) ? (v[e] * cv[e] + pv * sv[e]) : v[e]; }
              u32x4_t w; w.x = pkh(o[0], o[1]); w.y = pkh(o[2], o[3]); w.z = pkh(o[4], o[5]); w.w = pkh(o[6], o[7]);
              f16_t* dst = (seg == 0 ? KCR : seg == 1 ? KSR : seg == 2 ? KWR : VC16) + ((size_t)(b * NG + g) * NT + t) * HD + oct * 8;
              *(u32x4_t*)dst = w; }
        }
    }
}
__device__ __forceinline__ void phase_nsa_vtrans(const Ctx& C, const f16_t* KV16, f16_t* VST, f16_t* VWT) {
    const int lane = C.lane;
    for (int it = C.gw; it < NB * NG * (NT / 64) * 2; it += C.NGW) {
        const int which = it & 1, tile = (it >> 1) % (NT / 64), bg = (it >> 1) / (NT / 64), b = bg / NG, g = bg % NG;
        const f16_t* src = KV16 + ((size_t)b * NT + tile * 64 + lane) * 640 + (which ? 512 : 256) + g * 64;
        f16_t* dst = (which ? VWT : VST) + (size_t)bg * HD * NT + tile * 64 + lane;
#pragma unroll
        for (int c8 = 0; c8 < 8; ++c8) { const u32x4_t w = *(const u32x4_t*)(src + c8 * 8); const unsigned ws[4] = {w.x, w.y, w.z, w.w};
#pragma unroll
            for (int i = 0; i < 4; ++i) { dst[(size_t)(c8 * 8 + 2 * i) * NT] = (f16_t)(ws[i] & 0xffffu); dst[(size_t)(c8 * 8 + 2 * i + 1) * NT] = (f16_t)(ws[i] >> 16); } }
    }
}

__device__ __forceinline__ void phase_cmp_weights(const Ctx& C, f16_t* W1C, f16_t* W2C, float* C1) {
    LAS float* scr = (LAS float*)(C.lds + 32768) + C.wave * (64 * 33);
    constexpr int I1 = 32 * 4;
    for (int it = C.gw; it < 4 * I1; it += C.NGW) { const int mi = it / I1, q = it % I1, kb = q / 4, nb = q % 4, l = mi >> 1, w = mi & 1;
        wconv_item((w ? PA(w1_v) : PA(w1_k)) + (size_t)l * 2048 * 128, 2048, 128, W1C + (size_t)mi * 128 * 2048, 64 * kb, 32 * nb, 32 * nb, scr, C.lane); }
    for (int i = C.bid * NTHR + C.tid; i < 4 * 64 * 128; i += C.G * NTHR) { const int mi = i / 8192, d = (i % 8192) / 128, hd = i % 128, l = mi >> 1, w = mi & 1;
        W2C[i] = f2h(((w ? PA(w2_v) : PA(w2_k)) + (size_t)l * 128 * 64)[hd * 64 + d]); }
    for (int i = C.bid * NTHR + C.tid; i < 4 * 128; i += C.G * NTHR) { const int mi = i / 128, j = i % 128, l = mi >> 1, w = mi & 1;
        const float* pe = (w ? PA(pe_v) : PA(pe_k)) + (size_t)l * 2048; const float* w1 = (w ? PA(w1_v) : PA(w1_k)) + (size_t)l * 2048 * 128;
        float a = 0.f; for (int k = 0; k < 2048; ++k) a += pe[k] * w1[(size_t)k * 128 + j];
        C1[i] = a; }
}

__device__ __forceinline__ void phase_compress_mfma(const Ctx& C, int lastfirst, const f16_t* KCR, const f16_t* VC16, const f16_t* W1C, const f16_t* W2C, const float* C1, f16_t* KCMP16, f16_t* VCMPT) {
    const int lane = C.lane, r = lane & 31, h = lane >> 5, ht = C.wave & 3, hb = C.wave >> 2;
    (void)lastfirst;
    LAS float* part = (LAS float*)C.lds + hb * 8192;
    const int gb = (C.G - 1 - C.bid) * 2 + hb;
    for (int grp = gb; grp < 2 * NB * NG * 8; grp += C.G * 2) {
        const int rt = grp & 7, bg = (grp >> 3) % (NB * NG), which = grp / (8 * NB * NG);
        const f16_t* src = (which ? VC16 : KCR) + (size_t)bg * NT * HD + (size_t)(32 * rt + r) * 1024 + 8 * h;
        const f16_t* w1 = W1C + (size_t)which * 128 * 2048 + (size_t)(32 * ht + r) * 2048 + 8 * h;
        f32x16_t acc = (f32x16_t){};
#pragma unroll 16
        for (int ks = 0; ks < 128; ++ks) acc = __builtin_amdgcn_mfma_f32_32x32x16_f16(*(const h8_t*)(w1 + 16 * ks), *(const h8_t*)(src + 16 * ks), acc, 0, 0, 0);
#pragma unroll
        for (int reg = 0; reg < 16; ++reg) acc[reg] = siluf(acc[reg] + C1[which * 128 + 32 * ht + crow16(reg, h)]);
        const h8_t hf0 = acc2frag(acc, 0), hf1 = acc2frag(acc, 1);
        const f16_t* w2 = W2C + (size_t)which * 64 * 128;
#pragma unroll
        for (int dt = 0; dt < 2; ++dt) { f32x16_t o = (f32x16_t){};
            o = __builtin_amdgcn_mfma_f32_32x32x16_f16(ldfrag_perm(w2 + (32 * dt + r) * 128 + 32 * ht, h), hf0, o, 0, 0, 0);
            o = __builtin_amdgcn_mfma_f32_32x32x16_f16(ldfrag_perm(w2 + (32 * dt + r) * 128 + 32 * ht + 16, h), hf1, o, 0, 0, 0);
            LAS f32x4_t* pp = (LAS f32x4_t*)(part + ((ht * 2 + dt) * 64 + lane) * 16);
            pp[0] = (f32x4_t){o[0], o[1], o[2], o[3]}; pp[1] = (f32x4_t){o[4], o[5], o[6], o[7]}; pp[2] = (f32x4_t){o[8], o[9], o[10], o[11]}; pp[3] = (f32x4_t){o[12], o[13], o[14], o[15]}; }
        __syncthreads();
        { const int dt = ht >> 1, s = ht & 1;
          float v[8];
#pragma unroll
          for (int e = 0; e < 8; ++e) v[e] = 0.f;
#pragma unroll
          for (int k = 0; k < 4; ++k) { const LAS f32x4_t* pp = (const LAS f32x4_t*)(part + ((k * 2 + dt) * 64 + lane) * 16 + 8 * s); const f32x4_t a = pp[0], b2 = pp[1];
              v[0] += a.x; v[1] += a.y; v[2] += a.z; v[3] += a.w; v[4] += b2.x; v[5] += b2.y; v[6] += b2.z; v[7] += b2.w; }
          const int n = 32 * rt + r; const bool live = n < NCMP;
          if (which == 0) {
#pragma unroll
              for (int q = 0; q < 2; ++q) { u32x2_t w; w.x = live ? pkh(v[4 * q], v[4 * q + 1]) : 0u; w.y = live ? pkh(v[4 * q + 2], v[4 * q + 3]) : 0u;
                  *(u32x2_t*)(KCMP16 + ((size_t)bg * 256 + n) * HD + 32 * dt + 16 * s + 8 * q + 4 * h) = w; }
          } else {
#pragma unroll
              for (int e = 0; e < 8; ++e) VCMPT[((size_t)bg * HD + 32 * dt + crow16(8 * s + e, h)) * 256 + n] = live ? f2h(v[e]) : (f16_t)0;
          } }
        __syncthreads();
    }
}

struct AttnState { f32x16_t o[2]; float m, l; };
template <int MODE> __device__ __forceinline__ void nsa_tile(AttnState& st, const f16_t* Kp, const f16_t* Vtp, int key0, const h8_t (&qf)[4], bool rowsel, int tlo, int thi, int r, int h) {
    f32x16_t p[2];
#pragma unroll
    for (int kt = 0; kt < 2; ++kt) { p[kt] = (f32x16_t){};
#pragma unroll
        for (int s = 0; s < 4; ++s) p[kt] = __builtin_amdgcn_mfma_f32_32x32x16_f16(*(const h8_t*)(Kp + (size_t)(key0 + 32 * kt + r) * HD + 16 * s + 8 * h), qf[s], p[kt], 0, 0, 0); }
    float tm = -INFINITY;
#pragma unroll
    for (int kt = 0; kt < 2; ++kt)
#pragma unroll
        for (int reg = 0; reg < 16; ++reg) {
            if (MODE != 0) { const int key = key0 + 32 * kt + crow16(reg, h); const bool ok = (MODE == 1) ? (rowsel && key <= thi) : (key >= tlo && key <= thi); if (!ok) p[kt][reg] = -INFINITY; }
            tm = fmaxf(tm, p[kt][reg]); }
    tm = fmaxf(tm, lshx(tm, r + 32 * h, 32));
    if (__any(tm > st.m + 8.f)) {
        const float mn = fmaxf(st.m, tm); const float al = (mn == -INFINITY) ? 1.f : exp2f(st.m - mn);
        st.o[0] = st.o[0] * al; st.o[1] = st.o[1] * al; st.l *= al; st.m = mn;
    }
    float ps = 0.f;
#pragma unroll
    for (int kt = 0; kt < 2; ++kt)
#pragma unroll
        for (int reg = 0; reg < 16; ++reg) { const float e = (p[kt][reg] == -INFINITY) ? 0.f : exp2f(p[kt][reg] - st.m); p[kt][reg] = e; ps += e; }
    st.l += ps;
#pragma unroll
    for (int kt = 0; kt < 2; ++kt)
#pragma unroll
        for (int s = 0; s < 2; ++s) { const h8_t pf = acc2frag(p[kt], s);
#pragma unroll
            for (int dt = 0; dt < 2; ++dt) st.o[dt] = __builtin_amdgcn_mfma_f32_32x32x16_f16(ldfrag_perm(Vtp + (size_t)(32 * dt + r) * NT + key0 + 32 * kt + 16 * s, h), pf, st.o[dt], 0, 0, 0); }
}

template <int MODE> __device__ __forceinline__ void nsa_tile_lds(AttnState& st, const LAS unsigned char* kb, const LAS unsigned char* vb, int key0, const h8_t (&qf)[4], bool rowsel, int tlo, int thi, int r, int h, int ro, int xs) {
    f32x16_t p[2];
    const int hx = (h << 4) ^ xs;
#pragma unroll
    for (int kt = 0; kt < 2; ++kt) { p[kt] = (f32x16_t){};
#pragma unroll
        for (int s = 0; s < 4; ++s) p[kt] = __builtin_amdgcn_mfma_f32_32x32x16_f16(*(const LAS h8_t*)(kb + kt * 4096 + ro + ((s << 5) ^ hx)), qf[s], p[kt], 0, 0, 0); }
    float tm = -INFINITY;
#pragma unroll
    for (int kt = 0; kt < 2; ++kt)
#pragma unroll
        for (int reg = 0; reg < 16; ++reg) {
            if (MODE != 0) { const int key = key0 + 32 * kt + crow16(reg, h); const bool ok = (MODE == 1) ? (rowsel && key <= thi) : (key >= tlo && key <= thi); if (!ok) p[kt][reg] = -INFINITY; }
            tm = fmaxf(tm, p[kt][reg]); }
    tm = fmaxf(tm, lshx(tm, r + 32 * h, 32));
    if (__any(tm > st.m + 8.f)) {
        const float mn = fmaxf(st.m, tm); const float al = (mn == -INFINITY) ? 1.f : exp2f(st.m - mn);
        st.o[0] = st.o[0] * al; st.o[1] = st.o[1] * al; st.l *= al; st.m = mn;
    }
    float ps = 0.f;
#pragma unroll
    for (int kt = 0; kt < 2; ++kt)
#pragma unroll
        for (int reg = 0; reg < 16; ++reg) { const float e = (p[kt][reg] == -INFINITY) ? 0.f : exp2f(p[kt][reg] - st.m); p[kt][reg] = e; ps += e; }
    st.l += ps;
    const int rov = ro + 8 * h;
#pragma unroll
    for (int kt = 0; kt < 2; ++kt)
#pragma unroll
        for (int s = 0; s < 2; ++s) { const h8_t pf = acc2frag(p[kt], s);
#pragma unroll
            for (int dt = 0; dt < 2; ++dt) st.o[dt] = __builtin_amdgcn_mfma_f32_32x32x16_f16(lds_fragx(vb + dt * 4096, rov, xs, 4 * kt + 2 * s), pf, st.o[dt], 0, 0, 0); }
}

__device__ __forceinline__ void nsa_unit(int q, LAS float* wl, int lane, const f16_t* Q16, const f16_t* KCMP16, const f16_t* VCMPT, const f16_t* KSR, const f16_t* VST, const f16_t* KWR, const f16_t* VWT,
                                         const float* GR32, const float* ng, f16_t* Y) {
    asm volatile("" : "+v"(lane));
    const int r = lane & 31, h = lane >> 5, tau = r & 7, a = r >> 3;
    const int cur = 63 - (q >> 6), qq = q & 63, b = qq >> 4, g = (qq >> 3) & 1, t0 = 64 * cur + 8 * (qq & 7), bg = b * NG + g, tr = t0 + tau, hq = 4 * g + a;
    const size_t mrow = (size_t)b * NT + tr;
    LAS float* impL = wl; LAS unsigned* maskL = (LAS unsigned*)(wl + 512);
    h8_t qf[4];
#pragma unroll
    for (int s = 0; s < 4; ++s) qf[s] = *(const h8_t*)(Q16 + mrow * 512 + hq * HD + 16 * s + 8 * h);
    const float* gr = GR32 + mrow * 24 + hq * 3;
    const float g0 = sigmf(gr[0]), g1 = sigmf(gr[1]), g2 = sigmf(gr[2]);
    LAS float* finL = wl + 640 + lane * 33;
    {
        const int nvr = (tr >= 31) ? (tr - 31) / 16 + 1 : 0;
        const int nvmax = (t0 + 7 >= 31) ? (t0 + 7 - 31) / 16 + 1 : 0; const int ntl = (nvmax + 31) >> 5;
        const f16_t* kc = KCMP16 + (size_t)bg * 256 * HD; const f16_t* vt = VCMPT + (size_t)bg * HD * 256;
        float mx = -INFINITY, sum = 0.f;
#pragma unroll 1
        for (int nt = 0; nt < ntl; ++nt) { f32x16_t sc = (f32x16_t){};
#pragma unroll
            for (int s = 0; s < 4; ++s) sc = __builtin_amdgcn_mfma_f32_32x32x16_f16(*(const h8_t*)(kc + (size_t)(32 * nt + r) * HD + 16 * s + 8 * h), qf[s], sc, 0, 0, 0);
#pragma unroll
            for (int reg = 0; reg < 16; ++reg) if (32 * nt + crow16(reg, h) < nvr) mx = fmaxf(mx, sc[reg]); }
        mx = fmaxf(mx, lshx(mx, lane, 32));
#pragma unroll 1
        for (int nt = 0; nt < ntl; ++nt) { f32x16_t sc = (f32x16_t){};
#pragma unroll
            for (int s = 0; s < 4; ++s) sc = __builtin_amdgcn_mfma_f32_32x32x16_f16(*(const h8_t*)(kc + (size_t)(32 * nt + r) * HD + 16 * s + 8 * h), qf[s], sc, 0, 0, 0);
#pragma unroll
            for (int reg = 0; reg < 16; ++reg) if (32 * nt + crow16(reg, h) < nvr) sum += exp2f(sc[reg] - mx); }
        sum += lshx(sum, lane, 32);
        const float inv = 1.f / fmaxf(sum, 1e-30f);
        if (a == 0) {
#pragma unroll
            for (int gi = 0; gi < 32; ++gi) { const int j = 2 * gi + h; const bool valid = j <= cur, forced = (j == 0) || (j == cur) || (j == cur - 1);
                impL[tau * 64 + j] = forced ? INFINITY : (valid ? 0.f : -INFINITY); }
        }
        f32x16_t oc[2]; oc[0] = (f32x16_t){}; oc[1] = (f32x16_t){};
        float carry = 0.f;
#pragma unroll 1
        for (int nt = 0; nt < ntl; ++nt) { f32x16_t sc = (f32x16_t){};
#pragma unroll
            for (int s = 0; s < 4; ++s) sc = __builtin_amdgcn_mfma_f32_32x32x16_f16(*(const h8_t*)(kc + (size_t)(32 * nt + r) * HD + 16 * s + 8 * h), qf[s], sc, 0, 0, 0);
#pragma unroll
            for (int reg = 0; reg < 16; ++reg) sc[reg] = (32 * nt + crow16(reg, h) < nvr) ? exp2f(sc[reg] - mx) * inv : 0.f;
#pragma unroll
            for (int s = 0; s < 2; ++s) { const h8_t pf = acc2frag(sc, s);
#pragma unroll
                for (int dt = 0; dt < 2; ++dt) oc[dt] = __builtin_amdgcn_mfma_f32_32x32x16_f16(ldfrag_perm(vt + (size_t)(32 * dt + r) * 256 + 32 * nt + 16 * s, h), pf, oc[dt], 0, 0, 0); }
#pragma unroll
            for (int qd = 0; qd < 4; ++qd) {
                const float G = (sc[4 * qd] + sc[4 * qd + 1]) + (sc[4 * qd + 2] + sc[4 * qd + 3]);
                const float ol = lshx(sc[4 * qd + 3], lane, 32);
                const float ol2 = lshx(qd == 0 ? carry : sc[4 * qd - 1], lane, 32);
                float v = G + ((h == 1) ? ol : ol2);
                v += lshx(v, lane, 8); v += lshx(v, lane, 16);
                const int j = 2 * (4 * nt + qd) + h; const bool valid = j <= cur, forced = (j == 0) || (j == cur) || (j == cur - 1);
                if (a == 0) impL[tau * 64 + j] = forced ? INFINITY : (valid ? v : -INFINITY); }
            carry = sc[15];
        }
#pragma unroll
        for (int dt = 0; dt < 2; ++dt)
#pragma unroll
            for (int reg = 0; reg < 16; ++reg) finL[16 * dt + reg] = oc[dt][reg] * g0;
        __builtin_amdgcn_wave_barrier();
        { const int tk = lane >> 3, part = lane & 7; float mine[8]; int rank[8];
#pragma unroll
          for (int e = 0; e < 8; ++e) { mine[e] = impL[tk * 64 + 8 * part + e]; rank[e] = 0; }
          for (int j4 = 0; j4 < 16; ++j4) { const f32x4_t o4 = *(const LAS f32x4_t*)(impL + tk * 64 + 4 * j4); const float ov[4] = {o4.x, o4.y, o4.z, o4.w};
#pragma unroll
              for (int c = 0; c < 4; ++c) { const int jj = 4 * j4 + c;
#pragma unroll
                  for (int e = 0; e < 8; ++e) rank[e] += (ov[c] > mine[e] || (ov[c] == mine[e] && jj < 8 * part + e)) ? 1 : 0; } }
          unsigned bits = 0;
#pragma unroll
          for (int e = 0; e < 8; ++e) bits |= ((rank[e] < NSEL) && (8 * part + e <= cur)) ? (1u << e) : 0u;
          unsigned lo = (part < 4) ? (bits << (8 * part)) : 0u, hi = (part >= 4) ? (bits << (8 * (part - 4))) : 0u;
#pragma unroll
          for (int o = 1; o < 8; o <<= 1) { lo |= lshx(lo, lane, o); hi |= lshx(hi, lane, o); }
          if (part == 0) { maskL[2 * tk] = lo; maskL[2 * tk + 1] = hi; } }
        __builtin_amdgcn_wave_barrier();
    }
    {
        unsigned ulo = 0, uhi = 0;
#pragma unroll
        for (int e = 0; e < 8; ++e) { ulo |= maskL[2 * e]; uhi |= maskL[2 * e + 1]; }
        ulo = __builtin_amdgcn_readfirstlane(ulo); uhi = __builtin_amdgcn_readfirstlane(uhi);
        const unsigned mlo = maskL[2 * tau], mhi = maskL[2 * tau + 1];
        const unsigned long long rowmask = ((unsigned long long)mhi << 32) | mlo; unsigned long long um = ((unsigned long long)uhi << 32) | ulo;
        AttnState st; st.o[0] = (f32x16_t){}; st.o[1] = (f32x16_t){}; st.m = -INFINITY; st.l = 0.f;
        const f16_t* Kp = KSR + (size_t)bg * NT * HD; const f16_t* Vp = VST + (size_t)bg * HD * NT;
        while (um) { const int j = __builtin_ctzll(um); um &= um - 1;
            nsa_tile<1>(st, Kp, Vp, 64 * j, qf, (rowmask >> j) & 1ull, 0, tr, r, h); }
        const float lt = st.l + lshx(st.l, lane, 32); const float sc1 = g1 / fmaxf(lt, 1e-30f);
#pragma unroll
        for (int dt = 0; dt < 2; ++dt)
#pragma unroll
            for (int reg = 0; reg < 16; ++reg) finL[16 * dt + reg] += st.o[dt][reg] * sc1;
    }
    f32x16_t fin[2];
    {
        AttnState st; st.o[0] = (f32x16_t){}; st.o[1] = (f32x16_t){}; st.m = -INFINITY; st.l = 0.f;
        const f16_t* Kp = KWR + (size_t)bg * NT * HD; const f16_t* Vp = VWT + (size_t)bg * HD * NT;
        const int lo = max(tr - WIN + 1, 0), j0 = max(t0 - WIN + 1, 0) >> 6;
        for (int j = j0; j <= cur; ++j) {
            if (j <= j0 + 1 || j == cur) nsa_tile<2>(st, Kp, Vp, 64 * j, qf, true, lo, tr, r, h);
            else nsa_tile<0>(st, Kp, Vp, 64 * j, qf, true, lo, tr, r, h); }
        const float lt = st.l + lshx(st.l, lane, 32); const float sc2 = g2 / fmaxf(lt, 1e-30f);
        fin[0] = st.o[0] * sc2; fin[1] = st.o[1] * sc2;
#pragma unroll
        for (int dt = 0; dt < 2; ++dt)
#pragma unroll
            for (int reg = 0; reg < 16; ++reg) fin[dt][reg] += finL[16 * dt + reg];
    }
    float ss = 0.f;
#pragma unroll
    for (int dt = 0; dt < 2; ++dt)
#pragma unroll
        for (int reg = 0; reg < 16; ++reg) ss += fin[dt][reg] * fin[dt][reg];
    ss += lshx(ss, lane, 32);
    const float rs = rsqrtf(ss * (1.f / HD) + EPS);
    f16_t* yp = Y + mrow * DM + 512 + hq * HD;
#pragma unroll
    for (int dt = 0; dt < 2; ++dt)
#pragma unroll
        for (int qd = 0; qd < 4; ++qd) { const int d = 32 * dt + 8 * qd + 4 * h; const f32x4_t gv = *(const f32x4_t*)(ng + d);
            u32x2_t w; w.x = pkh(fin[dt][4 * qd] * rs * gv.x, fin[dt][4 * qd + 1] * rs * gv.y); w.y = pkh(fin[dt][4 * qd + 2] * rs * gv.z, fin[dt][4 * qd + 3] * rs * gv.w);
            *(u32x2_t*)(yp + d) = w; }
}
__device__ __forceinline__ void nsa_block_unit(int q, LAS unsigned char* lds, int tid, LAS float* wl, int lane, int wave, const f16_t* Q16, const f16_t* KCMP16, const f16_t* VCMPT, const f16_t* KSR, const f16_t* VST, const f16_t* KWR, const f16_t* VWT,
                                         const float* GR32, const float* ng, f16_t* Y) {
    asm volatile("" : "+v"(lane));
    const int r = lane & 31, h = lane >> 5, tau = r & 7, a = r >> 3;
    const int cur = 63 - (q >> 3), qq = q & 7, b = qq >> 1, g = qq & 1, t0 = 64 * cur + 8 * wave, bg = b * NG + g, tr = t0 + tau, hq = 4 * g + a;
    const size_t mrow = (size_t)b * NT + tr;
    LAS float* impL = wl; LAS unsigned* maskL = (LAS unsigned*)(wl + 512);
    h8_t qf[4];
#pragma unroll
    for (int s = 0; s < 4; ++s) qf[s] = *(const h8_t*)(Q16 + mrow * 512 + hq * HD + 16 * s + 8 * h);
    const float* gr = GR32 + mrow * 24 + hq * 3;
    const float g0 = sigmf(gr[0]), g1 = sigmf(gr[1]), g2 = sigmf(gr[2]);
    LAS float* finL = wl + 640 + lane * 33;
    {
        const int nvr = (tr >= 31) ? (tr - 31) / 16 + 1 : 0;
        const int nvmax = (t0 + 7 >= 31) ? (t0 + 7 - 31) / 16 + 1 : 0; const int ntl = (nvmax + 31) >> 5;
        const f16_t* kc = KCMP16 + (size_t)bg * 256 * HD; const f16_t* vt = VCMPT + (size_t)bg * HD * 256;
        float mx = -INFINITY, sum = 0.f;
#pragma unroll 1
        for (int nt = 0; nt < ntl; ++nt) { f32x16_t sc = (f32x16_t){};
#pragma unroll
            for (int s = 0; s < 4; ++s) sc = __builtin_amdgcn_mfma_f32_32x32x16_f16(*(const h8_t*)(kc + (size_t)(32 * nt + r) * HD + 16 * s + 8 * h), qf[s], sc, 0, 0, 0);
#pragma unroll
            for (int reg = 0; reg < 16; ++reg) if (32 * nt + crow16(reg, h) < nvr) mx = fmaxf(mx, sc[reg]); }
        mx = fmaxf(mx, lshx(mx, lane, 32));
#pragma unroll 1
        for (int nt = 0; nt < ntl; ++nt) { f32x16_t sc = (f32x16_t){};
#pragma unroll
            for (int s = 0; s < 4; ++s) sc = __builtin_amdgcn_mfma_f32_32x32x16_f16(*(const h8_t*)(kc + (size_t)(32 * nt + r) * HD + 16 * s + 8 * h), qf[s], sc, 0, 0, 0);
#pragma unroll
            for (int reg = 0; reg < 16; ++reg) if (32 * nt + crow16(reg, h) < nvr) sum += exp2f(sc[reg] - mx); }
        sum += lshx(sum, lane, 32);
        const float inv = 1.f / fmaxf(sum, 1e-30f);
        if (a == 0) {
#pragma unroll
            for (int gi = 0; gi < 32; ++gi) { const int j = 2 * gi + h; const bool valid = j <= cur, forced = (j == 0) || (j == cur) || (j == cur - 1);
                impL[tau * 64 + j] = forced ? INFINITY : (valid ? 0.f : -INFINITY); }
        }
        f32x16_t oc[2]; oc[0] = (f32x16_t){}; oc[1] = (f32x16_t){};
        float carry = 0.f;
#pragma unroll 1
        for (int nt = 0; nt < ntl; ++nt) { f32x16_t sc = (f32x16_t){};
#pragma unroll
            for (int s = 0; s < 4; ++s) sc = __builtin_amdgcn_mfma_f32_32x32x16_f16(*(const h8_t*)(kc + (size_t)(32 * nt + r) * HD + 16 * s + 8 * h), qf[s], sc, 0, 0, 0);
#pragma unroll
            for (int reg = 0; reg < 16; ++reg) sc[reg] = (32 * nt + crow16(reg, h) < nvr) ? exp2f(sc[reg] - mx) * inv : 0.f;
#pragma unroll
            for (int s = 0; s < 2; ++s) { const h8_t pf = acc2frag(sc, s);
#pragma unroll
                for (int dt = 0; dt < 2; ++dt) oc[dt] = __builtin_amdgcn_mfma_f32_32x32x16_f16(ldfrag_perm(vt + (size_t)(32 * dt + r) * 256 + 32 * nt + 16 * s, h), pf, oc[dt], 0, 0, 0); }
#pragma unroll
            for (int qd = 0; qd < 4; ++qd) {
                const float G = (sc[4 * qd] + sc[4 * qd + 1]) + (sc[4 * qd + 2] + sc[4 * qd + 3]);
                const float ol = lshx(sc[4 * qd + 3], lane, 32);
                const float ol2 = lshx(qd == 0 ? carry : sc[4 * qd - 1], lane, 32);
                float v = G + ((h == 1) ? ol : ol2);
                v += lshx(v, lane, 8); v += lshx(v, lane, 16);
                const int j = 2 * (4 * nt + qd) + h; const bool valid = j <= cur, forced = (j == 0) || (j == cur) || (j == cur - 1);
                if (a == 0) impL[tau * 64 + j] = forced ? INFINITY : (valid ? v : -INFINITY); }
            carry = sc[15];
        }
#pragma unroll
        for (int dt = 0; dt < 2; ++dt)
#pragma unroll
            for (int reg = 0; reg < 16; ++reg) finL[16 * dt + reg] = oc[dt][reg] * g0;
        __builtin_amdgcn_wave_barrier();
        { const int tk = lane >> 3, part = lane & 7; float mine[8]; int rank[8];
#pragma unroll
          for (int e = 0; e < 8; ++e) { mine[e] = impL[tk * 64 + 8 * part + e]; rank[e] = 0; }
          for (int j4 = 0; j4 < 16; ++j4) { const f32x4_t o4 = *(const LAS f32x4_t*)(impL + tk * 64 + 4 * j4); const float ov[4] = {o4.x, o4.y, o4.z, o4.w};
#pragma unroll
              for (int c = 0; c < 4; ++c) { const int jj = 4 * j4 + c;
#pragma unroll
                  for (int e = 0; e < 8; ++e) rank[e] += (ov[c] > mine[e] || (ov[c] == mine[e] && jj < 8 * part + e)) ? 1 : 0; } }
          unsigned bits = 0;
#pragma unroll
          for (int e = 0; e < 8; ++e) bits |= ((rank[e] < NSEL) && (8 * part + e <= cur)) ? (1u << e) : 0u;
          unsigned lo = (part < 4) ? (bits << (8 * part)) : 0u, hi = (part >= 4) ? (bits << (8 * (part - 4))) : 0u;
#pragma unroll
          for (int o = 1; o < 8; o <<= 1) { lo |= lshx(lo, lane, o); hi |= lshx(hi, lane, o); }
          if (part == 0) { maskL[2 * tk] = lo; maskL[2 * tk + 1] = hi; } }
        __builtin_amdgcn_wave_barrier();
    }
    f32x16_t fin[2];
    {
        unsigned ulo = 0, uhi = 0;
#pragma unroll
        for (int e = 0; e < 8; ++e) { ulo |= maskL[2 * e]; uhi |= maskL[2 * e + 1]; }
        ulo = __builtin_amdgcn_readfirstlane(ulo); uhi = __builtin_amdgcn_readfirstlane(uhi);
        const unsigned mlo = maskL[2 * tau], mhi = maskL[2 * tau + 1];
        const unsigned long long rowmask = ((unsigned long long)mhi << 32) | mlo; const unsigned long long um = ((unsigned long long)uhi << 32) | ulo;
        AttnState st; st.o[0] = (f32x16_t){}; st.o[1] = (f32x16_t){}; st.m = -INFINITY; st.l = 0.f;
        const f16_t* Ks = KSR + (size_t)bg * NT * HD; const f16_t* Vs = VST + (size_t)bg * HD * NT;
        const f16_t* Kw = KWR + (size_t)bg * NT * HD; const f16_t* Vw = VWT + (size_t)bg * HD * NT;
        const int lo = max(tr - WIN + 1, 0), j0 = max(64 * cur - WIN + 1, 0) >> 6, nsel = cur + 1, ntile = nsel + (cur - j0 + 1);
        const int srow = tid >> 3, sch = tid & 7, soff = srow * 128 + ((sch ^ ((srow >> 1) & 7)) << 4);
        const int ro = r * 128, xs = ((r >> 1) & 7) << 4;
        LAS unsigned char* tb = lds + 90112;
        u32x4_t kreg, vreg;
        { kreg = *(const u32x4_t*)(Ks + (size_t)srow * HD + sch * 8); vreg = *(const u32x4_t*)(Vs + (size_t)srow * NT + sch * 8); }
        __syncthreads();
        *(LAS u32x4_t*)(tb + soff) = kreg; *(LAS u32x4_t*)(tb + 8192 + soff) = vreg;
        __syncthreads();
#pragma unroll 1
        for (int i = 0; i < ntile; ++i) {
            const bool isw = i >= nsel; const int j = isw ? (j0 + i - nsel) : i;
            if (i + 1 < ntile) { const bool nw = (i + 1) >= nsel; const int jn = nw ? (j0 + i + 1 - nsel) : (i + 1);
                const f16_t* kp = nw ? Kw : Ks; const f16_t* vp = nw ? Vw : Vs;
                kreg = *(const u32x4_t*)(kp + (size_t)(64 * jn + srow) * HD + sch * 8); vreg = *(const u32x4_t*)(vp + (size_t)srow * NT + 64 * jn + sch * 8); }
            if (i == nsel) {
                const float lt = st.l + lshx(st.l, lane, 32); const float sc1 = g1 / fmaxf(lt, 1e-30f);
#pragma unroll
                for (int dt = 0; dt < 2; ++dt)
#pragma unroll
                    for (int reg = 0; reg < 16; ++reg) finL[16 * dt + reg] += st.o[dt][reg] * sc1;
                st.o[0] = (f32x16_t){}; st.o[1] = (f32x16_t){}; st.m = -INFINITY; st.l = 0.f;
            }
            const LAS unsigned char* kb = tb + (i & 1) * 16384; const LAS unsigned char* vb = kb + 8192;
            if (!isw) { if ((um >> j) & 1ull) nsa_tile_lds<1>(st, kb, vb, 64 * j, qf, (rowmask >> j) & 1ull, 0, tr, r, h, ro, xs); }
            else if (j <= j0 + 2 || j == cur) nsa_tile_lds<2>(st, kb, vb, 64 * j, qf, true, lo, tr, r, h, ro, xs);
            else nsa_tile_lds<0>(st, kb, vb, 64 * j, qf, true, lo, tr, r, h, ro, xs);
            if (i + 1 < ntile) { LAS unsigned char* nb = tb + ((i + 1) & 1) * 16384; *(LAS u32x4_t*)(nb + soff) = kreg; *(LAS u32x4_t*)(nb + 8192 + soff) = vreg; }
            __syncthreads();
        }
        const float lt = st.l + lshx(st.l, lane, 32); const float sc2 = g2 / fmaxf(lt, 1e-30f);
        fin[0] = st.o[0] * sc2; fin[1] = st.o[1] * sc2;
#pragma unroll
        for (int dt = 0; dt < 2; ++dt)
#pragma unroll
            for (int reg = 0; reg < 16; ++reg) fin[dt][reg] += finL[16 * dt + reg];
    }
    float ss = 0.f;
#pragma unroll
    for (int dt = 0; dt < 2; ++dt)
#pragma unroll
        for (int reg = 0; reg < 16; ++reg) ss += fin[dt][reg] * fin[dt][reg];
    ss += lshx(ss, lane, 32);
    const float rs = rsqrtf(ss * (1.f / HD) + EPS);
    f16_t* yp = Y + mrow * DM + 512 + hq * HD;
#pragma unroll
    for (int dt = 0; dt < 2; ++dt)
#pragma unroll
        for (int qd = 0; qd < 4; ++qd) { const int d = 32 * dt + 8 * qd + 4 * h; const f32x4_t gv = *(const f32x4_t*)(ng + d);
            u32x2_t w; w.x = pkh(fin[dt][4 * qd] * rs * gv.x, fin[dt][4 * qd + 1] * rs * gv.y); w.y = pkh(fin[dt][4 * qd + 2] * rs * gv.z, fin[dt][4 * qd + 3] * rs * gv.w);
            *(u32x2_t*)(yp + d) = w; }
}
__device__ __forceinline__ void phase_nsa_blk(const Ctx& C, unsigned* counter, const f16_t* Q16, const f16_t* KCMP16, const f16_t* VCMPT, const f16_t* KSR, const f16_t* VST, const f16_t* KWR, const f16_t* VWT,
                                              const float* GR32, const float* ng, f16_t* Y) {
    LAS float* wl = (LAS float*)C.lds + C.wave * 2752;
    LAS unsigned* qw = (LAS unsigned*)(C.lds + 122880);
    for (;;) {
        __syncthreads();
        if (C.tid == 0) *qw = __hip_atomic_fetch_add(counter, 1u, __ATOMIC_RELAXED, __HIP_MEMORY_SCOPE_AGENT);
        __syncthreads();
        const unsigned q = (unsigned)__builtin_amdgcn_readfirstlane(*qw);
        if (q >= (unsigned)(NB * NG * NT / 64)) break;
        nsa_block_unit((int)q, C.lds, C.tid, wl, C.lane, C.wave, Q16, KCMP16, VCMPT, KSR, VST, KWR, VWT, GR32, ng, Y);
    }
}
__device__ __forceinline__ void phase_nsa(const Ctx& C, unsigned* counter, const f16_t* Q16, const f16_t* KCMP16, const f16_t* VCMPT, const f16_t* KSR, const f16_t* VST, const f16_t* KWR, const f16_t* VWT,
                                          const float* GR32, const float* ng, f16_t* Y) {
    LAS float* wl = (LAS float*)C.lds + C.wave * 2752;
    for (;;) {
        unsigned q = 0;
        if (C.lane == 0) q = __hip_atomic_fetch_add(counter, 1u, __ATOMIC_RELAXED, __HIP_MEMORY_SCOPE_AGENT);
        q = __builtin_amdgcn_readfirstlane(q);
        if (q >= (unsigned)(NB * NG * NT / 8)) break;
        nsa_unit((int)q, wl, C.lane, Q16, KCMP16, VCMPT, KSR, VST, KWR, VWT, GR32, ng, Y);
    }
}

__device__ __forceinline__ int my_tid(int wave_s) { return wave_s * 64 + (int)__builtin_amdgcn_mbcnt_hi(~0u, __builtin_amdgcn_mbcnt_lo(~0u, 0u)); }
template <class Epi> __device__ __forceinline__ void run_gemm(LAS unsigned char* lds, int wave_s, const f16_t* A, const f16_t* Bt, int N, int K, const Epi& E) {
    int bid = blockIdx.x, G = gridDim.x; asm volatile("" : "+s"(bid), "+s"(G));
    pg8::Gemm g{A, Bt, MR, N, K, 0}; pg8::StaticOrder S; S.init(MR, N, G, bid);
    pg8::gemm_phase<Epi, pg8::StaticOrder, true, true>(lds, g, S, E, my_tid(wave_s));
}
__device__ __forceinline__ Ctx make_ctx(LAS unsigned char* lds, int wave_s) {
    Ctx C; C.lds = lds; int t = my_tid(wave_s); asm volatile("" : "+v"(t));
    C.tid = t; C.lane = t & 63; C.wave = __builtin_amdgcn_readfirstlane(t >> 6);
    int bid = blockIdx.x, G = gridDim.x; asm volatile("" : "+s"(bid), "+s"(G));
    C.bid = bid; C.G = G; C.gw = C.bid * NWAVES + C.wave; C.NGW = C.G * NWAVES; return C;
}
#define MK_BAR(b_) XcdBarrier b_; b_.bar = WSP(unsigned, WS_CTL) + CW_BAR; { unsigned x_ = xb_xcc_id(); asm volatile("" : "+s"(x_)); b_.x = x_; } b_.st = (volatile LAS unsigned*)(lds + LDSCTL_OFF + 64)
#define GRID_BAR_FIRST() do { MK_BAR(b_); xcd_barrier(b_); } while (0)
#define GRID_BAR() do { MK_BAR(b_); xcd_barrier_fast(b_); } while (0)
#define MODL(l) (WSP(float, WS_MOD) + (size_t)(l) * NB * 9216)
template <int l> __device__ __forceinline__ void layer_body(LAS unsigned char* lds, const int wave_s) {
        { Ctx C = make_ctx(lds, wave_s); phase_norm(C, l == 0 ? PA(x) : (const float*)PA(out), PA(norm_g) + (size_t)(l * 3 + 0) * DM, MODL(l) + 0 * DM, MODL(l) + 1 * DM, WSP(f16_t, WS_HN)); }
        { Ctx C = make_ctx(lds, wave_s); phase_norm(C, l == 0 ? PA(x) : (const float*)PA(out), PA(norm_g) + (size_t)(l * 3 + 0) * DM, MODL(l) + 0 * DM, MODL(l) + 1 * DM, WSP(f16_t, WS_HN)); }
        GRID_BAR();
        run_gemm(lds, wave_s, WSP(f16_t, WS_HN), WSP(f16_t, WS_WT1) + (size_t)(l * 2 + 0) * 2 * FF * DM, 2 * FF, DM, pg8::EpiSwiglu{WSP(f16_t, WS_ACT)});
        GRID_BAR();
        run_gemm(lds, wave_s, WSP(f16_t, WS_ACT), WSP(f16_t, WS_WT2) + (size_t)(l * 2 + 0) * DM * FF, DM, FF, pg8::EpiResidual{l == 0 ? PA(x) : (const float*)PA(out), PA(out), MODL(l) + 2 * DM, 9216, 0.5f});
        GRID_BAR();
        { Ctx C = make_ctx(lds, wave_s); phase_norm(C, PA(out), PA(norm_g) + (size_t)(l * 3 + 1) * DM, MODL(l) + 3 * DM, MODL(l) + 4 * DM, WSP(f16_t, WS_HN)); }
        { Ctx C = make_ctx(lds, wave_s); phase_norm(C, PA(out), PA(norm_g) + (size_t)(l * 3 + 1) * DM, MODL(l) + 3 * DM, MODL(l) + 4 * DM, WSP(f16_t, WS_HN)); }
        GRID_BAR();
        run_gemm(lds, wave_s, WSP(f16_t, WS_HN), WSP(f16_t, WS_WTIN) + (size_t)l * NINP * DM, NINP, DM,
                 pg8::EpiInProj{WSP(f16_t, WS_C16), WSP(f16_t, WS_Z16), WSP(float, WS_AB32), WSP(float, WS_QN32), WSP(float, WS_KC32), WSP(f16_t, WS_KV16), WSP(float, WS_GR32)});
        GRID_BAR();
        { Ctx C = make_ctx(lds, wave_s); phase_gdn_prep(C, WSP(f16_t, WS_C16), PA(conv_w) + (size_t)l * 4 * 1536, WSP(float, WS_AB32), PA(a_log) + l * 4, PA(dt_bias) + l * 4,
                                                WSP(f16_t, WS_GQ), WSP(f16_t, WS_GK), WSP(f16_t, WS_GV), WSP(float, WS_GG), WSP(float, WS_GB)); }
        { Ctx C = make_ctx(lds, wave_s); phase_nsa_prep(C, PA(positions), WSP(float, WS_QN32), WSP(float, WS_KC32), WSP(f16_t, WS_KV16), WSP(f16_t, WS_Q16), WSP(f16_t, WS_KCR), WSP(f16_t, WS_KSR), WSP(f16_t, WS_KWR),
                                                WSP(f16_t, WS_VC16)); }
        GRID_BAR();
        { Ctx C = make_ctx(lds, wave_s); phase_compress_mfma(C, 0, WSP(f16_t, WS_KCR), WSP(f16_t, WS_VC16), WSP(f16_t, WS_W1C) + (size_t)l * 2 * 128 * 2048, WSP(f16_t, WS_W2C) + (size_t)l * 2 * 64 * 128,
                                                     WSP(float, WS_C1) + l * 256, WSP(f16_t, WS_KCMP16), WSP(f16_t, WS_VCMPT)); }
        { Ctx C = make_ctx(lds, wave_s); phase_nsa_vtrans(C, WSP(f16_t, WS_KV16), WSP(f16_t, WS_VST), WSP(f16_t, WS_VWT)); }
        { Ctx C = make_ctx(lds, wave_s); phase_gdn_chunk(C, WSP(f16_t, WS_GQ), WSP(f16_t, WS_GK), WSP(f16_t, WS_GV), WSP(float, WS_GG), WSP(float, WS_GB), WSP(f16_t, WS_UIMG), WSP(f16_t, WS_ATT), WSP(float, WS_DL)); }
        GRID_BAR();
        { Ctx C = make_ctx(lds, wave_s); if (C.bid < NB * GH) phase_gdn_scan(C, C.bid, WSP(f16_t, WS_GQ), WSP(f16_t, WS_GK), WSP(f16_t, WS_GV), WSP(f16_t, WS_UIMG), WSP(f16_t, WS_ATT), WSP(float, WS_DL), WSP(f16_t, WS_OG16)); }
        { Ctx C = make_ctx(lds, wave_s); phase_nsa_blk(C, WSP(unsigned, WS_CTL) + CW_NSA + 64 * l, WSP(f16_t, WS_Q16), WSP(f16_t, WS_KCMP16), WSP(f16_t, WS_VCMPT), WSP(f16_t, WS_KSR), WSP(f16_t, WS_VST), WSP(f16_t, WS_KWR), WSP(f16_t, WS_VWT),
                                           WSP(float, WS_GR32), PA(nsa_ng) + l * HD, WSP(f16_t, WS_HN)); }
        GRID_BAR();
        { Ctx C = make_ctx(lds, wave_s); phase_gdn_out16(C, WSP(f16_t, WS_OG16), WSP(f16_t, WS_Z16), PA(gdn_ng) + l * GD, WSP(f16_t, WS_HN)); }
        GRID_BAR();
        run_gemm(lds, wave_s, WSP(f16_t, WS_HN), WSP(f16_t, WS_WTOUT) + (size_t)l * DM * DM, DM, DM, pg8::EpiResidual{PA(out), PA(out), MODL(l) + 5 * DM, 9216, 1.0f});
        GRID_BAR();
        { Ctx C = make_ctx(lds, wave_s); phase_norm(C, PA(out), PA(norm_g) + (size_t)(l * 3 + 2) * DM, MODL(l) + 6 * DM, MODL(l) + 7 * DM, WSP(f16_t, WS_HN)); }
        { Ctx C = make_ctx(lds, wave_s); phase_norm(C, PA(out), PA(norm_g) + (size_t)(l * 3 + 2) * DM, MODL(l) + 6 * DM, MODL(l) + 7 * DM, WSP(f16_t, WS_HN)); }
        GRID_BAR();
        run_gemm(lds, wave_s, WSP(f16_t, WS_HN), WSP(f16_t, WS_WT1) + (size_t)(l * 2 + 1) * 2 * FF * DM, 2 * FF, DM, pg8::EpiSwiglu{WSP(f16_t, WS_ACT)});
        GRID_BAR();
        run_gemm(lds, wave_s, WSP(f16_t, WS_ACT), WSP(f16_t, WS_WT2) + (size_t)(l * 2 + 1) * DM * FF, DM, FF, pg8::EpiResidual{PA(out), PA(out), MODL(l) + 8 * DM, 9216, 0.5f});
        GRID_BAR();
}
__global__ void __launch_bounds__(NTHR, 2) mega_fwd(Params p_unused) {
    extern __shared__ __attribute__((aligned(16))) unsigned char lds_raw[];
    LAS unsigned char* lds = (LAS unsigned char*)lds_raw;
    const int wave_s = __builtin_amdgcn_readfirstlane(threadIdx.x >> 6);
    for (int u = threadIdx.x; u < (LDS_BYTES - LDSCTL_OFF) / 4; u += NTHR) ((LAS unsigned*)(lds + LDSCTL_OFF))[u] = 0u;
    __syncthreads();
    (void)xcd_barrier_post(WSP(unsigned, WS_CTL) + CW_BAR, (volatile LAS unsigned*)(lds + LDSCTL_OFF + 64));
    { Ctx C = make_ctx(lds, wave_s); phase_mod(C, PA(c), PA(ada_w), PA(ada_b), WSP(float, WS_MOD)); }
    { Ctx C = make_ctx(lds, wave_s); phase_wconv(C, WSP(f16_t, WS_WT1), WSP(f16_t, WS_WT2), WSP(f16_t, WS_WTIN), WSP(f16_t, WS_WTOUT)); }
    { Ctx C = make_ctx(lds, wave_s); phase_cmp_weights(C, WSP(f16_t, WS_W1C), WSP(f16_t, WS_W2C), WSP(float, WS_C1)); }
    GRID_BAR_FIRST();
    layer_body<0>(lds, wave_s);
    layer_body<1>(lds, wave_s);
    { Ctx C = make_ctx(lds, wave_s); phase_final_norm(C, PA(out), PA(final_g)); }
}

extern "C" void kernel_launch(void* const* d_in, const int* in_sizes, int n_in, void* d_out, int out_size, void* d_ws, size_t ws_size, hipStream_t stream) {
    static int grid = 0;
    if (grid == 0) {
        if (n_in != 22 || out_size != MR * DM || ws_size < WS_END + 4096) { fprintf(stderr, "kernel_launch: unexpected shapes (n_in %d out %d ws %zu)\n", n_in, out_size, ws_size); grid = -1; return; }
        int dev = 0, cus = 0, per_cu = 0;
        if (hipGetDevice(&dev) != hipSuccess || hipDeviceGetAttribute(&cus, hipDeviceAttributeMultiprocessorCount, dev) != hipSuccess) { grid = -1; return; }
        if (hipFuncSetAttribute((const void*)mega_fwd, hipFuncAttributeMaxDynamicSharedMemorySize, LDS_BYTES) != hipSuccess) { fprintf(stderr, "kernel_launch: hipFuncSetAttribute failed\n"); grid = -1; return; }
        if (hipOccupancyMaxActiveBlocksPerMultiprocessor(&per_cu, (const void*)mega_fwd, NTHR, LDS_BYTES) != hipSuccess || per_cu < 1) { fprintf(stderr, "kernel_launch: occupancy query says %d\n", per_cu); (void)hipGetLastError(); grid = -1; return; }
        grid = cus;
    }
    if (grid < 0) return;
    (void)hipMemsetAsync((char*)d_ws + WS_CTL, 0, CTL_ZERO_BYTES, stream);
    Params p{};
    p.x = (const float*)d_in[0]; p.c = (const float*)d_in[1]; p.positions = (const int*)d_in[2]; p.ada_w = (const float*)d_in[3]; p.ada_b = (const float*)d_in[4];
    p.norm_g = (const float*)d_in[5]; p.ffn_w_in = (const float*)d_in[6]; p.ffn_w_out = (const float*)d_in[7]; p.mix_w_in = (const float*)d_in[8]; p.conv_w = (const float*)d_in[9];
    p.a_log = (const float*)d_in[10]; p.dt_bias = (const float*)d_in[11]; p.gdn_ng = (const float*)d_in[12]; p.pe_k = (const float*)d_in[13]; p.w1_k = (const float*)d_in[14];
    p.w2_k = (const float*)d_in[15]; p.pe_v = (const float*)d_in[16]; p.w1_v = (const float*)d_in[17]; p.w2_v = (const float*)d_in[18]; p.nsa_ng = (const float*)d_in[19];
    p.mix_w_out = (const float*)d_in[20]; p.final_g = (const float*)d_in[21]; p.out = (float*)d_out; p.ws = (unsigned char*)d_ws;
    hipLaunchKernelGGL(mega_fwd, dim3(grid), dim3(NTHR), LDS_BYTES, stream, p);
}
```

```cpp
#include <hip/hip_runtime.h>
#include <cstdio>
#include <cstdint>

constexpr int NB = 4, NT = 4096, DM = 1024, MR = NB * NT, FF = 2816, NIN = 3360, NINP = 3584, DEPTH = 2;
constexpr int GH = 4, GD = 128, GW = 512;
constexpr int NH = 8, NG = 2, HD = 64;
constexpr int NCMP = 255, NBLK = 64, NSEL = 16, WIN = 512;
constexpr float EPS = 1e-6f;
constexpr size_t MiB = 1u << 20;
constexpr size_t WS_CTL = 0, WS_MOD = 1 * MiB, WS_WT1 = 4 * MiB, WS_WT2 = 48 * MiB, WS_WTIN = 70 * MiB, WS_WTOUT = 84 * MiB, WS_W1C = 88 * MiB,
                 WS_HN = 90 * MiB, WS_ACT = 122 * MiB, WS_C16 = 122 * MiB, WS_UIMG = 122 * MiB, WS_ATT = 138 * MiB, WS_DL = 146 * MiB, WS_Z16 = 170 * MiB, WS_KV16 = 186 * MiB,
                 WS_QN32 = 210 * MiB, WS_KC32 = 242 * MiB, WS_AB32 = 250 * MiB, WS_GR32 = 251 * MiB, WS_GQ = 253 * MiB, WS_GK = 269 * MiB, WS_GV = 285 * MiB,
                 WS_GG = 301 * MiB, WS_GB = 301 * MiB + 512 * 1024, WS_KCMP = 302 * MiB, WS_VCMP = 302 * MiB + 512 * 1024, WS_SEL = 303 * MiB, WS_OACC = 304 * MiB, WS_END = 336 * MiB,
                 WS_W2C = 2 * MiB, WS_C1 = 2 * MiB + 128 * 1024, WS_VST = 147 * MiB, WS_VWT = 151 * MiB, WS_KCMP16 = 302 * MiB, WS_VCMPT = 302 * MiB + 512 * 1024,
                 WS_Q16 = 304 * MiB, WS_KCR = 320 * MiB, WS_KSR = 324 * MiB, WS_KWR = 328 * MiB, WS_VC16 = 332 * MiB;
constexpr size_t WS_OG16 = 210 * MiB;
constexpr int CW_NSA = 8192;

typedef unsigned short f16_t;
typedef _Float16 h2_t __attribute__((ext_vector_type(2)));
typedef float f32x2_t __attribute__((ext_vector_type(2)));
typedef float f32x4_t __attribute__((ext_vector_type(4)));
typedef unsigned u32x4_t __attribute__((ext_vector_type(4)));
typedef unsigned u32x2_t __attribute__((ext_vector_type(2)));
__device__ __forceinline__ unsigned pkh(float lo, float hi) { f32x2_t v = {lo, hi}; h2_t h = __builtin_convertvector(v, h2_t); return __builtin_bit_cast(unsigned, h); }
__device__ __forceinline__ float h2f(f16_t u) { return (float)__builtin_bit_cast(_Float16, u); }
__device__ __forceinline__ f16_t f2h(float f) { return __builtin_bit_cast(f16_t, (_Float16)f); }
__device__ __forceinline__ float hlo(unsigned u) { return h2f((f16_t)(u & 0xffffu)); }
__device__ __forceinline__ float hhi(unsigned u) { return h2f((f16_t)(u >> 16)); }
__device__ __forceinline__ float siluf(float x) { return x / (1.f + __expf(-x)); }
__device__ __forceinline__ float sigmf(float x) { return 1.f / (1.f + __expf(-x)); }
__device__ __forceinline__ float lshx(float v, int lane, int m) { return __builtin_bit_cast(float, __builtin_amdgcn_ds_bpermute((lane ^ m) << 2, __builtin_bit_cast(int, v))); }
__device__ __forceinline__ unsigned lshx(unsigned v, int lane, int m) { return (unsigned)__builtin_amdgcn_ds_bpermute((lane ^ m) << 2, (int)v); }
__device__ __forceinline__ float lshf(float v, int src) { return __builtin_bit_cast(float, __builtin_amdgcn_ds_bpermute(src << 2, __builtin_bit_cast(int, v))); }
__device__ __forceinline__ float wave_sum(float v, int lane) {
#pragma unroll
    for (int o = 1; o < 64; o <<= 1) v += lshx(v, lane, o);
    return v;
}

namespace pg8 {
#define PG8_LAS __attribute__((address_space(3)))
typedef unsigned short bf16_t;
typedef _Float16 bf16x8 __attribute__((ext_vector_type(8)));
typedef float f32x4 __attribute__((ext_vector_type(4)));
typedef unsigned u32x4 __attribute__((ext_vector_type(4)));
constexpr int BM = 256, BK = 64, HALF = 128, HTB = HALF * BK * 2  , STAGE_BYTES = 8 * HTB, NXCD = 8, WGM = 8;

__host__ __device__ __forceinline__ int lds_byte(int r, int c) { const int st = (r >> 4) * 2 + (c >> 5), rr = r & 15, cc = c & 31, ob = rr * 64 + cc * 2; return st * 1024 + (ob ^ (((ob >> 9) & 1) << 5)); }
__host__ __device__ __forceinline__ void stage_rc(int b, int& R, int& C) { const int st = b / 1024, sb = b % 1024, swz = sb ^ (((sb >> 9) & 1) << 5); R = (st >> 1) * 16 + swz / 64; C = (st & 1) * 32 + (swz % 64) / 2; }
__host__ __device__ __forceinline__ int perm32(int rho) { const int n = rho >> 4, i = rho & 15; return 8 * (i >> 2) + 4 * n + (i & 3); }

struct Unit { int pm, pn; };
struct Gemm { const bf16_t* A; const bf16_t* Bt; int M, N, K, pad; };

struct StaticOrder {
    int nM, nN, nwg, G, c;
    __host__ __device__ void init(int M, int N, int G_, int c_) { nM = M / BM; nN = N / BM; nwg = nM * nN; G = G_; c = c_; }
    __host__ __device__ bool next(int i, Unit& u) const {
        const long L = (long)i * G + c; if (L >= nwg) return false;
        int wgid = (int)L; { const int q = nwg / NXCD, r = nwg % NXCD, xcd = wgid % NXCD, off = wgid / NXCD; wgid = (xcd < r ? xcd * (q + 1) : r * (q + 1) + (xcd - r) * q) + off; }
        const int nig = WGM * nN, gid = wgid / nig, fm = gid * WGM, gsz = (nM - fm) < WGM ? (nM - fm) : WGM;
        u.pm = fm + ((wgid % nig) % gsz); u.pn = (wgid % nig) / gsz; return true;
    }
    __device__ __forceinline__ void a_ready(const Unit&) const {}
    __device__ __forceinline__ void done(const Unit&) const {}
};


template <class Epi, class Sched, bool ALIGN_EPI = false, bool SP2 = false>
__device__ __forceinline__ void gemm_phase(PG8_LAS unsigned char* lds, const Gemm g, const Sched& S, const Epi& E, int tid_) {
    asm volatile("" : "+v"(tid_));
    const int tid = tid_, wid = __builtin_amdgcn_readfirstlane(tid >> 6), lane = tid & 63, wr = wid >> 2, wc = wid & 3, fr = lane & 15, fq = lane >> 4;
    const int K = g.K, nt = K / BK;
    unsigned voffA[2], voffB[2];
#pragma unroll
    for (int i = 0; i < 2; ++i) { int R, C; stage_rc(tid * 16 + i * 8192, R, C); const int Rb = Epi::PERM ? ((R & ~31) + perm32(R & 31)) : R;
        voffA[i] = (unsigned)(R * K + C) * 2u; voffB[i] = (unsigned)(Rb * K + C) * 2u; }
    const size_t kstep = (size_t)(BK * 2);
    const size_t hstep = (size_t)HALF * K * 2;
    const size_t tstep = 2 * hstep;
    const unsigned ldsw = (unsigned)wid * 1024u;
    const int aoff = lds_byte(wr * 64 + fr, fq * 8), boff = lds_byte(wc * 32 + fr, fq * 8);
#define PG8_SA(b, h) (((b) * 2 + (h)) * HTB)
#define PG8_SB(b, h) ((4 + (b) * 2 + (h)) * HTB)
#define PG8_STAGE(bufoff, gbase, voff) do { _Pragma("unroll") for (int _i = 0; _i < 2; ++_i) \
        __builtin_amdgcn_global_load_lds((const unsigned*)((const char*)(gbase) + (voff)[_i]), (PG8_LAS unsigned*)(lds + (bufoff) + ldsw + _i * 8192), 16, 0, 0); } while (0)
#define PG8_LDA(dst, b, h) do { _Pragma("unroll") for (int m = 0; m < 4; ++m) _Pragma("unroll") for (int k = 0; k < 2; ++k) dst[m][k] = *(const PG8_LAS bf16x8*)(lds + PG8_SA(b, h) + aoff + m * 2048 + k * 1024); } while (0)
#define PG8_LDB(dst, b, h) do { _Pragma("unroll") for (int n = 0; n < 2; ++n) _Pragma("unroll") for (int k = 0; k < 2; ++k) dst[n][k] = *(const PG8_LAS bf16x8*)(lds + PG8_SB(b, h) + boff + n * 2048 + k * 1024); } while (0)
#define PG8_MMA(ai, bj, At, Bt) do { __builtin_amdgcn_s_setprio(1); _Pragma("unroll") for (int m = 0; m < 4; ++m) _Pragma("unroll") for (int n = 0; n < 2; ++n) _Pragma("unroll") for (int k = 0; k < 2; ++k) \
        acc[ai][bj][m][n] = __builtin_amdgcn_mfma_f32_16x16x32_f16(Bt[n][k], At[m][k], acc[ai][bj][m][n], 0, 0, 0); __builtin_amdgcn_s_setprio(0); } while (0)
#define PG8_WAIT_V(n) asm volatile("s_waitcnt vmcnt(" #n ")" ::: "memory")
#define PG8_WAIT_L(n) asm volatile("s_waitcnt lgkmcnt(" #n ")" ::: "memory")
#define PG8_BAR __builtin_amdgcn_s_barrier()
#define PG8_SCHED __builtin_amdgcn_sched_barrier(0)
    Unit cur, nxt; int ui = 0;
    if (!S.next(0, cur)) return;
    f32x4 acc[2][2][4][2];
#pragma unroll
    for (int a = 0; a < 2; ++a)
#pragma unroll
        for (int b = 0; b < 2; ++b)
#pragma unroll
            for (int m = 0; m < 4; ++m)
#pragma unroll
                for (int n = 0; n < 2; ++n) acc[a][b][m][n] = (f32x4){0.f, 0.f, 0.f, 0.f};
    bf16x8 At[4][2], B0[2][2], B1[2][2];
    const char* cA = (const char*)g.A + (size_t)cur.pm * tstep; const char* cB = (const char*)g.Bt + (size_t)cur.pn * tstep;
    S.a_ready(cur);
    if constexpr (SP2) {
        PG8_STAGE(PG8_SB(0, 0), cB, voffB); PG8_STAGE(PG8_SB(0, 1), cB + hstep, voffB); PG8_STAGE(PG8_SA(0, 0), cA, voffA); PG8_STAGE(PG8_SA(0, 1), cA + hstep, voffA);
        if (wr == 1) PG8_BAR;
        PG8_WAIT_V(2); PG8_BAR;
        PG8_STAGE(PG8_SB(1, 0), cB + kstep, voffB); PG8_STAGE(PG8_SA(1, 0), cA + kstep, voffA); PG8_STAGE(PG8_SB(1, 1), cB + hstep + kstep, voffB);
        PG8_WAIT_V(6); PG8_BAR;
    } else {
        PG8_STAGE(PG8_SB(0, 0), cB, voffB); PG8_STAGE(PG8_SA(0, 0), cA, voffA); PG8_STAGE(PG8_SB(0, 1), cB + hstep, voffB); PG8_STAGE(PG8_SA(0, 1), cA + hstep, voffA);
        if (wr == 1) PG8_BAR;
        PG8_WAIT_V(4); PG8_BAR;
        PG8_STAGE(PG8_SB(1, 0), cB + kstep, voffB); PG8_STAGE(PG8_SA(1, 0), cA + kstep, voffA); PG8_STAGE(PG8_SB(1, 1), cB + hstep + kstep, voffB);
        PG8_WAIT_V(6); PG8_BAR;
    }
    for (;;) {
        const bool has_next = S.next(ui + 1, nxt);
        const char* nA = has_next ? (const char*)g.A + (size_t)nxt.pm * tstep : cA; const char* nB = has_next ? (const char*)g.Bt + (size_t)nxt.pn * tstep : cB;
        for (int t = 0; t < nt; t += 2) {
            const bool last = (t == nt - 2);
            const char* a1 = cA + (size_t)(t + 1) * kstep;
            const char* a2 = last ? nA : cA + (size_t)(t + 2) * kstep; const char* b2 = last ? nB : cB + (size_t)(t + 2) * kstep;
            const char* a3 = a2 + kstep; const char* b3 = b2 + kstep;
            if (last && has_next) S.a_ready(nxt);
            if constexpr (SP2) {
            PG8_LDB(B0, 0, 0); PG8_LDB(B1, 0, 1); PG8_SCHED; PG8_LDA(At, 0, 0); PG8_STAGE(PG8_SA(1, 1), a1 + hstep, voffA);
            PG8_WAIT_V(8); PG8_WAIT_L(0); PG8_BAR; PG8_MMA(0, 0, At, B0); PG8_MMA(0, 1, At, B1); PG8_BAR; PG8_SCHED;
            PG8_LDA(At, 0, 1); PG8_STAGE(PG8_SB(0, 0), b2, voffB); PG8_STAGE(PG8_SB(0, 1), b2 + hstep, voffB); PG8_STAGE(PG8_SA(0, 0), a2, voffA);
            PG8_WAIT_V(8); PG8_WAIT_L(0); PG8_BAR; PG8_MMA(1, 0, At, B0); PG8_MMA(1, 1, At, B1); PG8_BAR; PG8_SCHED;
            PG8_LDB(B0, 1, 0); PG8_LDB(B1, 1, 1); PG8_SCHED; PG8_LDA(At, 1, 0); PG8_STAGE(PG8_SA(0, 1), a2 + hstep, voffA);
            PG8_WAIT_V(8); PG8_WAIT_L(0); PG8_BAR; PG8_MMA(0, 0, At, B0); PG8_MMA(0, 1, At, B1); PG8_BAR; PG8_SCHED;
            PG8_LDA(At, 1, 1); PG8_STAGE(PG8_SB(1, 0), b3, voffB); PG8_STAGE(PG8_SB(1, 1), b3 + hstep, voffB); PG8_STAGE(PG8_SA(1, 0), a3, voffA);
            PG8_WAIT_V(8); PG8_WAIT_L(0); PG8_BAR; PG8_MMA(1, 0, At, B0); PG8_MMA(1, 1, At, B1); PG8_BAR; PG8_SCHED;
            } else {
            PG8_LDB(B0, 0, 0); PG8_SCHED; PG8_LDA(At, 0, 0); PG8_STAGE(PG8_SA(1, 1), a1 + hstep, voffA);
            PG8_WAIT_L(8); PG8_BAR; PG8_WAIT_L(0); PG8_MMA(0, 0, At, B0); PG8_BAR; PG8_SCHED;
            PG8_LDB(B1, 0, 1); PG8_STAGE(PG8_SB(0, 0), b2, voffB);
            PG8_BAR; PG8_WAIT_L(0); PG8_MMA(0, 1, At, B1); PG8_BAR;
            PG8_LDA(At, 0, 1); PG8_STAGE(PG8_SA(0, 0), a2, voffA);
            PG8_BAR; PG8_WAIT_L(0); PG8_MMA(1, 0, At, B0); PG8_BAR; PG8_SCHED;
            PG8_STAGE(PG8_SB(0, 1), b2 + hstep, voffB);
            PG8_WAIT_V(6); PG8_BAR; PG8_MMA(1, 1, At, B1); PG8_BAR;
            PG8_LDB(B0, 1, 0); PG8_SCHED; PG8_LDA(At, 1, 0); PG8_STAGE(PG8_SA(0, 1), a2 + hstep, voffA);
            PG8_WAIT_L(8); PG8_BAR; PG8_WAIT_L(0); PG8_MMA(0, 0, At, B0); PG8_BAR; PG8_SCHED;
            PG8_LDB(B1, 1, 1); PG8_STAGE(PG8_SB(1, 0), b3, voffB);
            PG8_BAR; PG8_WAIT_L(0); PG8_MMA(0, 1, At, B1); PG8_BAR;
            PG8_LDA(At, 1, 1); PG8_STAGE(PG8_SA(1, 0), a3, voffA);
            PG8_BAR; PG8_WAIT_L(0); PG8_MMA(1, 0, At, B0); PG8_BAR; PG8_SCHED;
            PG8_STAGE(PG8_SB(1, 1), b3 + hstep, voffB);
            PG8_WAIT_V(6); PG8_BAR; PG8_MMA(1, 1, At, B1); PG8_BAR;
            }
        }
        if constexpr (ALIGN_EPI) { if (wr == 0) PG8_BAR; }
        if constexpr (!Epi::AFTER_DRAIN) { E(acc, cur, wr, wc, fr, fq); S.done(cur); }
        if (!has_next) break;
#pragma unroll
        for (int a = 0; a < 2; ++a)
#pragma unroll
            for (int b = 0; b < 2; ++b)
#pragma unroll
                for (int m = 0; m < 4; ++m)
#pragma unroll
                    for (int n = 0; n < 2; ++n) acc[a][b][m][n] = (f32x4){0.f, 0.f, 0.f, 0.f};
        cur = nxt; cA = nA; cB = nB; ++ui;
        if constexpr (ALIGN_EPI) { if (wr == 1) PG8_BAR; }
    }
    PG8_WAIT_V(0);
    if constexpr (!ALIGN_EPI) { if (wr == 0) PG8_BAR; }
    PG8_BAR;
    if constexpr (Epi::AFTER_DRAIN) { E.fused(acc, cur, wr, wc, fr, fq, lds, wid, lane); S.done(cur); }
#undef PG8_SA
#undef PG8_SB
#undef PG8_STAGE
#undef PG8_LDA
#undef PG8_LDB
#undef PG8_MMA
#undef PG8_WAIT_V
#undef PG8_WAIT_L
#undef PG8_BAR
#undef PG8_SCHED
}
}

namespace pg8 {
struct EpiSwiglu {
    static constexpr bool PERM = true, AFTER_DRAIN = false;
    f16_t* O;
    __device__ __forceinline__ void operator()(const f32x4 (&acc)[2][2][4][2], const Unit& u, int wr, int wc, int fr, int fq) const {
        const int row0 = u.pm * BM + wr * 64 + fr, col0 = u.pn * 128 + wc * 32 + 8 * fq;
#pragma unroll
        for (int ai = 0; ai < 2; ++ai)
#pragma unroll
            for (int m = 0; m < 4; ++m) {
                const f32x4 g0 = acc[ai][0][m][0], g1 = acc[ai][0][m][1], u0 = acc[ai][1][m][0], u1 = acc[ai][1][m][1];
                u32x4 w;
                w.x = pkh(siluf(g0[0]) * u0[0], siluf(g0[1]) * u0[1]); w.y = pkh(siluf(g0[2]) * u0[2], siluf(g0[3]) * u0[3]);
                w.z = pkh(siluf(g1[0]) * u1[0], siluf(g1[1]) * u1[1]); w.w = pkh(siluf(g1[2]) * u1[2], siluf(g1[3]) * u1[3]);
                *(u32x4*)(O + (size_t)(row0 + ai * HALF + m * 16) * FF + col0) = w;
            }
    }
};
struct EpiResidual {
    static constexpr bool PERM = false, AFTER_DRAIN = false;
    const float* base; float* out; const float* gate; int gstride; float coef;
    __device__ __forceinline__ void operator()(const f32x4 (&acc)[2][2][4][2], const Unit& u, int wr, int wc, int fr, int fq) const {
        const int row0 = u.pm * BM + wr * 64 + fr, col0 = u.pn * BM + wc * 32 + 4 * fq;
        const float* gp = gate + (size_t)(u.pm / (NT / BM)) * gstride + col0;
        f32x4 gv[2][2];
#pragma unroll
        for (int bj = 0; bj < 2; ++bj)
#pragma unroll
            for (int n = 0; n < 2; ++n) gv[bj][n] = *(const f32x4*)(gp + bj * HALF + n * 16) * coef;
#pragma unroll
        for (int ai = 0; ai < 2; ++ai)
#pragma unroll
            for (int m = 0; m < 4; ++m) { const size_t off = (size_t)(row0 + ai * HALF + m * 16) * DM + col0;
#pragma unroll
                for (int bj = 0; bj < 2; ++bj)
#pragma unroll
                    for (int n = 0; n < 2; ++n) { const f32x4 bs = *(const f32x4*)(base + off + bj * HALF + n * 16);
                        *(f32x4*)(out + off + bj * HALF + n * 16) = bs + gv[bj][n] * acc[ai][bj][m][n]; } }
    }
};
struct EpiInProj {
    static constexpr bool PERM = true, AFTER_DRAIN = false;
    f16_t* C16; f16_t* Z16; float* AB32; float* QN32; float* KC32; f16_t* KV16; float* GR32;
    __device__ __forceinline__ void operator()(const f32x4 (&acc)[2][2][4][2], const Unit& u, int wr, int wc, int fr, int fq) const {
        const int row0 = u.pm * BM + wr * 64 + fr;
#pragma unroll
        for (int bj = 0; bj < 2; ++bj) {
            const int c0 = u.pn * BM + bj * HALF + wc * 32 + 8 * fq;
            int kind; size_t ld; int cc; void* basep;
            if (c0 < 1536)      { kind = 0; basep = C16;  ld = 1536; cc = c0; }
            else if (c0 < 2048) { kind = 0; basep = Z16;  ld = 512;  cc = c0 - 1536; }
            else if (c0 < 2056) { kind = 1; basep = AB32; ld = 8;    cc = 0; }
            else if (c0 < 2568) { kind = 1; basep = QN32; ld = 512;  cc = c0 - 2056; }
            else if (c0 < 2696) { kind = 1; basep = KC32; ld = 128;  cc = c0 - 2568; }
            else if (c0 < 3336) { kind = 0; basep = KV16; ld = 640;  cc = c0 - 2696; }
            else if (c0 < 3360) { kind = 1; basep = GR32; ld = 24;   cc = c0 - 3336; }
            else continue;
#pragma unroll
            for (int ai = 0; ai < 2; ++ai)
#pragma unroll
                for (int m = 0; m < 4; ++m) {
                    const size_t row = (size_t)(row0 + ai * HALF + m * 16);
                    const f32x4 v0 = acc[ai][bj][m][0], v1 = acc[ai][bj][m][1];
                    if (kind == 0) { u32x4 w; w.x = pkh(v0[0], v0[1]); w.y = pkh(v0[2], v0[3]); w.z = pkh(v1[0], v1[1]); w.w = pkh(v1[2], v1[3]);
                        *(u32x4*)((f16_t*)basep + row * ld + cc) = w; }
                    else { float* p = (float*)basep + row * ld + cc; *(f32x4*)p = v0; *(f32x4*)(p + 4) = v1; }
                }
        }
    }
};
}

#define GAS __attribute__((address_space(1)))
#define LAS __attribute__((address_space(3)))
typedef GAS unsigned gu32;
#define RLX_AGENT __ATOMIC_RELAXED, __HIP_MEMORY_SCOPE_AGENT
#define XB_TMO      128
#define XB_XCNT(j)  (256  + 64 * (j))
#define XB_XSUB(j)  (1280 + 64 * (j))
#define XB_XGEN(j)  (2304 + 64 * (j))
#define XB_TOP      3328
#define XB_TOPGEN   3392
#define XCD_BAR_WORDS 3456
#define XB_SPIN_CAP (1u << 18)

__device__ __forceinline__ unsigned xb_ld(unsigned* p)              { return __hip_atomic_load(p, __ATOMIC_RELAXED, __HIP_MEMORY_SCOPE_AGENT); }
__device__ __forceinline__ unsigned xb_add(unsigned* p, unsigned v) { return __hip_atomic_fetch_add(p, v, __ATOMIC_RELAXED, __HIP_MEMORY_SCOPE_AGENT); }
__device__ __forceinline__ unsigned xb_xcc_id() { return (unsigned)__builtin_amdgcn_s_getreg((3 << 11) | 20) & 0xFu; }
#define XB_SPIN(cond, bar) do { unsigned _sp = 0; while (cond) { __builtin_amdgcn_s_sleep(1); \
    if ((++_sp & 255u) == 0u) { if (xb_ld(&(bar)[XB_TMO])) break; if (_sp > XB_SPIN_CAP) { atomicAdd(&(bar)[XB_TMO], 1u); break; } } } } while (0)

struct XcdBarrier {
    unsigned* bar; unsigned x;
    volatile LAS unsigned* st;
};

__device__ __forceinline__ XcdBarrier xcd_barrier_post(unsigned* bar, volatile LAS unsigned* st) {
    XcdBarrier b; b.bar = bar; b.x = xb_xcc_id(); b.st = st;
    if (threadIdx.x == 0) (void)xb_add(&bar[XB_XCNT(b.x)], 1u);
    return b;
}
__device__ __forceinline__ void xcd_barrier_complete(unsigned* bar, unsigned x, unsigned& nloc, unsigned& nx) {
    const unsigned G = gridDim.x * gridDim.y * gridDim.z;
    unsigned sum, cnt, mine, sp = 0u;
    for (;;) {
        sum = 0u; cnt = 0u; mine = 0u;
#pragma unroll
        for (unsigned j = 0; j < 16; ++j) { const unsigned c = xb_ld(&bar[XB_XCNT(j)]); sum += c; cnt += (c > 0u) ? 1u : 0u; mine = (j == x) ? c : mine; }
        if (sum == G) break;
        __builtin_amdgcn_s_sleep(1);
        if ((++sp & 255u) == 0u) { if (xb_ld(&bar[XB_TMO])) break; if (sp > XB_SPIN_CAP) { atomicAdd(&bar[XB_TMO], 1u); break; } }
    }
    nloc = mine > 0u ? mine : 1u; nx = cnt > 0u ? cnt : 1u;
}

__device__ __forceinline__ void xcd_barrier(const XcdBarrier& b) {
    asm volatile("s_waitcnt vmcnt(0)" ::: "memory");
    __syncthreads();
    if (threadIdx.x == 0) {
        unsigned* bar = b.bar;
        __builtin_amdgcn_s_waitcnt(0);
        unsigned nloc = b.st[0], nx = b.st[1];
        if (nloc == 0u) { xcd_barrier_complete(bar, b.x, nloc, nx); b.st[0] = nloc; b.st[1] = nx; }
        const unsigned old = xb_add(&bar[XB_XSUB(b.x)], 1u);
        const unsigned gen = old / nloc;
        if (old + 1u == (gen + 1u) * nloc) {
            __builtin_amdgcn_fence(__ATOMIC_RELEASE, "agent");
            asm volatile("s_waitcnt vmcnt(0)" ::: "memory");
            const unsigned og = xb_add(&bar[XB_TOP], 1u);
            const unsigned tg = og / nx;
            if (og + 1u == (tg + 1u) * nx) xb_add(&bar[XB_TOPGEN], 1u);
            else XB_SPIN(xb_ld(&bar[XB_TOPGEN]) == tg, bar);
            __builtin_amdgcn_fence(__ATOMIC_ACQUIRE, "agent");
            xb_add(&bar[XB_XGEN(b.x)], 1u);
            asm volatile("s_waitcnt vmcnt(0)" ::: "memory");
        } else {
            XB_SPIN(xb_ld(&bar[XB_XGEN(b.x)]) == gen, bar);
            __builtin_amdgcn_fence(__ATOMIC_ACQUIRE, "agent");
            asm volatile("s_waitcnt vmcnt(0)" ::: "memory");
        }
    }
    __syncthreads();
}

__device__ __forceinline__ void xcd_barrier_fast(const XcdBarrier& b) {
    asm volatile("s_waitcnt vmcnt(0)" ::: "memory");
    __syncthreads();
    if (threadIdx.x == 0) {
        unsigned* bar = b.bar;
        __builtin_amdgcn_s_waitcnt(0);
        unsigned nloc = b.st[0], nx = b.st[1];
        const unsigned old = xb_add(&bar[XB_XSUB(b.x)], 1u);
        const unsigned gen = old / nloc;
        if (old + 1u == (gen + 1u) * nloc) {
            __builtin_amdgcn_fence(__ATOMIC_RELEASE, "agent");
            asm volatile("s_waitcnt vmcnt(0)" ::: "memory");
            const unsigned og = xb_add(&bar[XB_TOP], 1u);
            const unsigned tg = og / nx;
            if (og + 1u == (tg + 1u) * nx) xb_add(&bar[XB_TOPGEN], 1u);
            else XB_SPIN(xb_ld(&bar[XB_TOPGEN]) == tg, bar);
            __builtin_amdgcn_fence(__ATOMIC_ACQUIRE, "agent");
            xb_add(&bar[XB_XGEN(b.x)], 1u);
            asm volatile("s_waitcnt vmcnt(0)" ::: "memory");
        } else {
            XB_SPIN(xb_ld(&bar[XB_XGEN(b.x)]) == gen, bar);
            __builtin_amdgcn_fence(__ATOMIC_ACQUIRE, "agent");
            asm volatile("s_waitcnt vmcnt(0)" ::: "memory");
        }
    }
    __syncthreads();
}

constexpr int NWAVES = 8, NTHR = 512;
constexpr int RING_BYTES = 147456, LDSCTL_OFF = RING_BYTES, LDS_BYTES = 148480;
constexpr int CW_BAR = 4096;
constexpr size_t CTL_ZERO_BYTES = 64 * 1024;

struct Params {
    const float *x, *c; const int* positions; const float *ada_w, *ada_b, *norm_g, *ffn_w_in, *ffn_w_out, *mix_w_in, *conv_w, *a_log, *dt_bias, *gdn_ng,
                *pe_k, *w1_k, *w2_k, *pe_v, *w1_v, *w2_v, *nsa_ng, *mix_w_out, *final_g;
    float* out; unsigned char* ws;
};
struct Ctx { LAS unsigned char* lds; int tid, lane, wave, bid, G, gw, NGW; };
__device__ __forceinline__ const __attribute__((address_space(4))) Params* kargs() {
    const __attribute__((address_space(4))) Params* q = (const __attribute__((address_space(4))) Params*)__builtin_amdgcn_kernarg_segment_ptr();
    asm volatile("" : "+s"(q)); return q;
}
#define PA(f) (kargs()->f)
#define WSP(T, off) ((T*)(PA(ws) + (off)))

__device__ __forceinline__ void phase_mod(const Ctx& C, const float* c, const float* ada_w, const float* ada_b, float* mod) {
    LAS float* cond = (LAS float*)C.lds; LAS float* part = (LAS float*)(C.lds + 16384);
    for (int i = C.tid; i < NB * DM; i += NTHR) cond[i] = siluf(c[i]);
    __syncthreads();
    for (int item = C.bid; item < 2 * 9216 / 64; item += C.G) {
        const int col = item * 64 + C.lane, l = col / 9216, j = col % 9216;
        const float* w = ada_w + (size_t)l * DM * 9216 + j; const int k0 = C.wave * 128;
        float a0 = 0.f, a1 = 0.f, a2 = 0.f, a3 = 0.f;
#pragma unroll 32
        for (int k = k0; k < k0 + 128; ++k) { const float wv = w[(size_t)k * 9216]; a0 += cond[k] * wv; a1 += cond[DM + k] * wv; a2 += cond[2 * DM + k] * wv; a3 += cond[3 * DM + k] * wv; }
        part[(C.wave * 4 + 0) * 64 + C.lane] = a0; part[(C.wave * 4 + 1) * 64 + C.lane] = a1; part[(C.wave * 4 + 2) * 64 + C.lane] = a2; part[(C.wave * 4 + 3) * 64 + C.lane] = a3;
        __syncthreads();
        if (C.wave < 4) { float s = ada_b[l * 9216 + j];
#pragma unroll
            for (int w8 = 0; w8 < 8; ++w8) s += part[(w8 * 4 + C.wave) * 64 + C.lane];
            mod[((size_t)l * NB + C.wave) * 9216 + j] = s; }
        __syncthreads();
    }
}
__device__ __forceinline__ void wconv_item(const float* W, int K, int N, f16_t* WT, int k0, int n0, int r0, LAS float* scr, int lane) {
    float wv[32];
#pragma unroll
    for (int i = 0; i < 32; ++i) wv[i] = W[(size_t)(k0 + 2 * i + (lane >> 5)) * N + n0 + (lane & 31)];
#pragma unroll
    for (int i = 0; i < 32; ++i) scr[(2 * i + (lane >> 5)) * 33 + (lane & 31)] = wv[i];
    __builtin_amdgcn_wave_barrier();
    const int c = lane & 7;
#pragma unroll
    for (int j = 0; j < 4; ++j) { const int n = (lane >> 3) + 8 * j; const LAS float* s = scr + (8 * c) * 33 + n;
        u32x4_t o; o.x = pkh(s[0 * 33], s[1 * 33]); o.y = pkh(s[2 * 33], s[3 * 33]); o.z = pkh(s[4 * 33], s[5 * 33]); o.w = pkh(s[6 * 33], s[7 * 33]);
        *(u32x4_t*)(WT + (size_t)(r0 + n) * K + k0 + 8 * c) = o; }
    __builtin_amdgcn_wave_barrier();
}
__device__ __forceinline__ void phase_wconv(const Ctx& C, f16_t* WT1, f16_t* WT2, f16_t* WTIN, f16_t* WTOUT) {
    LAS float* scr = (LAS float*)(C.lds + 32768) + C.wave * (64 * 33);
    constexpr int I1 = 16 * 176, I2 = 44 * 32, I3 = 16 * 105, I4 = 16 * 32, T1 = 4 * I1, T2 = 4 * I2, T3 = 2 * I3, T4 = 2 * I4;
    for (int it = C.gw; it < T1 + T2 + T3 + T4; it += C.NGW) {
        int r = it;
        if (r < T1) { const int mi = r / I1, q = r % I1, kb = q / 176, nb = q % 176, n0 = 32 * nb, half = n0 / FF, jj = n0 % FF;
            wconv_item(PA(ffn_w_in) + (size_t)mi * DM * 2 * FF, DM, 2 * FF, WT1 + (size_t)mi * 2 * FF * DM, 64 * kb, n0, 256 * (jj / 128) + 128 * half + (jj % 128), scr, C.lane); continue; }
        r -= T1;
        if (r < T2) { const int mi = r / I2, q = r % I2, kb = q / 32, nb = q % 32;
            wconv_item(PA(ffn_w_out) + (size_t)mi * FF * DM, FF, DM, WT2 + (size_t)mi * DM * FF, 64 * kb, 32 * nb, 32 * nb, scr, C.lane); continue; }
        r -= T2;
        if (r < T3) { const int mi = r / I3, q = r % I3, kb = q / 105, nb = q % 105;
            wconv_item(PA(mix_w_in) + (size_t)mi * DM * NIN, DM, NIN, WTIN + (size_t)mi * NINP * DM, 64 * kb, 32 * nb, 32 * nb, scr, C.lane); continue; }
        r -= T3;
        { const int mi = r / I4, q = r % I4, kb = q / 32, nb = q % 32;
            wconv_item(PA(mix_w_out) + (size_t)mi * DM * DM, DM, DM, WTOUT + (size_t)mi * DM * DM, 64 * kb, 32 * nb, 32 * nb, scr, C.lane); }
    }
    constexpr int PADV = (NINP - NIN) * DM * 2 / 16;
    for (int i = C.bid * NTHR + C.tid; i < 2 * PADV; i += C.G * NTHR) { const int l = i / PADV, q = i % PADV;
        ((u32x4_t*)(WTIN + ((size_t)l * NINP + NIN) * DM))[q] = (u32x4_t){0u, 0u, 0u, 0u}; }
}
__device__ __forceinline__ void phase_norm(const Ctx& C, const float* x, const float* g, const float* shift, const float* scale, f16_t* hn) {
    for (int m = C.gw; m < MR; m += C.NGW) {
        const int b = m / NT; const f32x4_t* xr = (const f32x4_t*)(x + (size_t)m * DM) + C.lane;
        f32x4_t v[4]; float s = 0.f;
#pragma unroll
        for (int j = 0; j < 4; ++j) { v[j] = xr[64 * j]; s += v[j].x * v[j].x + v[j].y * v[j].y + v[j].z * v[j].z + v[j].w * v[j].w; }
        const float rstd = rsqrtf(wave_sum(s, C.lane) * (1.f / DM) + EPS);
        u32x2_t* o = (u32x2_t*)(hn + (size_t)m * DM) + C.lane;
#pragma unroll
        for (int j = 0; j < 4; ++j) {
            const f32x4_t gg = ((const f32x4_t*)g)[C.lane + 64 * j], sh = ((const f32x4_t*)(shift + (size_t)b * 9216))[C.lane + 64 * j], sc = ((const f32x4_t*)(scale + (size_t)b * 9216))[C.lane + 64 * j];
            const f32x4_t h = v[j] * rstd * gg * (sc + 1.f) + sh;
            u32x2_t w; w.x = pkh(h.x, h.y); w.y = pkh(h.z, h.w); o[64 * j] = w;
        }
    }
}
__device__ __forceinline__ void phase_final_norm(const Ctx& C, float* x, const float* g) {
    for (int m = C.gw; m < MR; m += C.NGW) {
        f32x4_t* xr = (f32x4_t*)(x + (size_t)m * DM) + C.lane;
        f32x4_t v[4]; float s = 0.f;
#pragma unroll
        for (int j = 0; j < 4; ++j) { v[j] = xr[64 * j]; s += v[j].x * v[j].x + v[j].y * v[j].y + v[j].z * v[j].z + v[j].w * v[j].w; }
        const float rstd = rsqrtf(wave_sum(s, C.lane) * (1.f / DM) + EPS);
#pragma unroll
        for (int j = 0; j < 4; ++j) xr[64 * j] = v[j] * rstd * ((const f32x4_t*)g)[C.lane + 64 * j];
    }
}
__device__ __forceinline__ void phase_gdn_prep(const Ctx& C, const f16_t* C16, const float* convw, const float* AB32, const float* a_log, const float* dt_bias,
                                               f16_t* GQ, f16_t* GK, f16_t* GV, float* Gg, float* Gb) {
    const int lane = C.lane;
    for (int it = C.gw; it < (MR / 8) * 12; it += C.NGW) {
        const int hs = it % 12, m0 = (it / 12) * 8, b = m0 / NT, t0 = m0 % NT; const int c = hs * 128 + 2 * lane;
        unsigned xv[11];
#pragma unroll
        for (int i = 0; i < 11; ++i) xv[i] = (t0 - 3 + i >= 0) ? *(const unsigned*)(C16 + (size_t)(m0 - 3 + i) * 1536 + c) : 0u;
        float w0[4], w1[4];
#pragma unroll
        for (int i = 0; i < 4; ++i) { w0[i] = convw[i * 1536 + c]; w1[i] = convw[i * 1536 + c + 1]; }
        const int which = hs >> 2, h = hs & 3;
        f16_t* dst = (which == 0 ? GQ : which == 1 ? GK : GV) + ((size_t)(b * GH + h) * NT + t0) * GD + 2 * lane;
#pragma unroll
        for (int j = 0; j < 8; ++j) {
            float y0 = 0.f, y1 = 0.f;
#pragma unroll
            for (int i = 0; i < 4; ++i) { y0 += hlo(xv[j + i]) * w0[i]; y1 += hhi(xv[j + i]) * w1[i]; }
            y0 = siluf(y0); y1 = siluf(y1);
            if (which < 2) { const float ss = wave_sum(y0 * y0 + y1 * y1, lane); float r = rsqrtf(ss + EPS); if (which == 0) r *= 0.08838834764831845f; y0 *= r; y1 *= r; }
            *(unsigned*)(dst + (size_t)j * GD) = pkh(y0, y1);
        }
        if (hs == 8 && lane < 32) { const int j = lane >> 2, hd = lane & 3; const size_t m = (size_t)m0 + j;
            const float braw = AB32[m * 8 + hd], araw = AB32[m * 8 + 4 + hd];
            const float xx = araw + dt_bias[hd]; const float sp = (xx > 20.f) ? xx : log1pf(__expf(xx));
            Gg[(size_t)(b * GH + hd) * NT + t0 + j] = -__expf(a_log[hd]) * sp;
            Gb[(size_t)(b * GH + hd) * NT + t0 + j] = sigmf(braw);
        }
    }
}
typedef _Float16 h8_t __attribute__((ext_vector_type(8)));
typedef _Float16 h4_t __attribute__((ext_vector_type(4)));
typedef float f32x16_t __attribute__((ext_vector_type(16)));
__device__ __forceinline__ h8_t ldfrag_perm(const f16_t* p16, int h) {
    const h4_t a = *(const h4_t*)(p16 + 4 * h), b = *(const h4_t*)(p16 + 8 + 4 * h);
    return (h8_t){a[0], a[1], a[2], a[3], b[0], b[1], b[2], b[3]};
}
__device__ __forceinline__ h8_t acc2frag(const f32x16_t& x, int s) {
    u32x4_t w; w.x = pkh(x[8 * s + 0], x[8 * s + 1]); w.y = pkh(x[8 * s + 2], x[8 * s + 3]); w.z = pkh(x[8 * s + 4], x[8 * s + 5]); w.w = pkh(x[8 * s + 6], x[8 * s + 7]);
    return __builtin_bit_cast(h8_t, w);
}
__device__ __forceinline__ int crow16(int reg, int h) { return (reg & 3) + 8 * (reg >> 2) + 4 * h; }

__device__ __forceinline__ void phase_gdn_chunk(const Ctx& C, f16_t* GQ, f16_t* GK, f16_t* GV, const float* Gg, const float* Gb, f16_t* UIMG, f16_t* ATT, float* DL) {
    const int hb = C.tid >> 8, th = C.tid & 255, lane = C.lane, hw = C.wave & 3, r = lane & 31, h = lane >> 5;
    LAS unsigned char* base = C.lds + hb * 65536;
    LAS f16_t* Kt = (LAS f16_t*)base;
    LAS f16_t* Qt = (LAS f16_t*)(base + 17408);
    LAS float* Lm = (LAS float*)(base + 34816);
    LAS float* gcs = (LAS float*)(base + 51200);
    for (int u = C.bid * 2 + hb; u < NB * GH * 64; u += C.G * 2) {
        const int bh = u >> 6, n = u & 63; const size_t row0 = (size_t)bh * NT + 64 * n;
        if (hw == 0) {
            float g = Gg[row0 + lane];
#pragma unroll
            for (int o = 1; o < 64; o <<= 1) { const float t = lshf(g, lane - o); if (lane >= o) g += t; }
            const float glast = lshf(g, 63);
            gcs[lane] = g; gcs[64 + lane] = __expf(g); gcs[128 + lane] = Gb[row0 + lane]; gcs[192 + lane] = __expf(glast - g);
            if (lane == 63) DL[u] = __expf(g);
        }
#pragma unroll
        for (int q = 0; q < 4; ++q) { const int idx = th + 256 * q, row = idx >> 4, ch = idx & 15;
            *(LAS u32x4_t*)(Kt + row * 136 + ch * 8) = *(const u32x4_t*)(GK + (row0 + row) * GD + ch * 8);
            *(LAS u32x4_t*)(Qt + row * 136 + ch * 8) = *(const u32x4_t*)(GQ + (row0 + row) * GD + ch * 8); }
        __syncthreads();
        { const int ti = hw >> 1, tj = hw & 1;
          f32x16_t kk = {}, qk = {};
          if (ti >= tj) {
#pragma unroll
              for (int s = 0; s < 8; ++s) {
                  const h8_t bk = *(const LAS h8_t*)(Kt + (32 * tj + r) * 136 + 16 * s + 8 * h);
                  const h8_t ak = *(const LAS h8_t*)(Kt + (32 * ti + r) * 136 + 16 * s + 8 * h);
                  const h8_t aq = *(const LAS h8_t*)(Qt + (32 * ti + r) * 136 + 16 * s + 8 * h);
                  kk = __builtin_amdgcn_mfma_f32_32x32x16_f16(ak, bk, kk, 0, 0, 0);
                  qk = __builtin_amdgcn_mfma_f32_32x32x16_f16(aq, bk, qk, 0, 0, 0);
              }
          }
          const int sidx = 32 * tj + r; const float gs = gcs[sidx];
          f16_t* att = ATT + (size_t)u * 4096;
#pragma unroll
          for (int reg = 0; reg < 16; ++reg) { const int c = 32 * ti + crow16(reg, h);
              const float dec = (sidx <= c) ? __expf(gcs[c] - gs) : 0.f;
              Lm[c * 64 + sidx] = (sidx < c) ? gcs[128 + c] * kk[reg] * dec : 0.f;
              att[c * 64 + sidx] = f2h(qk[reg] * dec); }
        }
        __syncthreads();
        float sol[64];
        { const bool isu = th < 128; const int col = th & 127;
#pragma unroll
          for (int c = 0; c < 64; ++c) { const float bc = gcs[128 + c];
              sol[c] = isu ? bc * h2f(GV[(row0 + c) * GD + col]) : bc * gcs[64 + c] * h2f(Kt[c * 136 + col]); }
#pragma unroll
          for (int c = 1; c < 64; ++c) { float a0 = 0.f, a1 = 0.f;
#pragma unroll
              for (int s4 = 0; s4 < (c + 3) / 4; ++s4) { const f32x4_t lv = *(const LAS f32x4_t*)(Lm + c * 64 + 4 * s4);
                  if (4 * s4 + 0 < c) a0 += lv.x * sol[4 * s4 + 0];
                  if (4 * s4 + 1 < c) a1 += lv.y * sol[4 * s4 + 1];
                  if (4 * s4 + 2 < c) a0 += lv.z * sol[4 * s4 + 2];
                  if (4 * s4 + 3 < c) a1 += lv.w * sol[4 * s4 + 3]; }
              sol[c] -= a0 + a1; }
        }
        __syncthreads();
        if (th < 128) {
            const int w = th >> 5, rr = th & 31; f16_t* up = UIMG + (size_t)u * 8192 + w * 2048;
#pragma unroll
            for (int tile = 0; tile < 2; ++tile)
#pragma unroll
                for (int hh = 0; hh < 2; ++hh) { u32x4_t o0, o1;
#define SOLV(reg) sol[32 * tile + ((reg) & 3) + 8 * ((reg) >> 2) + 4 * hh]
                    o0.x = pkh(SOLV(0), SOLV(1)); o0.y = pkh(SOLV(2), SOLV(3)); o0.z = pkh(SOLV(4), SOLV(5)); o0.w = pkh(SOLV(6), SOLV(7));
                    o1.x = pkh(SOLV(8), SOLV(9)); o1.y = pkh(SOLV(10), SOLV(11)); o1.z = pkh(SOLV(12), SOLV(13)); o1.w = pkh(SOLV(14), SOLV(15));
#undef SOLV
                    u32x4_t* dst = (u32x4_t*)(up + tile * 1024 + (rr + 32 * hh) * 16); dst[0] = o0; dst[1] = o1; }
        } else { const int col = th - 128;
#pragma unroll
            for (int c = 0; c < 64; ++c) GV[(row0 + c) * GD + col] = f2h(sol[c]); }
#pragma unroll
        for (int q = 0; q < 4; ++q) { const int idx = th + 256 * q, row = idx >> 4, ch = idx & 15; const float e = gcs[64 + row];
            const h8_t v = *(const LAS h8_t*)(Qt + row * 136 + ch * 8); u32x4_t o;
            o.x = pkh((float)v[0] * e, (float)v[1] * e); o.y = pkh((float)v[2] * e, (float)v[3] * e); o.z = pkh((float)v[4] * e, (float)v[5] * e); o.w = pkh((float)v[6] * e, (float)v[7] * e);
            *(u32x4_t*)(GQ + (row0 + row) * GD + ch * 8) = o; }
        { const int dk = th & 127, ch = th >> 7; f16_t* kd = GK + row0 * GD + dk * 64 + 32 * ch;
#pragma unroll
          for (int q = 0; q < 4; ++q) { float v[8];
#pragma unroll
              for (int e = 0; e < 8; ++e) { const int c = 32 * ch + 8 * q + e; v[e] = h2f(Kt[c * 136 + dk]) * gcs[192 + c]; }
              u32x4_t o; o.x = pkh(v[0], v[1]); o.y = pkh(v[2], v[3]); o.z = pkh(v[4], v[5]); o.w = pkh(v[6], v[7]);
              *(u32x4_t*)(kd + 8 * q) = o; } }
        __syncthreads();
    }
}

constexpr int SC_W = 0, SC_Q = 16384, SC_K = 32768, SC_A = 49152, SC_U = 57344, SC_BUF = 73728;
__device__ __forceinline__ h8_t lds_fragx(const LAS unsigned char* base, int rowoff, int xs, int c) {
    const h4_t a = *(const LAS h4_t*)(base + rowoff + ((c << 4) ^ xs)), b = *(const LAS h4_t*)(base + rowoff + (((c + 1) << 4) ^ xs));
    return (h8_t){a[0], a[1], a[2], a[3], b[0], b[1], b[2], b[3]};
}
__device__ __forceinline__ void scan_stage(const Ctx& C, LAS unsigned char* buf, const f16_t* Wg, const f16_t* Qg, const f16_t* Kg, const f16_t* Ag, const f16_t* Ug) {
    const int L = C.tid - 256;
    u32x4_t w[4], q[4], k[4], a[2], u[4];
#pragma unroll
    for (int i = 0; i < 4; ++i) { const int x = L + 256 * i; w[i] = ((const u32x4_t*)Wg)[x]; q[i] = ((const u32x4_t*)Qg)[x]; k[i] = ((const u32x4_t*)Kg)[x]; u[i] = ((const u32x4_t*)Ug)[x]; }
#pragma unroll
    for (int i = 0; i < 2; ++i) a[i] = ((const u32x4_t*)Ag)[L + 256 * i];
#pragma unroll
    for (int i = 0; i < 4; ++i) { const int x = L + 256 * i;
        { const int R = x >> 4, c = x & 15; *(LAS u32x4_t*)(buf + SC_W + R * 256 + ((c ^ (R & 15)) << 4)) = w[i]; *(LAS u32x4_t*)(buf + SC_Q + R * 256 + ((c ^ (R & 15)) << 4)) = q[i]; }
        { const int R = x >> 3, c = x & 7; *(LAS u32x4_t*)(buf + SC_K + R * 128 + ((c ^ ((R >> 1) & 7)) << 4)) = k[i]; }
        *(LAS u32x4_t*)(buf + SC_U + x * 16) = u[i]; }
#pragma unroll
    for (int i = 0; i < 2; ++i) { const int x = L + 256 * i, R = x >> 3, c = x & 7; *(LAS u32x4_t*)(buf + SC_A + R * 128 + ((c ^ ((R >> 1) & 7)) << 4)) = a[i]; }
}
__device__ __forceinline__ void phase_gdn_scan(const Ctx& C, int bh, const f16_t* QG, const f16_t* KDT, const f16_t* W, const f16_t* UIMG, const f16_t* ATT, const float* DL, f16_t* OG16) {
    const int lane = C.lane, r = lane & 31, h = lane >> 5, w = C.wave, b = bh / GH, hh = bh % GH;
    f32x16_t S[4];
#pragma unroll
    for (int T = 0; T < 4; ++T) S[T] = (f32x16_t){};
    __syncthreads();
    if (w >= 4) { const size_t row0 = (size_t)bh * NT; scan_stage(C, C.lds, W + row0 * GD, QG + row0 * GD, KDT + row0 * GD, ATT + (size_t)(bh * 64) * 4096, UIMG + (size_t)(bh * 64) * 8192); }
    __syncthreads();
#pragma unroll 1
    for (int n = 0; n < 64; ++n) {
        LAS unsigned char* cur = C.lds + (n & 1) * SC_BUF;
        if (w >= 4) {
            if (n + 1 < 64) { const size_t row0 = (size_t)bh * NT + 64 * (n + 1); const int u = bh * 64 + n + 1;
                scan_stage(C, C.lds + ((n + 1) & 1) * SC_BUF, W + row0 * GD, QG + row0 * GD, KDT + row0 * GD, ATT + (size_t)u * 4096, UIMG + (size_t)u * 8192); }
        } else {
            const int u = bh * 64 + n;
            const float dl = DL[u];
            int x256 = (r & 15) << 4, x128 = ((r >> 1) & 7) << 4, ro256 = r * 256 + 8 * h, ro128 = r * 128 + 8 * h;
            asm volatile("" : "+v"(x256), "+v"(x128), "+v"(ro256), "+v"(ro128));
            h8_t sf[4][2];
#pragma unroll
            for (int T = 0; T < 4; ++T) { sf[T][0] = acc2frag(S[T], 0); sf[T][1] = acc2frag(S[T], 1); }
            f32x16_t ws[2], qs[2];
#pragma unroll
            for (int ct = 0; ct < 2; ++ct) { ws[ct] = (f32x16_t){}; qs[ct] = (f32x16_t){};
#pragma unroll
                for (int T = 0; T < 4; ++T)
#pragma unroll
                    for (int s = 0; s < 2; ++s) {
                        ws[ct] = __builtin_amdgcn_mfma_f32_32x32x16_f16(lds_fragx(cur + SC_W + ct * 8192, ro256, x256, 4 * T + 2 * s), sf[T][s], ws[ct], 0, 0, 0);
                        qs[ct] = __builtin_amdgcn_mfma_f32_32x32x16_f16(lds_fragx(cur + SC_Q + ct * 8192, ro256, x256, 4 * T + 2 * s), sf[T][s], qs[ct], 0, 0, 0);
                        __builtin_amdgcn_sched_barrier(0);
                    } }
            h8_t vf[2][2];
#pragma unroll
            for (int ct = 0; ct < 2; ++ct) { const LAS h8_t* up = (const LAS h8_t*)(cur + SC_U + (w * 2048 + ct * 1024 + lane * 16) * 2); const h8_t u0 = up[0], u1 = up[1];
                f32x16_t vn;
#pragma unroll
                for (int e = 0; e < 8; ++e) { vn[e] = (float)u0[e] - ws[ct][e]; vn[8 + e] = (float)u1[e] - ws[ct][8 + e]; }
                vf[ct][0] = acc2frag(vn, 0); vf[ct][1] = acc2frag(vn, 1); }
#pragma unroll
            for (int ct = 0; ct < 2; ++ct)
#pragma unroll
                for (int c2 = 0; c2 < 2; ++c2)
#pragma unroll
                    for (int s = 0; s < 2; ++s)
                    { qs[ct] = __builtin_amdgcn_mfma_f32_32x32x16_f16(lds_fragx(cur + SC_A + ct * 4096, ro128, x128, 4 * c2 + 2 * s), vf[c2][s], qs[ct], 0, 0, 0); __builtin_amdgcn_sched_barrier(0); }
            { f16_t* op = OG16 + ((size_t)b * NT + 64 * n) * GW + hh * GD + 32 * w + r;
#pragma unroll
              for (int ct = 0; ct < 2; ++ct)
#pragma unroll
                  for (int reg = 0; reg < 16; ++reg) op[(size_t)(32 * ct + crow16(reg, h)) * GW] = f2h(qs[ct][reg]); }
#pragma unroll
            for (int T = 0; T < 4; ++T) { S[T] = S[T] * dl;
#pragma unroll
                for (int c2 = 0; c2 < 2; ++c2)
#pragma unroll
                    for (int s = 0; s < 2; ++s)
                    { S[T] = __builtin_amdgcn_mfma_f32_32x32x16_f16(lds_fragx(cur + SC_K + T * 4096, ro128, x128, 4 * c2 + 2 * s), vf[c2][s], S[T], 0, 0, 0); __builtin_amdgcn_sched_barrier(0); } }
        }
        __syncthreads();
    }
}
__device__ __forceinline__ void phase_gdn_out16(const Ctx& C, const f16_t* OG16, const f16_t* Z16, const float* ng, f16_t* Y) {
    const int lane = C.lane, hd = lane >> 4, c0 = (lane & 15) * 8;
    const f32x4_t ga = *(const f32x4_t*)(ng + c0), gb = *(const f32x4_t*)(ng + c0 + 4);
    const float gv[8] = {ga.x, ga.y, ga.z, ga.w, gb.x, gb.y, gb.z, gb.w};
    for (int m0 = C.gw * 4; m0 < MR; m0 += C.NGW * 4) {
        u32x4_t ov[4], zv[4];
#pragma unroll
        for (int i = 0; i < 4; ++i) { ov[i] = *(const u32x4_t*)(OG16 + (size_t)(m0 + i) * GW + lane * 8); zv[i] = *(const u32x4_t*)(Z16 + (size_t)(m0 + i) * GW + lane * 8); }
#pragma unroll
        for (int i = 0; i < 4; ++i) { const unsigned ou[4] = {ov[i].x, ov[i].y, ov[i].z, ov[i].w}, zu[4] = {zv[i].x, zv[i].y, zv[i].z, zv[i].w};
            float o[8], z[8], ss = 0.f;
#pragma unroll
            for (int e = 0; e < 4; ++e) { o[2 * e] = hlo(ou[e]); o[2 * e + 1] = hhi(ou[e]); z[2 * e] = hlo(zu[e]); z[2 * e + 1] = hhi(zu[e]); ss += o[2 * e] * o[2 * e] + o[2 * e + 1] * o[2 * e + 1]; }
            ss += lshx(ss, lane, 1); ss += lshx(ss, lane, 2); ss += lshx(ss, lane, 4); ss += lshx(ss, lane, 8);
            const float rr = rsqrtf(ss * (1.f / GD) + EPS);
            u32x4_t w; w.x = pkh(o[0] * rr * gv[0] * siluf(z[0]), o[1] * rr * gv[1] * siluf(z[1])); w.y = pkh(o[2] * rr * gv[2] * siluf(z[2]), o[3] * rr * gv[3] * siluf(z[3]));
            w.z = pkh(o[4] * rr * gv[4] * siluf(z[4]), o[5] * rr * gv[5] * siluf(z[5])); w.w = pkh(o[6] * rr * gv[6] * siluf(z[6]), o[7] * rr * gv[7] * siluf(z[7]));
            *(u32x4_t*)(Y + (size_t)(m0 + i) * DM + hd * GD + c0) = w; }
    }
}
constexpr float QSCALE = 0.125f * 1.4426950408889634f;
__device__ __forceinline__ void phase_nsa_prep(const Ctx& C, const int* positions, const float* QN32, const float* KC32, const f16_t* KV16,
                                               f16_t* Q16, f16_t* KCR, f16_t* KSR, f16_t* KWR, f16_t* VC16) {
    const int lane = C.lane, oct = lane & 7, seg = lane >> 4, g = (lane >> 3) & 1;
    const float invf = powf(500000.0f, -(float)oct * 0.125f);
    const int coff = (seg == 1) ? 128 : (seg == 2) ? 384 : 0;
    for (int m0 = C.gw * 4; m0 < MR; m0 += C.NGW * 4) {
        f32x4_t qa[4], qb[4], ka[4], kb[4]; u32x4_t kh[4]; float pos[4];
#pragma unroll
        for (int j = 0; j < 4; ++j) { const size_t m = (size_t)m0 + j; pos[j] = (float)positions[m];
            const f32x4_t* src = (const f32x4_t*)(QN32 + m * 512 + lane * 8); qa[j] = src[0]; qb[j] = src[1];
            if (seg == 0) { const f32x4_t* ks = (const f32x4_t*)(KC32 + m * 128 + (lane & 15) * 8); ka[j] = ks[0]; kb[j] = ks[1]; }
            else kh[j] = *(const u32x4_t*)(KV16 + m * 640 + coff + (lane & 15) * 8); }
#pragma unroll
        for (int j = 0; j < 4; ++j) { const int m = m0 + j, b = m / NT, t = m % NT;
            const float ang = pos[j] * invf; const float cs = cosf(ang), sn = sinf(ang);
            float cv[8], sv[8];
#pragma unroll
            for (int e = 0; e < 8; ++e) { cv[e] = lshf(cs, e); sv[e] = lshf(sn, e); }
            { const float v[8] = {qa[j].x, qa[j].y, qa[j].z, qa[j].w, qb[j].x, qb[j].y, qb[j].z, qb[j].w}; float o[8];
#pragma unroll
              for (int e = 0; e < 8; ++e) { const float pv = lshx(v[e], lane, 1); o[e] = (oct == 0) ? (v[e] * cv[e] - pv * sv[e]) : (oct == 1) ? (v[e] * cv[e] + pv * sv[e]) : v[e]; o[e] *= QSCALE; }
              u32x4_t w; w.x = pkh(o[0], o[1]); w.y = pkh(o[2], o[3]); w.z = pkh(o[4], o[5]); w.w = pkh(o[6], o[7]);
              *(u32x4_t*)(Q16 + (size_t)m * 512 + lane * 8) = w; }
            { float v[8];
              if (seg == 0) { v[0] = ka[j].x; v[1] = ka[j].y; v[2] = ka[j].z; v[3] = ka[j].w; v[4] = kb[j].x; v[5] = kb[j].y; v[6] = kb[j].z; v[7] = kb[j].w; }
              else { const unsigned ku[4] = {kh[j].x, kh[j].y, kh[j].z, kh[j].w};
#pragma unroll
                  for (int e = 0; e < 4; ++e) { v[2 * e] = hlo(ku[e]); v[2 * e + 1] = hhi(ku[e]); } }
              float o[8];
#pragma unroll
              for (int e = 0; e < 8; ++e) { const float pv = lshx(v[e], lane, 1); o[e] = (seg == 3) ? v[e] : (oct == 0) ? (v[e] * cv[e] - pv * sv[e]) : (oct == 1) ? (v[e] * cv[e] + pv * sv[e]) : v[e]; }
              u32x4_t w; w.x = pkh(o[0], o[1]); w.y = pkh(o[2], o[3]); w.z = pkh(o[4], o[5]); w.w = pkh(o[6], o[7]);
              f16_t* dst = (seg == 0 ? KCR : seg == 1 ? KSR : seg == 2 ? KWR : VC16) + ((size_t)(b * NG + g) * NT + t) * HD + oct * 8;
              *(u32x4_t*)dst = w; }
        }
    }
}
__device__ __forceinline__ void phase_nsa_vtrans(const Ctx& C, const f16_t* KV16, f16_t* VST, f16_t* VWT) {
    const int lane = C.lane;
    for (int it = C.gw; it < NB * NG * (NT / 64) * 2; it += C.NGW) {
        const int which = it & 1, tile = (it >> 1) % (NT / 64), bg = (it >> 1) / (NT / 64), b = bg / NG, g = bg % NG;
        const f16_t* src = KV16 + ((size_t)b * NT + tile * 64 + lane) * 640 + (which ? 512 : 256) + g * 64;
        f16_t* dst = (which ? VWT : VST) + (size_t)bg * HD * NT + tile * 64 + lane;
#pragma unroll
        for (int c8 = 0; c8 < 8; ++c8) { const u32x4_t w = *(const u32x4_t*)(src + c8 * 8); const unsigned ws[4] = {w.x, w.y, w.z, w.w};
#pragma unroll
            for (int i = 0; i < 4; ++i) { dst[(size_t)(c8 * 8 + 2 * i) * NT] = (f16_t)(ws[i] & 0xffffu); dst[(size_t)(c8 * 8 + 2 * i + 1) * NT] = (f16_t)(ws[i] >> 16); } }
    }
}

__device__ __forceinline__ void phase_cmp_weights(const Ctx& C, f16_t* W1C, f16_t* W2C, float* C1) {
    LAS float* scr = (LAS float*)(C.lds + 32768) + C.wave * (64 * 33);
    constexpr int I1 = 32 * 4;
    for (int it = C.gw; it < 4 * I1; it += C.NGW) { const int mi = it / I1, q = it % I1, kb = q / 4, nb = q % 4, l = mi >> 1, w = mi & 1;
        wconv_item((w ? PA(w1_v) : PA(w1_k)) + (size_t)l * 2048 * 128, 2048, 128, W1C + (size_t)mi * 128 * 2048, 64 * kb, 32 * nb, 32 * nb, scr, C.lane); }
    for (int i = C.bid * NTHR + C.tid; i < 4 * 64 * 128; i += C.G * NTHR) { const int mi = i / 8192, d = (i % 8192) / 128, hd = i % 128, l = mi >> 1, w = mi & 1;
        W2C[i] = f2h(((w ? PA(w2_v) : PA(w2_k)) + (size_t)l * 128 * 64)[hd * 64 + d]); }
    for (int i = C.NGW - 1 - C.gw; i < 4 * 128; i += C.NGW) { const int mi = i / 128, j = i % 128, l = mi >> 1, w = mi & 1;
        const float* pe = (w ? PA(pe_v) : PA(pe_k)) + (size_t)l * 2048; const float* w1 = (w ? PA(w1_v) : PA(w1_k)) + (size_t)l * 2048 * 128;
        float a = 0.f;
#pragma unroll
        for (int q = 0; q < 32; ++q) { const int k = C.lane + 64 * q; a += pe[k] * w1[(size_t)k * 128 + j]; }
        a = wave_sum(a, C.lane);
        if (C.lane == 0) C1[i] = a; }
}

__device__ __forceinline__ void phase_compress_mfma(const Ctx& C, int lastfirst, const f16_t* KCR, const f16_t* VC16, const f16_t* W1C, const f16_t* W2C, const float* C1, f16_t* KCMP16, f16_t* VCMPT) {
    const int lane = C.lane, r = lane & 31, h = lane >> 5, ht = C.wave & 3, hb = C.wave >> 2;
    (void)lastfirst;
    LAS float* part = (LAS float*)C.lds + hb * 8192;
    const int gb = (C.G - 1 - C.bid) * 2 + hb;
    for (int grp = gb; grp < 2 * NB * NG * 8; grp += C.G * 2) {
        const int rt = grp & 7, bg = (grp >> 3) % (NB * NG), which = grp / (8 * NB * NG);
        const f16_t* src = (which ? VC16 : KCR) + (size_t)bg * NT * HD + (size_t)(32 * rt + r) * 1024 + 8 * h;
        const f16_t* w1 = W1C + (size_t)which * 128 * 2048 + (size_t)(32 * ht + r) * 2048 + 8 * h;
        f32x16_t acc = (f32x16_t){};
#pragma unroll 16
        for (int ks = 0; ks < 128; ++ks) acc = __builtin_amdgcn_mfma_f32_32x32x16_f16(*(const h8_t*)(w1 + 16 * ks), *(const h8_t*)(src + 16 * ks), acc, 0, 0, 0);
#pragma unroll
        for (int reg = 0; reg < 16; ++reg) acc[reg] = siluf(acc[reg] + C1[which * 128 + 32 * ht + crow16(reg, h)]);
        const h8_t hf0 = acc2frag(acc, 0), hf1 = acc2frag(acc, 1);
        const f16_t* w2 = W2C + (size_t)which * 64 * 128;
#pragma unroll
        for (int dt = 0; dt < 2; ++dt) { f32x16_t o = (f32x16_t){};
            o = __builtin_amdgcn_mfma_f32_32x32x16_f16(ldfrag_perm(w2 + (32 * dt + r) * 128 + 32 * ht, h), hf0, o, 0, 0, 0);
            o = __builtin_amdgcn_mfma_f32_32x32x16_f16(ldfrag_perm(w2 + (32 * dt + r) * 128 + 32 * ht + 16, h), hf1, o, 0, 0, 0);
            LAS f32x4_t* pp = (LAS f32x4_t*)(part + ((ht * 2 + dt) * 64 + lane) * 16);
            pp[0] = (f32x4_t){o[0], o[1], o[2], o[3]}; pp[1] = (f32x4_t){o[4], o[5], o[6], o[7]}; pp[2] = (f32x4_t){o[8], o[9], o[10], o[11]}; pp[3] = (f32x4_t){o[12], o[13], o[14], o[15]}; }
        __syncthreads();
        { const int dt = ht >> 1, s = ht & 1;
          float v[8];
#pragma unroll
          for (int e = 0; e < 8; ++e) v[e] = 0.f;
#pragma unroll
          for (int k = 0; k < 4; ++k) { const LAS f32x4_t* pp = (const LAS f32x4_t*)(part + ((k * 2 + dt) * 64 + lane) * 16 + 8 * s); const f32x4_t a = pp[0], b2 = pp[1];
              v[0] += a.x; v[1] += a.y; v[2] += a.z; v[3] += a.w; v[4] += b2.x; v[5] += b2.y; v[6] += b2.z; v[7] += b2.w; }
          const int n = 32 * rt + r; const bool live = n < NCMP;
          if (which == 0) {
#pragma unroll
              for (int q = 0; q < 2; ++q) { u32x2_t w; w.x = live ? pkh(v[4 * q], v[4 * q + 1]) : 0u; w.y = live ? pkh(v[4 * q + 2], v[4 * q + 3]) : 0u;
                  *(u32x2_t*)(KCMP16 + ((size_t)bg * 256 + n) * HD + 32 * dt + 16 * s + 8 * q + 4 * h) = w; }
          } else {
#pragma unroll
              for (int e = 0; e < 8; ++e) VCMPT[((size_t)bg * HD + 32 * dt + crow16(8 * s + e, h)) * 256 + n] = live ? f2h(v[e]) : (f16_t)0;
          } }
        __syncthreads();
    }
}

struct AttnState { f32x16_t o[2]; float m, l; };
template <int MODE> __device__ __forceinline__ void nsa_tile(AttnState& st, const f16_t* Kp, const f16_t* Vtp, int key0, const h8_t (&qf)[4], bool rowsel, int tlo, int thi, int r, int h) {
    f32x16_t p[2];
#pragma unroll
    for (int kt = 0; kt < 2; ++kt) { p[kt] = (f32x16_t){};
#pragma unroll
        for (int s = 0; s < 4; ++s) p[kt] = __builtin_amdgcn_mfma_f32_32x32x16_f16(*(const h8_t*)(Kp + (size_t)(key0 + 32 * kt + r) * HD + 16 * s + 8 * h), qf[s], p[kt], 0, 0, 0); }
    float tm = -INFINITY;
#pragma unroll
    for (int kt = 0; kt < 2; ++kt)
#pragma unroll
        for (int reg = 0; reg < 16; ++reg) {
            if (MODE != 0) { const int key = key0 + 32 * kt + crow16(reg, h); const bool ok = (MODE == 1) ? (rowsel && key <= thi) : (key >= tlo && key <= thi); if (!ok) p[kt][reg] = -INFINITY; }
            tm = fmaxf(tm, p[kt][reg]); }
    tm = fmaxf(tm, lshx(tm, r + 32 * h, 32));
    if (__any(tm > st.m + 8.f)) {
        const float mn = fmaxf(st.m, tm); const float al = (mn == -INFINITY) ? 1.f : exp2f(st.m - mn);
        st.o[0] = st.o[0] * al; st.o[1] = st.o[1] * al; st.l *= al; st.m = mn;
    }
    float ps = 0.f;
#pragma unroll
    for (int kt = 0; kt < 2; ++kt)
#pragma unroll
        for (int reg = 0; reg < 16; ++reg) { const float e = (p[kt][reg] == -INFINITY) ? 0.f : exp2f(p[kt][reg] - st.m); p[kt][reg] = e; ps += e; }
    st.l += ps;
#pragma unroll
    for (int kt = 0; kt < 2; ++kt)
#pragma unroll
        for (int s = 0; s < 2; ++s) { const h8_t pf = acc2frag(p[kt], s);
#pragma unroll
            for (int dt = 0; dt < 2; ++dt) st.o[dt] = __builtin_amdgcn_mfma_f32_32x32x16_f16(ldfrag_perm(Vtp + (size_t)(32 * dt + r) * NT + key0 + 32 * kt + 16 * s, h), pf, st.o[dt], 0, 0, 0); }
}

template <int MODE> __device__ __forceinline__ void nsa_tile_lds(AttnState& st, const LAS unsigned char* kb, const LAS unsigned char* vb, int key0, const h8_t (&qf)[4], bool rowsel, int tlo, int thi, int r, int h, int ro, int xs) {
    f32x16_t p[2];
    const int hx = (h << 4) ^ xs;
#pragma unroll
    for (int kt = 0; kt < 2; ++kt) { p[kt] = (f32x16_t){};
#pragma unroll
        for (int s = 0; s < 4; ++s) p[kt] = __builtin_amdgcn_mfma_f32_32x32x16_f16(*(const LAS h8_t*)(kb + kt * 4096 + ro + ((s << 5) ^ hx)), qf[s], p[kt], 0, 0, 0); }
    float tm = -INFINITY;
#pragma unroll
    for (int kt = 0; kt < 2; ++kt)
#pragma unroll
        for (int reg = 0; reg < 16; ++reg) {
            if (MODE == 1 || MODE == 2) { const int key = key0 + 32 * kt + crow16(reg, h); const bool ok = (MODE == 1) ? (rowsel && key <= thi) : (key >= tlo && key <= thi); if (!ok) p[kt][reg] = -INFINITY; }
            tm = fmaxf(tm, p[kt][reg]); }
    if (MODE == 3) tm = rowsel ? tm : -INFINITY;
    tm = fmaxf(tm, lshx(tm, r + 32 * h, 32));
    if (__any(tm > st.m + 8.f)) {
        const float mn = fmaxf(st.m, tm); const float al = (mn == -INFINITY) ? 1.f : exp2f(st.m - mn);
        st.o[0] = st.o[0] * al; st.o[1] = st.o[1] * al; st.l *= al; st.m = mn;
    }
    float ps = 0.f; const float me = (MODE == 3 && !rowsel) ? INFINITY : ((st.m == -INFINITY) ? 0.f : st.m);
#pragma unroll
    for (int kt = 0; kt < 2; ++kt)
#pragma unroll
        for (int reg = 0; reg < 16; ++reg) { const float e = __builtin_amdgcn_exp2f(p[kt][reg] - me); p[kt][reg] = e; ps += e; }
    st.l += ps;
    const int rov = ro + 8 * h;
#pragma unroll
    for (int kt = 0; kt < 2; ++kt)
#pragma unroll
        for (int s = 0; s < 2; ++s) { const h8_t pf = acc2frag(p[kt], s);
#pragma unroll
            for (int dt = 0; dt < 2; ++dt) st.o[dt] = __builtin_amdgcn_mfma_f32_32x32x16_f16(lds_fragx(vb + dt * 4096, rov, xs, 4 * kt + 2 * s), pf, st.o[dt], 0, 0, 0); }
}

__device__ __forceinline__ void nsa_unit(int q, LAS float* wl, int lane, const f16_t* Q16, const f16_t* KCMP16, const f16_t* VCMPT, const f16_t* KSR, const f16_t* VST, const f16_t* KWR, const f16_t* VWT,
                                         const float* GR32, const float* ng, f16_t* Y) {
    asm volatile("" : "+v"(lane));
    const int r = lane & 31, h = lane >> 5, tau = r & 7, a = r >> 3;
    const int cur = 63 - (q >> 6), qq = q & 63, b = qq >> 4, g = (qq >> 3) & 1, t0 = 64 * cur + 8 * (qq & 7), bg = b * NG + g, tr = t0 + tau, hq = 4 * g + a;
    const size_t mrow = (size_t)b * NT + tr;
    LAS float* impL = wl; LAS unsigned* maskL = (LAS unsigned*)(wl + 512);
    h8_t qf[4];
#pragma unroll
    for (int s = 0; s < 4; ++s) qf[s] = *(const h8_t*)(Q16 + mrow * 512 + hq * HD + 16 * s + 8 * h);
    const float* gr = GR32 + mrow * 24 + hq * 3;
    const float g0 = sigmf(gr[0]), g1 = sigmf(gr[1]), g2 = sigmf(gr[2]);
    LAS float* finL = wl + 640 + lane * 33;
    {
        const int nvr = (tr >= 31) ? (tr - 31) / 16 + 1 : 0;
        const int nvmax = (t0 + 7 >= 31) ? (t0 + 7 - 31) / 16 + 1 : 0; const int ntl = (nvmax + 31) >> 5;
        const f16_t* kc = KCMP16 + (size_t)bg * 256 * HD; const f16_t* vt = VCMPT + (size_t)bg * HD * 256;
        float mx = -INFINITY, sum = 0.f;
#pragma unroll 1
        for (int nt = 0; nt < ntl; ++nt) { f32x16_t sc = (f32x16_t){};
#pragma unroll
            for (int s = 0; s < 4; ++s) sc = __builtin_amdgcn_mfma_f32_32x32x16_f16(*(const h8_t*)(kc + (size_t)(32 * nt + r) * HD + 16 * s + 8 * h), qf[s], sc, 0, 0, 0);
#pragma unroll
            for (int reg = 0; reg < 16; ++reg) if (32 * nt + crow16(reg, h) < nvr) mx = fmaxf(mx, sc[reg]); }
        mx = fmaxf(mx, lshx(mx, lane, 32));
#pragma unroll 1
        for (int nt = 0; nt < ntl; ++nt) { f32x16_t sc = (f32x16_t){};
#pragma unroll
            for (int s = 0; s < 4; ++s) sc = __builtin_amdgcn_mfma_f32_32x32x16_f16(*(const h8_t*)(kc + (size_t)(32 * nt + r) * HD + 16 * s + 8 * h), qf[s], sc, 0, 0, 0);
#pragma unroll
            for (int reg = 0; reg < 16; ++reg) if (32 * nt + crow16(reg, h) < nvr) sum += exp2f(sc[reg] - mx); }
        sum += lshx(sum, lane, 32);
        const float inv = 1.f / fmaxf(sum, 1e-30f);
        if (a == 0) {
#pragma unroll
            for (int gi = 0; gi < 32; ++gi) { const int j = 2 * gi + h; const bool valid = j <= cur, forced = (j == 0) || (j == cur) || (j == cur - 1);
                impL[tau * 64 + j] = forced ? INFINITY : (valid ? 0.f : -INFINITY); }
        }
        f32x16_t oc[2]; oc[0] = (f32x16_t){}; oc[1] = (f32x16_t){};
        float carry = 0.f;
#pragma unroll 1
        for (int nt = 0; nt < ntl; ++nt) { f32x16_t sc = (f32x16_t){};
#pragma unroll
            for (int s = 0; s < 4; ++s) sc = __builtin_amdgcn_mfma_f32_32x32x16_f16(*(const h8_t*)(kc + (size_t)(32 * nt + r) * HD + 16 * s + 8 * h), qf[s], sc, 0, 0, 0);
#pragma unroll
            for (int reg = 0; reg < 16; ++reg) sc[reg] = (32 * nt + crow16(reg, h) < nvr) ? exp2f(sc[reg] - mx) * inv : 0.f;
#pragma unroll
            for (int s = 0; s < 2; ++s) { const h8_t pf = acc2frag(sc, s);
#pragma unroll
                for (int dt = 0; dt < 2; ++dt) oc[dt] = __builtin_amdgcn_mfma_f32_32x32x16_f16(ldfrag_perm(vt + (size_t)(32 * dt + r) * 256 + 32 * nt + 16 * s, h), pf, oc[dt], 0, 0, 0); }
#pragma unroll
            for (int qd = 0; qd < 4; ++qd) {
                const float G = (sc[4 * qd] + sc[4 * qd + 1]) + (sc[4 * qd + 2] + sc[4 * qd + 3]);
                const float ol = lshx(sc[4 * qd + 3], lane, 32);
                const float ol2 = lshx(qd == 0 ? carry : sc[4 * qd - 1], lane, 32);
                float v = G + ((h == 1) ? ol : ol2);
                v += lshx(v, lane, 8); v += lshx(v, lane, 16);
                const int j = 2 * (4 * nt + qd) + h; const bool valid = j <= cur, forced = (j == 0) || (j == cur) || (j == cur - 1);
                if (a == 0) impL[tau * 64 + j] = forced ? INFINITY : (valid ? v : -INFINITY); }
            carry = sc[15];
        }
#pragma unroll
        for (int dt = 0; dt < 2; ++dt)
#pragma unroll
            for (int reg = 0; reg < 16; ++reg) finL[16 * dt + reg] = oc[dt][reg] * g0;
        __builtin_amdgcn_wave_barrier();
        { const int tk = lane >> 3, part = lane & 7; float mine[8]; int rank[8];
#pragma unroll
          for (int e = 0; e < 8; ++e) { mine[e] = impL[tk * 64 + 8 * part + e]; rank[e] = 0; }
          for (int j4 = 0; j4 < 16; ++j4) { const f32x4_t o4 = *(const LAS f32x4_t*)(impL + tk * 64 + 4 * j4); const float ov[4] = {o4.x, o4.y, o4.z, o4.w};
#pragma unroll
              for (int c = 0; c < 4; ++c) { const int jj = 4 * j4 + c;
#pragma unroll
                  for (int e = 0; e < 8; ++e) rank[e] += (ov[c] > mine[e] || (ov[c] == mine[e] && jj < 8 * part + e)) ? 1 : 0; } }
          unsigned bits = 0;
#pragma unroll
          for (int e = 0; e < 8; ++e) bits |= ((rank[e] < NSEL) && (8 * part + e <= cur)) ? (1u << e) : 0u;
          unsigned lo = (part < 4) ? (bits << (8 * part)) : 0u, hi = (part >= 4) ? (bits << (8 * (part - 4))) : 0u;
#pragma unroll
          for (int o = 1; o < 8; o <<= 1) { lo |= lshx(lo, lane, o); hi |= lshx(hi, lane, o); }
          if (part == 0) { maskL[2 * tk] = lo; maskL[2 * tk + 1] = hi; } }
        __builtin_amdgcn_wave_barrier();
    }
    {
        unsigned ulo = 0, uhi = 0;
#pragma unroll
        for (int e = 0; e < 8; ++e) { ulo |= maskL[2 * e]; uhi |= maskL[2 * e + 1]; }
        ulo = __builtin_amdgcn_readfirstlane(ulo); uhi = __builtin_amdgcn_readfirstlane(uhi);
        const unsigned mlo = maskL[2 * tau], mhi = maskL[2 * tau + 1];
        const unsigned long long rowmask = ((unsigned long long)mhi << 32) | mlo; unsigned long long um = ((unsigned long long)uhi << 32) | ulo;
        AttnState st; st.o[0] = (f32x16_t){}; st.o[1] = (f32x16_t){}; st.m = -INFINITY; st.l = 0.f;
        const f16_t* Kp = KSR + (size_t)bg * NT * HD; const f16_t* Vp = VST + (size_t)bg * HD * NT;
        while (um) { const int j = __builtin_ctzll(um); um &= um - 1;
            nsa_tile<1>(st, Kp, Vp, 64 * j, qf, (rowmask >> j) & 1ull, 0, tr, r, h); }
        const float lt = st.l + lshx(st.l, lane, 32); const float sc1 = g1 / fmaxf(lt, 1e-30f);
#pragma unroll
        for (int dt = 0; dt < 2; ++dt)
#pragma unroll
            for (int reg = 0; reg < 16; ++reg) finL[16 * dt + reg] += st.o[dt][reg] * sc1;
    }
    f32x16_t fin[2];
    {
        AttnState st; st.o[0] = (f32x16_t){}; st.o[1] = (f32x16_t){}; st.m = -INFINITY; st.l = 0.f;
        const f16_t* Kp = KWR + (size_t)bg * NT * HD; const f16_t* Vp = VWT + (size_t)bg * HD * NT;
        const int lo = max(tr - WIN + 1, 0), j0 = max(t0 - WIN + 1, 0) >> 6;
        for (int j = j0; j <= cur; ++j) {
            if (j <= j0 + 1 || j == cur) nsa_tile<2>(st, Kp, Vp, 64 * j, qf, true, lo, tr, r, h);
            else nsa_tile<0>(st, Kp, Vp, 64 * j, qf, true, lo, tr, r, h); }
        const float lt = st.l + lshx(st.l, lane, 32); const float sc2 = g2 / fmaxf(lt, 1e-30f);
        fin[0] = st.o[0] * sc2; fin[1] = st.o[1] * sc2;
#pragma unroll
        for (int dt = 0; dt < 2; ++dt)
#pragma unroll
            for (int reg = 0; reg < 16; ++reg) fin[dt][reg] += finL[16 * dt + reg];
    }
    float ss = 0.f;
#pragma unroll
    for (int dt = 0; dt < 2; ++dt)
#pragma unroll
        for (int reg = 0; reg < 16; ++reg) ss += fin[dt][reg] * fin[dt][reg];
    ss += lshx(ss, lane, 32);
    const float rs = rsqrtf(ss * (1.f / HD) + EPS);
    f16_t* yp = Y + mrow * DM + 512 + hq * HD;
#pragma unroll
    for (int dt = 0; dt < 2; ++dt)
#pragma unroll
        for (int qd = 0; qd < 4; ++qd) { const int d = 32 * dt + 8 * qd + 4 * h; const f32x4_t gv = *(const f32x4_t*)(ng + d);
            u32x2_t w; w.x = pkh(fin[dt][4 * qd] * rs * gv.x, fin[dt][4 * qd + 1] * rs * gv.y); w.y = pkh(fin[dt][4 * qd + 2] * rs * gv.z, fin[dt][4 * qd + 3] * rs * gv.w);
            *(u32x2_t*)(yp + d) = w; }
}
__device__ __forceinline__ void nsa_block_unit(int q, LAS unsigned char* lds, int tid, LAS float* wl, int lane, int wave, const f16_t* Q16, const f16_t* KCMP16, const f16_t* VCMPT, const f16_t* KSR, const f16_t* VST, const f16_t* KWR, const f16_t* VWT,
                                         const float* GR32, const float* ng, f16_t* Y) {
    asm volatile("" : "+v"(lane), "+v"(tid));
    const int r = lane & 31, h = lane >> 5, tau = r & 7, a = r >> 3;
    const int cur = 63 - (q >> 3), qq = q & 7, b = qq >> 1, g = qq & 1, t0 = 64 * cur + 8 * wave, bg = b * NG + g, tr = t0 + tau, hq = 4 * g + a;
    const size_t mrow = (size_t)b * NT + tr;
    LAS unsigned* impK = (LAS unsigned*)wl; LAS unsigned* maskL = (LAS unsigned*)(wl + 512);
    h8_t qf[4];
#pragma unroll
    for (int s = 0; s < 4; ++s) qf[s] = *(const h8_t*)(Q16 + mrow * 512 + hq * HD + 16 * s + 8 * h);
    const float* gr = GR32 + mrow * 24 + hq * 3;
    const float g0 = sigmf(gr[0]), g1 = sigmf(gr[1]), g2 = sigmf(gr[2]);
    LAS float* finL = wl + 640 + lane * 33;
    {
        const int nvr = (tr >= 31) ? (tr - 31) / 16 + 1 : 0;
        const int nvmax = (t0 + 7 >= 31) ? (t0 + 7 - 31) / 16 + 1 : 0; const int ntl = (nvmax + 31) >> 5;
        const f16_t* kc = KCMP16 + (size_t)bg * 256 * HD; const f16_t* vt = VCMPT + (size_t)bg * HD * 256;
        LAS unsigned char* cb = lds + 90112;
        const int ntb = min(8, ((64 * cur + 63 >= 31 ? (64 * cur + 63 - 31) / 16 + 1 : 0) + 31) >> 5);
        u32x4_t stg[4];
#pragma unroll
        for (int i = 0; i < 4; ++i) { const int x = tid + 512 * i; if ((x >> 8) < ntb) stg[i] = ((const u32x4_t*)kc)[x]; }
        __syncthreads();
#pragma unroll
        for (int i = 0; i < 4; ++i) { const int x = tid + 512 * i, R = x >> 3, c = x & 7; if ((x >> 8) < ntb) *(LAS u32x4_t*)(cb + R * 128 + ((c ^ ((R >> 1) & 7)) << 4)) = stg[i]; }
        __syncthreads();
        const int ro = r * 128, hx = (h << 4) ^ (((r >> 1) & 7) << 4);
        f32x16_t sc[8]; float mx = -INFINITY;
#pragma unroll
        for (int nt = 0; nt < 8; ++nt) { sc[nt] = (f32x16_t){};
            if (nt < ntl) {
#pragma unroll
                for (int s = 0; s < 4; ++s) sc[nt] = __builtin_amdgcn_mfma_f32_32x32x16_f16(*(const LAS h8_t*)(cb + nt * 4096 + ro + ((s << 5) ^ hx)), qf[s], sc[nt], 0, 0, 0);
            } }
#pragma unroll
        for (int i = 0; i < 4; ++i) { const int x = tid + 512 * i, d = x >> 5, c = x & 31; if ((c >> 2) < ntb) stg[i] = *(const u32x4_t*)(vt + (size_t)d * 256 + c * 8); }
        __syncthreads();
#pragma unroll
        for (int i = 0; i < 4; ++i) { const int x = tid + 512 * i, d = x >> 5, c = x & 31; if ((c >> 2) < ntb) *(LAS u32x4_t*)(cb + d * 512 + ((c ^ (d & 15)) << 4)) = stg[i]; }
        __syncthreads();
#pragma unroll
        for (int nt = 0; nt < 8; ++nt)
#pragma unroll
            for (int reg = 0; reg < 16; ++reg) { const bool ok = (nt < ntl) && (32 * nt + crow16(reg, h) < nvr); sc[nt][reg] = ok ? sc[nt][reg] : -INFINITY; mx = fmaxf(mx, sc[nt][reg]); }
        mx = fmaxf(mx, lshx(mx, lane, 32));
        const float mxe = (mx == -INFINITY) ? 0.f : mx;
        float sum = 0.f;
#pragma unroll
        for (int nt = 0; nt < 8; ++nt)
#pragma unroll
            for (int reg = 0; reg < 16; ++reg) { const float e = __builtin_amdgcn_exp2f(sc[nt][reg] - mxe); sc[nt][reg] = e; sum += e; }
        sum += lshx(sum, lane, 32);
        const float inv = 1.f / fmaxf(sum, 1e-30f);
        f32x16_t oc[2]; oc[0] = (f32x16_t){}; oc[1] = (f32x16_t){};
        float carry = 0.f;
#pragma unroll
        for (int nt = 0; nt < 8; ++nt) {
#pragma unroll
            for (int reg = 0; reg < 16; ++reg) sc[nt][reg] *= inv;
            if (nt < ntl) {
#pragma unroll
                for (int s = 0; s < 2; ++s) { const h8_t pf = acc2frag(sc[nt], s);
#pragma unroll
                    for (int dt = 0; dt < 2; ++dt) oc[dt] = __builtin_amdgcn_mfma_f32_32x32x16_f16(lds_fragx(cb + dt * 16384, r * 512 + 8 * h, (r & 15) << 4, 4 * nt + 2 * s), pf, oc[dt], 0, 0, 0); }
            }
            if (cur >= NSEL) {
#pragma unroll
            for (int qd = 0; qd < 4; ++qd) {
                const float G = (sc[nt][4 * qd] + sc[nt][4 * qd + 1]) + (sc[nt][4 * qd + 2] + sc[nt][4 * qd + 3]);
                const float ol = lshx(sc[nt][4 * qd + 3], lane, 32);
                const float ol2 = lshx(qd == 0 ? carry : sc[nt][4 * qd - 1], lane, 32);
                float v = G + ((h == 1) ? ol : ol2);
                v += lshx(v, lane, 8); v += lshx(v, lane, 16);
                const int j = 2 * (4 * nt + qd) + h; const bool valid = j <= cur, forced = (j == 0) || (j == cur) || (j == cur - 1);
                if (a == 0) impK[tau * 64 + j] = forced ? (0xFFFFFFC0u | (unsigned)(63 - j)) : (valid ? ((__float_as_uint(v) & 0xFFFFFFC0u) | (unsigned)(63 - j)) : 0u); }
            carry = sc[nt][15];
            }
        }
#pragma unroll
        for (int dt = 0; dt < 2; ++dt)
#pragma unroll
            for (int reg = 0; reg < 16; ++reg) finL[16 * dt + reg] = oc[dt][reg] * g0;
        __builtin_amdgcn_wave_barrier();
        if (cur >= NSEL) { const int tk = lane >> 3, part = lane & 7; unsigned mine[8]; int rank[8];
#pragma unroll
          for (int e = 0; e < 8; ++e) { mine[e] = impK[tk * 64 + 8 * part + e]; rank[e] = 0; }
          for (int j4 = 0; j4 < 16; ++j4) { const u32x4_t o4 = *(const LAS u32x4_t*)(impK + tk * 64 + 4 * j4); const unsigned ov[4] = {o4.x, o4.y, o4.z, o4.w};
#pragma unroll
              for (int c = 0; c < 4; ++c)
#pragma unroll
                  for (int e = 0; e < 8; ++e) rank[e] += (ov[c] > mine[e]) ? 1 : 0; }
          unsigned bits = 0;
#pragma unroll
          for (int e = 0; e < 8; ++e) bits |= ((rank[e] < NSEL) && (8 * part + e <= cur)) ? (1u << e) : 0u;
          unsigned lo = (part < 4) ? (bits << (8 * part)) : 0u, hi = (part >= 4) ? (bits << (8 * (part - 4))) : 0u;
#pragma unroll
          for (int o = 1; o < 8; o <<= 1) { lo |= lshx(lo, lane, o); hi |= lshx(hi, lane, o); }
          if (part == 0) { maskL[2 * tk] = lo; maskL[2 * tk + 1] = hi; } }
        else if (lane < 8) { maskL[2 * lane] = (2u << cur) - 1u; maskL[2 * lane + 1] = 0u; }
        __builtin_amdgcn_wave_barrier();
    }
    f32x16_t fin[2];
    {
        h8_t qf[4];
        { const f16_t* qp = Q16 + mrow * 512 + hq * HD + 8 * h; asm volatile("" : "+v"(qp));
#pragma unroll
          for (int s = 0; s < 4; ++s) qf[s] = *(const h8_t*)(qp + 16 * s); }
        unsigned ulo = 0, uhi = 0;
#pragma unroll
        for (int e = 0; e < 8; ++e) { ulo |= maskL[2 * e]; uhi |= maskL[2 * e + 1]; }
        ulo = __builtin_amdgcn_readfirstlane(ulo); uhi = __builtin_amdgcn_readfirstlane(uhi);
        const unsigned mlo = maskL[2 * tau], mhi = maskL[2 * tau + 1];
        const unsigned long long rowmask = ((unsigned long long)mhi << 32) | mlo; const unsigned long long um = ((unsigned long long)uhi << 32) | ulo;
        AttnState st; st.o[0] = (f32x16_t){}; st.o[1] = (f32x16_t){}; st.m = -INFINITY; st.l = 0.f;
        const f16_t* Ks = KSR + (size_t)bg * NT * HD; const f16_t* Vs = VST + (size_t)bg * HD * NT;
        const f16_t* Kw = KWR + (size_t)bg * NT * HD; const f16_t* Vw = VWT + (size_t)bg * HD * NT;
        const int lo = max(tr - WIN + 1, 0), j0 = max(64 * cur - WIN + 1, 0) >> 6, nsel = cur + 1, ntile = nsel + (cur - j0 + 1);
        const int srow = tid >> 3, sch = tid & 7, soff = srow * 128 + ((sch ^ ((srow >> 1) & 7)) << 4);
        const int ro = r * 128, xs = ((r >> 1) & 7) << 4;
        LAS unsigned char* tb = lds + 90112;
        u32x4_t kA, vA, kB, vB;
#define NSA_TILE_LOAD(KR, VR, idx) do { const int ii_ = (idx); if (ii_ < ntile) { const bool nw_ = ii_ >= nsel; const int jn_ = nw_ ? (j0 + ii_ - nsel) : ii_; const f16_t* kp_ = nw_ ? Kw : Ks; const f16_t* vp_ = nw_ ? Vw : Vs; \
            KR = *(const u32x4_t*)(kp_ + (size_t)(64 * jn_ + srow) * HD + sch * 8); VR = *(const u32x4_t*)(vp_ + (size_t)srow * NT + 64 * jn_ + sch * 8); } } while (0)
        kA = (u32x4_t){0u, 0u, 0u, 0u}; vA = kA; kB = kA; vB = kA;
        NSA_TILE_LOAD(kB, vB, 0); NSA_TILE_LOAD(kA, vA, 1);
        __syncthreads();
        *(LAS u32x4_t*)(tb + soff) = kB; *(LAS u32x4_t*)(tb + 8192 + soff) = vB;
        NSA_TILE_LOAD(kB, vB, 2);
        __syncthreads();
#define NSA_STEP(i, KR, VR) do { \
            const bool isw = (i) >= nsel; const int j = isw ? (j0 + (i) - nsel) : (i); \
            if ((i) == nsel) {                                        \
                const float lt = st.l + lshx(st.l, lane, 32); const float sc1 = g1 / fmaxf(lt, 1e-30f); \
                _Pragma("unroll") for (int dt = 0; dt < 2; ++dt) _Pragma("unroll") for (int reg = 0; reg < 16; ++reg) finL[16 * dt + reg] += st.o[dt][reg] * sc1; \
                st.o[0] = (f32x16_t){}; st.o[1] = (f32x16_t){}; st.m = -INFINITY; st.l = 0.f; \
            } \
            const LAS unsigned char* kb = tb + ((i) & 1) * 16384; const LAS unsigned char* vb = kb + 8192; \
            if (!isw) { if ((um >> j) & 1ull) { if (j == cur) nsa_tile_lds<1>(st, kb, vb, 64 * j, qf, (rowmask >> j) & 1ull, 0, tr, r, h, ro, xs); else nsa_tile_lds<3>(st, kb, vb, 64 * j, qf, (rowmask >> j) & 1ull, 0, tr, r, h, ro, xs); } } \
            else if (j <= j0 + 2 || j == cur) nsa_tile_lds<2>(st, kb, vb, 64 * j, qf, true, lo, tr, r, h, ro, xs); \
            else nsa_tile_lds<0>(st, kb, vb, 64 * j, qf, true, lo, tr, r, h, ro, xs); \
            if ((i) + 1 < ntile) { LAS unsigned char* nb = tb + (((i) + 1) & 1) * 16384; *(LAS u32x4_t*)(nb + soff) = KR; *(LAS u32x4_t*)(nb + 8192 + soff) = VR; } \
            NSA_TILE_LOAD(KR, VR, (i) + 3);                            \
            __syncthreads(); } while (0)
#pragma unroll 1
        for (int i = 0; i < ntile; i += 2) { NSA_STEP(i, kA, vA); if (i + 1 < ntile) NSA_STEP(i + 1, kB, vB); }
#undef NSA_STEP
#undef NSA_TILE_LOAD
        const float lt = st.l + lshx(st.l, lane, 32); const float sc2 = g2 / fmaxf(lt, 1e-30f);
        fin[0] = st.o[0] * sc2; fin[1] = st.o[1] * sc2;
#pragma unroll
        for (int dt = 0; dt < 2; ++dt)
#pragma unroll
            for (int reg = 0; reg < 16; ++reg) fin[dt][reg] += finL[16 * dt + reg];
    }
    float ss = 0.f;
#pragma unroll
    for (int dt = 0; dt < 2; ++dt)
#pragma unroll
        for (int reg = 0; reg < 16; ++reg) ss += fin[dt][reg] * fin[dt][reg];
    ss += lshx(ss, lane, 32);
    const float rs = rsqrtf(ss * (1.f / HD) + EPS);
    f16_t* yp = Y + mrow * DM + 512 + hq * HD;
#pragma unroll
    for (int dt = 0; dt < 2; ++dt)
#pragma unroll
        for (int qd = 0; qd < 4; ++qd) { const int d = 32 * dt + 8 * qd + 4 * h; const f32x4_t gv = *(const f32x4_t*)(ng + d);
            u32x2_t w; w.x = pkh(fin[dt][4 * qd] * rs * gv.x, fin[dt][4 * qd + 1] * rs * gv.y); w.y = pkh(fin[dt][4 * qd + 2] * rs * gv.z, fin[dt][4 * qd + 3] * rs * gv.w);
            *(u32x2_t*)(yp + d) = w; }
}
__device__ __forceinline__ void phase_nsa_blk(const Ctx& C, unsigned* counter, const f16_t* Q16, const f16_t* KCMP16, const f16_t* VCMPT, const f16_t* KSR, const f16_t* VST, const f16_t* KWR, const f16_t* VWT,
                                              const float* GR32, const float* ng, f16_t* Y) {
    LAS float* wl = (LAS float*)C.lds + C.wave * 2752;
    LAS unsigned* qw = (LAS unsigned*)(C.lds + 122880);
    for (;;) {
        __syncthreads();
        if (C.tid == 0) *qw = __hip_atomic_fetch_add(counter, 1u, __ATOMIC_RELAXED, __HIP_MEMORY_SCOPE_AGENT);
        __syncthreads();
        const unsigned q = (unsigned)__builtin_amdgcn_readfirstlane(*qw);
        if (q >= (unsigned)(NB * NG * NT / 64)) break;
        nsa_block_unit((int)q, C.lds, C.tid, wl, C.lane, C.wave, Q16, KCMP16, VCMPT, KSR, VST, KWR, VWT, GR32, ng, Y);
    }
}
__device__ __forceinline__ void phase_nsa(const Ctx& C, unsigned* counter, const f16_t* Q16, const f16_t* KCMP16, const f16_t* VCMPT, const f16_t* KSR, const f16_t* VST, const f16_t* KWR, const f16_t* VWT,
                                          const float* GR32, const float* ng, f16_t* Y) {
    LAS float* wl = (LAS float*)C.lds + C.wave * 2752;
    for (;;) {
        unsigned q = 0;
        if (C.lane == 0) q = __hip_atomic_fetch_add(counter, 1u, __ATOMIC_RELAXED, __HIP_MEMORY_SCOPE_AGENT);
        q = __builtin_amdgcn_readfirstlane(q);
        if (q >= (unsigned)(NB * NG * NT / 8)) break;
        nsa_unit((int)q, wl, C.lane, Q16, KCMP16, VCMPT, KSR, VST, KWR, VWT, GR32, ng, Y);
    }
}

__device__ __forceinline__ int my_tid(int wave_s) { return wave_s * 64 + (int)__builtin_amdgcn_mbcnt_hi(~0u, __builtin_amdgcn_mbcnt_lo(~0u, 0u)); }
template <class Epi> __device__ __forceinline__ void run_gemm(LAS unsigned char* lds, int wave_s, const f16_t* A, const f16_t* Bt, int N, int K, const Epi& E) {
    int bid = blockIdx.x, G = gridDim.x; asm volatile("" : "+s"(bid), "+s"(G));
    pg8::Gemm g{A, Bt, MR, N, K, 0}; pg8::StaticOrder S; S.init(MR, N, G, bid);
    pg8::gemm_phase<Epi, pg8::StaticOrder, true, true>(lds, g, S, E, my_tid(wave_s));
}
__device__ __forceinline__ Ctx make_ctx(LAS unsigned char* lds, int wave_s) {
    Ctx C; C.lds = lds; int t = my_tid(wave_s); asm volatile("" : "+v"(t));
    C.tid = t; C.lane = t & 63; C.wave = __builtin_amdgcn_readfirstlane(t >> 6);
    int bid = blockIdx.x, G = gridDim.x; asm volatile("" : "+s"(bid), "+s"(G));
    C.bid = bid; C.G = G; C.gw = C.bid * NWAVES + C.wave; C.NGW = C.G * NWAVES; return C;
}
#define MK_BAR(b_) XcdBarrier b_; b_.bar = WSP(unsigned, WS_CTL) + CW_BAR; { unsigned x_ = xb_xcc_id(); asm volatile("" : "+s"(x_)); b_.x = x_; } b_.st = (volatile LAS unsigned*)(lds + LDSCTL_OFF + 64)
#define GRID_BAR_FIRST() do { MK_BAR(b_); xcd_barrier(b_); } while (0)
#define GRID_BAR() do { MK_BAR(b_); xcd_barrier_fast(b_); } while (0)
#define MODL(l) (WSP(float, WS_MOD) + (size_t)(l) * NB * 9216)
template <int l> __device__ __forceinline__ void layer_body(LAS unsigned char* lds, const int wave_s) {
        { Ctx C = make_ctx(lds, wave_s); phase_norm(C, l == 0 ? PA(x) : (const float*)PA(out), PA(norm_g) + (size_t)(l * 3 + 0) * DM, MODL(l) + 0 * DM, MODL(l) + 1 * DM, WSP(f16_t, WS_HN)); }
        { Ctx C = make_ctx(lds, wave_s); phase_norm(C, l == 0 ? PA(x) : (const float*)PA(out), PA(norm_g) + (size_t)(l * 3 + 0) * DM, MODL(l) + 0 * DM, MODL(l) + 1 * DM, WSP(f16_t, WS_HN)); }
        GRID_BAR();
        run_gemm(lds, wave_s, WSP(f16_t, WS_HN), WSP(f16_t, WS_WT1) + (size_t)(l * 2 + 0) * 2 * FF * DM, 2 * FF, DM, pg8::EpiSwiglu{WSP(f16_t, WS_ACT)});
        GRID_BAR();
        run_gemm(lds, wave_s, WSP(f16_t, WS_ACT), WSP(f16_t, WS_WT2) + (size_t)(l * 2 + 0) * DM * FF, DM, FF, pg8::EpiResidual{l == 0 ? PA(x) : (const float*)PA(out), PA(out), MODL(l) + 2 * DM, 9216, 0.5f});
        GRID_BAR();
        { Ctx C = make_ctx(lds, wave_s); phase_norm(C, PA(out), PA(norm_g) + (size_t)(l * 3 + 1) * DM, MODL(l) + 3 * DM, MODL(l) + 4 * DM, WSP(f16_t, WS_HN)); }
        { Ctx C = make_ctx(lds, wave_s); phase_norm(C, PA(out), PA(norm_g) + (size_t)(l * 3 + 1) * DM, MODL(l) + 3 * DM, MODL(l) + 4 * DM, WSP(f16_t, WS_HN)); }
        GRID_BAR();
        run_gemm(lds, wave_s, WSP(f16_t, WS_HN), WSP(f16_t, WS_WTIN) + (size_t)l * NINP * DM, NINP, DM,
                 pg8::EpiInProj{WSP(f16_t, WS_C16), WSP(f16_t, WS_Z16), WSP(float, WS_AB32), WSP(float, WS_QN32), WSP(float, WS_KC32), WSP(f16_t, WS_KV16), WSP(float, WS_GR32)});
        GRID_BAR();
        { Ctx C = make_ctx(lds, wave_s); phase_gdn_prep(C, WSP(f16_t, WS_C16), PA(conv_w) + (size_t)l * 4 * 1536, WSP(float, WS_AB32), PA(a_log) + l * 4, PA(dt_bias) + l * 4,
                                                WSP(f16_t, WS_GQ), WSP(f16_t, WS_GK), WSP(f16_t, WS_GV), WSP(float, WS_GG), WSP(float, WS_GB)); }
        { Ctx C = make_ctx(lds, wave_s); phase_nsa_prep(C, PA(positions), WSP(float, WS_QN32), WSP(float, WS_KC32), WSP(f16_t, WS_KV16), WSP(f16_t, WS_Q16), WSP(f16_t, WS_KCR), WSP(f16_t, WS_KSR), WSP(f16_t, WS_KWR),
                                                WSP(f16_t, WS_VC16)); }
        GRID_BAR();
        { Ctx C = make_ctx(lds, wave_s); phase_compress_mfma(C, 0, WSP(f16_t, WS_KCR), WSP(f16_t, WS_VC16), WSP(f16_t, WS_W1C) + (size_t)l * 2 * 128 * 2048, WSP(f16_t, WS_W2C) + (size_t)l * 2 * 64 * 128,
                                                     WSP(float, WS_C1) + l * 256, WSP(f16_t, WS_KCMP16), WSP(f16_t, WS_VCMPT)); }
        { Ctx C = make_ctx(lds, wave_s); phase_nsa_vtrans(C, WSP(f16_t, WS_KV16), WSP(f16_t, WS_VST), WSP(f16_t, WS_VWT)); }
        { Ctx C = make_ctx(lds, wave_s); phase_gdn_chunk(C, WSP(f16_t, WS_GQ), WSP(f16_t, WS_GK), WSP(f16_t, WS_GV), WSP(float, WS_GG), WSP(float, WS_GB), WSP(f16_t, WS_UIMG), WSP(f16_t, WS_ATT), WSP(float, WS_DL)); }
        GRID_BAR();
        { Ctx C = make_ctx(lds, wave_s); if (C.bid < NB * GH) phase_gdn_scan(C, C.bid, WSP(f16_t, WS_GQ), WSP(f16_t, WS_GK), WSP(f16_t, WS_GV), WSP(f16_t, WS_UIMG), WSP(f16_t, WS_ATT), WSP(float, WS_DL), WSP(f16_t, WS_OG16)); }
        { Ctx C = make_ctx(lds, wave_s); phase_nsa_blk(C, WSP(unsigned, WS_CTL) + CW_NSA + 64 * l, WSP(f16_t, WS_Q16), WSP(f16_t, WS_KCMP16), WSP(f16_t, WS_VCMPT), WSP(f16_t, WS_KSR), WSP(f16_t, WS_VST), WSP(f16_t, WS_KWR), WSP(f16_t, WS_VWT),
                                           WSP(float, WS_GR32), PA(nsa_ng) + l * HD, WSP(f16_t, WS_HN)); }
        GRID_BAR();
        { Ctx C = make_ctx(lds, wave_s); phase_gdn_out16(C, WSP(f16_t, WS_OG16), WSP(f16_t, WS_Z16), PA(gdn_ng) + l * GD, WSP(f16_t, WS_HN)); }
        GRID_BAR();
        run_gemm(lds, wave_s, WSP(f16_t, WS_HN), WSP(f16_t, WS_WTOUT) + (size_t)l * DM * DM, DM, DM, pg8::EpiResidual{PA(out), PA(out), MODL(l) + 5 * DM, 9216, 1.0f});
        GRID_BAR();
        { Ctx C = make_ctx(lds, wave_s); phase_norm(C, PA(out), PA(norm_g) + (size_t)(l * 3 + 2) * DM, MODL(l) + 6 * DM, MODL(l) + 7 * DM, WSP(f16_t, WS_HN)); }
        { Ctx C = make_ctx(lds, wave_s); phase_norm(C, PA(out), PA(norm_g) + (size_t)(l * 3 + 2) * DM, MODL(l) + 6 * DM, MODL(l) + 7 * DM, WSP(f16_t, WS_HN)); }
        GRID_BAR();
        run_gemm(lds, wave_s, WSP(f16_t, WS_HN), WSP(f16_t, WS_WT1) + (size_t)(l * 2 + 1) * 2 * FF * DM, 2 * FF, DM, pg8::EpiSwiglu{WSP(f16_t, WS_ACT)});
        GRID_BAR();
        run_gemm(lds, wave_s, WSP(f16_t, WS_ACT), WSP(f16_t, WS_WT2) + (size_t)(l * 2 + 1) * DM * FF, DM, FF, pg8::EpiResidual{PA(out), PA(out), MODL(l) + 8 * DM, 9216, 0.5f});
        GRID_BAR();
}
__global__ void __launch_bounds__(NTHR, 2) mega_fwd(Params p_unused) {
    extern __shared__ __attribute__((aligned(16))) unsigned char lds_raw[];
    LAS unsigned char* lds = (LAS unsigned char*)lds_raw;
    const int wave_s = __builtin_amdgcn_readfirstlane(threadIdx.x >> 6);
    for (int u = threadIdx.x; u < (LDS_BYTES - LDSCTL_OFF) / 4; u += NTHR) ((LAS unsigned*)(lds + LDSCTL_OFF))[u] = 0u;
    __syncthreads();
    (void)xcd_barrier_post(WSP(unsigned, WS_CTL) + CW_BAR, (volatile LAS unsigned*)(lds + LDSCTL_OFF + 64));
    { Ctx C = make_ctx(lds, wave_s); phase_mod(C, PA(c), PA(ada_w), PA(ada_b), WSP(float, WS_MOD)); }
    { Ctx C = make_ctx(lds, wave_s); phase_wconv(C, WSP(f16_t, WS_WT1), WSP(f16_t, WS_WT2), WSP(f16_t, WS_WTIN), WSP(f16_t, WS_WTOUT)); }
    { Ctx C = make_ctx(lds, wave_s); phase_cmp_weights(C, WSP(f16_t, WS_W1C), WSP(f16_t, WS_W2C), WSP(float, WS_C1)); }
    GRID_BAR_FIRST();
    layer_body<0>(lds, wave_s);
    layer_body<1>(lds, wave_s);
    { Ctx C = make_ctx(lds, wave_s); phase_final_norm(C, PA(out), PA(final_g)); }
}

extern "C" void kernel_launch(void* const* d_in, const int* in_sizes, int n_in, void* d_out, int out_size, void* d_ws, size_t ws_size, hipStream_t stream) {
    static int grid = 0;
    if (grid == 0) {
        if (n_in != 22 || out_size != MR * DM || ws_size < WS_END + 4096) { fprintf(stderr, "kernel_launch: unexpected shapes (n_in %d out %d ws %zu)\n", n_in, out_size, ws_size); grid = -1; return; }
        int dev = 0, cus = 0, per_cu = 0;
        if (hipGetDevice(&dev) != hipSuccess || hipDeviceGetAttribute(&cus, hipDeviceAttributeMultiprocessorCount, dev) != hipSuccess) { grid = -1; return; }
        if (hipFuncSetAttribute((const void*)mega_fwd, hipFuncAttributeMaxDynamicSharedMemorySize, LDS_BYTES) != hipSuccess) { fprintf(stderr, "kernel_launch: hipFuncSetAttribute failed\n"); grid = -1; return; }
        if (hipOccupancyMaxActiveBlocksPerMultiprocessor(&per_cu, (const void*)mega_fwd, NTHR, LDS_BYTES) != hipSuccess || per_cu < 1) { fprintf(stderr, "kernel_launch: occupancy query says %d\n", per_cu); (void)hipGetLastError(); grid = -1; return; }
        grid = cus;
    }
    if (grid < 0) return;
    (void)hipMemsetAsync((char*)d_ws + WS_CTL, 0, CTL_ZERO_BYTES, stream);
    Params p{};
    p.x = (const float*)d_in[0]; p.c = (const float*)d_in[1]; p.positions = (const int*)d_in[2]; p.ada_w = (const float*)d_in[3]; p.ada_b = (const float*)d_in[4];
    p.norm_g = (const float*)d_in[5]; p.ffn_w_in = (const float*)d_in[6]; p.ffn_w_out = (const float*)d_in[7]; p.mix_w_in = (const float*)d_in[8]; p.conv_w = (const float*)d_in[9];
    p.a_log = (const float*)d_in[10]; p.dt_bias = (const float*)d_in[11]; p.gdn_ng = (const float*)d_in[12]; p.pe_k = (const float*)d_in[13]; p.w1_k = (const float*)d_in[14];
    p.w2_k = (const float*)d_in[15]; p.pe_v = (const float*)d_in[16]; p.w1_v = (const float*)d_in[17]; p.w2_v = (const float*)d_in[18]; p.nsa_ng = (const float*)d_in[19];
    p.mix_w_out = (const float*)d_in[20]; p.final_g = (const float*)d_in[21]; p.out = (float*)d_out; p.ws = (unsigned char*)d_ws;
    hipLaunchKernelGGL(mega_fwd, dim3(grid), dim3(NTHR), LDS_BYTES, stream, p);
}
```

```cpp
#include <hip/hip_runtime.h>
#include <cstdio>
#include <cstdint>

constexpr int NB = 4, NT = 4096, DM = 1024, MR = NB * NT, FF = 2816, NIN = 3360, NINP = 3584, DEPTH = 2;
constexpr int GH = 4, GD = 128, GW = 512;
constexpr int NH = 8, NG = 2, HD = 64;
constexpr int NCMP = 255, NBLK = 64, NSEL = 16, WIN = 512;
constexpr float EPS = 1e-6f;
constexpr size_t MiB = 1u << 20;
constexpr size_t WS_CTL = 0, WS_MOD = 1 * MiB, WS_WT1 = 4 * MiB, WS_WT2 = 48 * MiB, WS_WTIN = 70 * MiB, WS_WTOUT = 84 * MiB, WS_W1C = 88 * MiB,
                 WS_X16 = 90 * MiB, WS_ACT = 122 * MiB, WS_C16 = 122 * MiB, WS_UIMG = 122 * MiB, WS_ATT = 138 * MiB, WS_DL = 146 * MiB, WS_Z16 = 170 * MiB, WS_KV16 = 186 * MiB,
                 WS_QN32 = 210 * MiB, WS_KC32 = 242 * MiB, WS_AB32 = 250 * MiB, WS_GR32 = 251 * MiB, WS_GQ = 253 * MiB, WS_GK = 269 * MiB, WS_GV = 285 * MiB,
                 WS_GG = 301 * MiB, WS_GB = 301 * MiB + 512 * 1024, WS_KCMP = 302 * MiB, WS_VCMP = 302 * MiB + 512 * 1024, WS_SEL = 303 * MiB, WS_OACC = 304 * MiB, WS_END = 336 * MiB,
                 WS_W2C = 2 * MiB, WS_C1 = 2 * MiB + 128 * 1024, WS_VST = 147 * MiB, WS_VWT = 151 * MiB, WS_KCMP16 = 302 * MiB, WS_VCMPT = 302 * MiB + 512 * 1024,
                 WS_Q16 = 304 * MiB, WS_KCR = 320 * MiB, WS_KSR = 324 * MiB, WS_KWR = 328 * MiB, WS_VC16 = 332 * MiB;
constexpr size_t WS_OG16 = 210 * MiB;
constexpr int CW_NSA = 8192;

typedef unsigned short f16_t;
typedef _Float16 h2_t __attribute__((ext_vector_type(2)));
typedef float f32x2_t __attribute__((ext_vector_type(2)));
typedef float f32x4_t __attribute__((ext_vector_type(4)));
typedef unsigned u32x4_t __attribute__((ext_vector_type(4)));
typedef unsigned u32x2_t __attribute__((ext_vector_type(2)));
__device__ __forceinline__ unsigned pkh(float lo, float hi) { f32x2_t v = {lo, hi}; h2_t h = __builtin_convertvector(v, h2_t); return __builtin_bit_cast(unsigned, h); }
__device__ __forceinline__ float h2f(f16_t u) { return (float)__builtin_bit_cast(_Float16, u); }
__device__ __forceinline__ f16_t f2h(float f) { return __builtin_bit_cast(f16_t, (_Float16)f); }
__device__ __forceinline__ float hlo(unsigned u) { return h2f((f16_t)(u & 0xffffu)); }
__device__ __forceinline__ float hhi(unsigned u) { return h2f((f16_t)(u >> 16)); }
__device__ __forceinline__ float siluf(float x) { return x * __builtin_amdgcn_rcpf(1.f + __builtin_amdgcn_exp2f(-1.4426950408889634f * x)); }
__device__ __forceinline__ float sigmf(float x) { return __builtin_amdgcn_rcpf(1.f + __builtin_amdgcn_exp2f(-1.4426950408889634f * x)); }
__device__ __forceinline__ float lshx(float v, int lane, int m) { return __builtin_bit_cast(float, __builtin_amdgcn_ds_bpermute((lane ^ m) << 2, __builtin_bit_cast(int, v))); }
__device__ __forceinline__ unsigned lshx(unsigned v, int lane, int m) { return (unsigned)__builtin_amdgcn_ds_bpermute((lane ^ m) << 2, (int)v); }
__device__ __forceinline__ float lshf(float v, int src) { return __builtin_bit_cast(float, __builtin_amdgcn_ds_bpermute(src << 2, __builtin_bit_cast(int, v))); }
__device__ __forceinline__ float wave_sum(float v, int lane) {
#pragma unroll
    for (int o = 1; o < 64; o <<= 1) v += lshx(v, lane, o);
    return v;
}

namespace pg8 {
#define PG8_LAS __attribute__((address_space(3)))
typedef unsigned short bf16_t;
typedef _Float16 bf16x8 __attribute__((ext_vector_type(8)));
typedef float f32x4 __attribute__((ext_vector_type(4)));
typedef unsigned u32x4 __attribute__((ext_vector_type(4)));
constexpr int BM = 256, BK = 64, HALF = 128, HTB = HALF * BK * 2  , STAGE_BYTES = 8 * HTB, NXCD = 8, WGM = 8;

__host__ __device__ __forceinline__ int lds_byte(int r, int c) { const int st = (r >> 4) * 2 + (c >> 5), rr = r & 15, cc = c & 31, ob = rr * 64 + cc * 2; return st * 1024 + (ob ^ (((ob >> 9) & 1) << 5)); }
__host__ __device__ __forceinline__ void stage_rc(int b, int& R, int& C) { const int st = b / 1024, sb = b % 1024, swz = sb ^ (((sb >> 9) & 1) << 5); R = (st >> 1) * 16 + swz / 64; C = (st & 1) * 32 + (swz % 64) / 2; }
__host__ __device__ __forceinline__ int perm32(int rho) { const int n = rho >> 4, i = rho & 15; return 8 * (i >> 2) + 4 * n + (i & 3); }

struct Unit { int pm, pn; };
struct Gemm { const bf16_t* A; const bf16_t* Bt; int M, N, K, pad; };

struct StaticOrder {
    int nM, nN, nwg, G, c;
    __host__ __device__ void init(int M, int N, int G_, int c_) { nM = M / BM; nN = N / BM; nwg = nM * nN; G = G_; c = c_; }
    __host__ __device__ bool next(int i, Unit& u) const {
        const long L = (long)i * G + c; if (L >= nwg) return false;
        int wgid = (int)L; { const int q = nwg / NXCD, r = nwg % NXCD, xcd = wgid % NXCD, off = wgid / NXCD; wgid = (xcd < r ? xcd * (q + 1) : r * (q + 1) + (xcd - r) * q) + off; }
        const int nig = WGM * nN, gid = wgid / nig, fm = gid * WGM, gsz = (nM - fm) < WGM ? (nM - fm) : WGM;
        u.pm = fm + ((wgid % nig) % gsz); u.pn = (wgid % nig) / gsz; return true;
    }
    __device__ __forceinline__ void a_ready(const Unit&) const {}
    __device__ __forceinline__ void done(const Unit&) const {}
};


template <class Epi, class Sched, bool ALIGN_EPI = false, bool SP2 = false>
__device__ __forceinline__ void gemm_phase(PG8_LAS unsigned char* lds, const Gemm g, const Sched& S, const Epi& E, int tid_) {
    asm volatile("" : "+v"(tid_));
    const int tid = tid_, wid = __builtin_amdgcn_readfirstlane(tid >> 6), lane = tid & 63, wr = wid >> 2, wc = wid & 3, fr = lane & 15, fq = lane >> 4;
    const int K = g.K, nt = K / BK;
    unsigned voffA[2], voffB[2];
#pragma unroll
    for (int i = 0; i < 2; ++i) { int R, C; stage_rc(tid * 16 + i * 8192, R, C); const int Rb = Epi::PERM ? ((R & ~31) + perm32(R & 31)) : R;
        voffA[i] = (unsigned)(R * K + C) * 2u; voffB[i] = (unsigned)(Rb * K + C) * 2u; }
    const size_t kstep = (size_t)(BK * 2);
    const size_t hstep = (size_t)HALF * K * 2;
    const size_t tstep = 2 * hstep;
    const unsigned ldsw = (unsigned)wid * 1024u;
    const int aoff = lds_byte(wr * 64 + fr, fq * 8), boff = lds_byte(wc * 32 + fr, fq * 8);
#define PG8_SA(b, h) (((b) * 2 + (h)) * HTB)
#define PG8_SB(b, h) ((4 + (b) * 2 + (h)) * HTB)
#define PG8_STAGE(bufoff, gbase, voff) do { _Pragma("unroll") for (int _i = 0; _i < 2; ++_i) \
        __builtin_amdgcn_global_load_lds((const unsigned*)((const char*)(gbase) + (voff)[_i]), (PG8_LAS unsigned*)(lds + (bufoff) + ldsw + _i * 8192), 16, 0, 0); } while (0)
#define PG8_LDA(dst, b, h) do { _Pragma("unroll") for (int m = 0; m < 4; ++m) _Pragma("unroll") for (int k = 0; k < 2; ++k) dst[m][k] = *(const PG8_LAS bf16x8*)(lds + PG8_SA(b, h) + aoff + m * 2048 + k * 1024); } while (0)
#define PG8_LDB(dst, b, h) do { _Pragma("unroll") for (int n = 0; n < 2; ++n) _Pragma("unroll") for (int k = 0; k < 2; ++k) dst[n][k] = *(const PG8_LAS bf16x8*)(lds + PG8_SB(b, h) + boff + n * 2048 + k * 1024); } while (0)
#define PG8_MMA(ai, bj, At, Bt) do { __builtin_amdgcn_s_setprio(1); _Pragma("unroll") for (int m = 0; m < 4; ++m) _Pragma("unroll") for (int n = 0; n < 2; ++n) _Pragma("unroll") for (int k = 0; k < 2; ++k) \
        acc[ai][bj][m][n] = __builtin_amdgcn_mfma_f32_16x16x32_f16(Bt[n][k], At[m][k], acc[ai][bj][m][n], 0, 0, 0); __builtin_amdgcn_s_setprio(0); } while (0)
#define PG8_WAIT_V(n) asm volatile("s_waitcnt vmcnt(" #n ")" ::: "memory")
#define PG8_WAIT_L(n) asm volatile("s_waitcnt lgkmcnt(" #n ")" ::: "memory")
#define PG8_BAR __builtin_amdgcn_s_barrier()
#define PG8_SCHED __builtin_amdgcn_sched_barrier(0)
    Unit cur, nxt; int ui = 0;
    if (!S.next(0, cur)) return;
    f32x4 acc[2][2][4][2];
#pragma unroll
    for (int a = 0; a < 2; ++a)
#pragma unroll
        for (int b = 0; b < 2; ++b)
#pragma unroll
            for (int m = 0; m < 4; ++m)
#pragma unroll
                for (int n = 0; n < 2; ++n) acc[a][b][m][n] = (f32x4){0.f, 0.f, 0.f, 0.f};
    bf16x8 At[4][2], B0[2][2], B1[2][2];
    const char* cA = (const char*)g.A + (size_t)cur.pm * tstep; const char* cB = (const char*)g.Bt + (size_t)cur.pn * tstep;
    S.a_ready(cur);
    if constexpr (SP2) {
        PG8_STAGE(PG8_SB(0, 0), cB, voffB); PG8_STAGE(PG8_SB(0, 1), cB + hstep, voffB); PG8_STAGE(PG8_SA(0, 0), cA, voffA); PG8_STAGE(PG8_SA(0, 1), cA + hstep, voffA);
        if (wr == 1) PG8_BAR;
        PG8_WAIT_V(2); PG8_BAR;
        PG8_STAGE(PG8_SB(1, 0), cB + kstep, voffB); PG8_STAGE(PG8_SA(1, 0), cA + kstep, voffA); PG8_STAGE(PG8_SB(1, 1), cB + hstep + kstep, voffB);
        PG8_WAIT_V(6); PG8_BAR;
    } else {
        PG8_STAGE(PG8_SB(0, 0), cB, voffB); PG8_STAGE(PG8_SA(0, 0), cA, voffA); PG8_STAGE(PG8_SB(0, 1), cB + hstep, voffB); PG8_STAGE(PG8_SA(0, 1), cA + hstep, voffA);
        if (wr == 1) PG8_BAR;
        PG8_WAIT_V(4); PG8_BAR;
        PG8_STAGE(PG8_SB(1, 0), cB + kstep, voffB); PG8_STAGE(PG8_SA(1, 0), cA + kstep, voffA); PG8_STAGE(PG8_SB(1, 1), cB + hstep + kstep, voffB);
        PG8_WAIT_V(6); PG8_BAR;
    }
    for (;;) {
        const bool has_next = S.next(ui + 1, nxt);
        const char* nA = has_next ? (const char*)g.A + (size_t)nxt.pm * tstep : cA; const char* nB = has_next ? (const char*)g.Bt + (size_t)nxt.pn * tstep : cB;
        for (int t = 0; t < nt; t += 2) {
            const bool last = (t == nt - 2);
            const char* a1 = cA + (size_t)(t + 1) * kstep;
            const char* a2 = last ? nA : cA + (size_t)(t + 2) * kstep; const char* b2 = last ? nB : cB + (size_t)(t + 2) * kstep;
            const char* a3 = a2 + kstep; const char* b3 = b2 + kstep;
            if (last && has_next) S.a_ready(nxt);
            if constexpr (SP2) {
            PG8_LDB(B0, 0, 0); PG8_LDB(B1, 0, 1); PG8_SCHED; PG8_LDA(At, 0, 0); PG8_STAGE(PG8_SA(1, 1), a1 + hstep, voffA);
            PG8_WAIT_V(8); PG8_WAIT_L(0); PG8_BAR; PG8_MMA(0, 0, At, B0); PG8_MMA(0, 1, At, B1); PG8_BAR; PG8_SCHED;
            PG8_LDA(At, 0, 1); PG8_STAGE(PG8_SB(0, 0), b2, voffB); PG8_STAGE(PG8_SB(0, 1), b2 + hstep, voffB); PG8_STAGE(PG8_SA(0, 0), a2, voffA);
            PG8_WAIT_V(8); PG8_WAIT_L(0); PG8_BAR; PG8_MMA(1, 0, At, B0); PG8_MMA(1, 1, At, B1); PG8_BAR; PG8_SCHED;
            PG8_LDB(B0, 1, 0); PG8_LDB(B1, 1, 1); PG8_SCHED; PG8_LDA(At, 1, 0); PG8_STAGE(PG8_SA(0, 1), a2 + hstep, voffA);
            PG8_WAIT_V(8); PG8_WAIT_L(0); PG8_BAR; PG8_MMA(0, 0, At, B0); PG8_MMA(0, 1, At, B1); PG8_BAR; PG8_SCHED;
            PG8_LDA(At, 1, 1); PG8_STAGE(PG8_SB(1, 0), b3, voffB); PG8_STAGE(PG8_SB(1, 1), b3 + hstep, voffB); PG8_STAGE(PG8_SA(1, 0), a3, voffA);
            PG8_WAIT_V(8); PG8_WAIT_L(0); PG8_BAR; PG8_MMA(1, 0, At, B0); PG8_MMA(1, 1, At, B1); PG8_BAR; PG8_SCHED;
            } else {
            PG8_LDB(B0, 0, 0); PG8_SCHED; PG8_LDA(At, 0, 0); PG8_STAGE(PG8_SA(1, 1), a1 + hstep, voffA);
            PG8_WAIT_L(8); PG8_BAR; PG8_WAIT_L(0); PG8_MMA(0, 0, At, B0); PG8_BAR; PG8_SCHED;
            PG8_LDB(B1, 0, 1); PG8_STAGE(PG8_SB(0, 0), b2, voffB);
            PG8_BAR; PG8_WAIT_L(0); PG8_MMA(0, 1, At, B1); PG8_BAR;
            PG8_LDA(At, 0, 1); PG8_STAGE(PG8_SA(0, 0), a2, voffA);
            PG8_BAR; PG8_WAIT_L(0); PG8_MMA(1, 0, At, B0); PG8_BAR; PG8_SCHED;
            PG8_STAGE(PG8_SB(0, 1), b2 + hstep, voffB);
            PG8_WAIT_V(6); PG8_BAR; PG8_MMA(1, 1, At, B1); PG8_BAR;
            PG8_LDB(B0, 1, 0); PG8_SCHED; PG8_LDA(At, 1, 0); PG8_STAGE(PG8_SA(0, 1), a2 + hstep, voffA);
            PG8_WAIT_L(8); PG8_BAR; PG8_WAIT_L(0); PG8_MMA(0, 0, At, B0); PG8_BAR; PG8_SCHED;
            PG8_LDB(B1, 1, 1); PG8_STAGE(PG8_SB(1, 0), b3, voffB);
            PG8_BAR; PG8_WAIT_L(0); PG8_MMA(0, 1, At, B1); PG8_BAR;
            PG8_LDA(At, 1, 1); PG8_STAGE(PG8_SA(1, 0), a3, voffA);
            PG8_BAR; PG8_WAIT_L(0); PG8_MMA(1, 0, At, B0); PG8_BAR; PG8_SCHED;
            PG8_STAGE(PG8_SB(1, 1), b3 + hstep, voffB);
            PG8_WAIT_V(6); PG8_BAR; PG8_MMA(1, 1, At, B1); PG8_BAR;
            }
        }
        if constexpr (ALIGN_EPI) { if (wr == 0) PG8_BAR; }
        if constexpr (!Epi::AFTER_DRAIN) { E(acc, cur, wr, wc, fr, fq); S.done(cur); }
        if (!has_next) break;
#pragma unroll
        for (int a = 0; a < 2; ++a)
#pragma unroll
            for (int b = 0; b < 2; ++b)
#pragma unroll
                for (int m = 0; m < 4; ++m)
#pragma unroll
                    for (int n = 0; n < 2; ++n) acc[a][b][m][n] = (f32x4){0.f, 0.f, 0.f, 0.f};
        cur = nxt; cA = nA; cB = nB; ++ui;
        if constexpr (ALIGN_EPI) { if (wr == 1) PG8_BAR; }
    }
    PG8_WAIT_V(0);
    if constexpr (!ALIGN_EPI) { if (wr == 0) PG8_BAR; }
    PG8_BAR;
    if constexpr (Epi::AFTER_DRAIN) { E.fused(acc, cur, wr, wc, fr, fq, lds, wid, lane); S.done(cur); }
#undef PG8_SA
#undef PG8_SB
#undef PG8_STAGE
#undef PG8_LDA
#undef PG8_LDB
#undef PG8_MMA
#undef PG8_WAIT_V
#undef PG8_WAIT_L
#undef PG8_BAR
#undef PG8_SCHED
}
}

namespace pg8 {
struct EpiSwiglu {
    static constexpr bool PERM = true, AFTER_DRAIN = false;
    f16_t* O;
    __device__ __forceinline__ void operator()(const f32x4 (&acc)[2][2][4][2], const Unit& u, int wr, int wc, int fr, int fq) const {
        const int row0 = u.pm * BM + wr * 64 + fr, col0 = u.pn * 128 + wc * 32 + 8 * fq;
#pragma unroll
        for (int ai = 0; ai < 2; ++ai)
#pragma unroll
            for (int m = 0; m < 4; ++m) {
                const f32x4 g0 = acc[ai][0][m][0], g1 = acc[ai][0][m][1], u0 = acc[ai][1][m][0], u1 = acc[ai][1][m][1];
                u32x4 w;
                w.x = pkh(siluf(g0[0]) * u0[0], siluf(g0[1]) * u0[1]); w.y = pkh(siluf(g0[2]) * u0[2], siluf(g0[3]) * u0[3]);
                w.z = pkh(siluf(g1[0]) * u1[0], siluf(g1[1]) * u1[1]); w.w = pkh(siluf(g1[2]) * u1[2], siluf(g1[3]) * u1[3]);
                *(u32x4*)(O + (size_t)(row0 + ai * HALF + m * 16) * FF + col0) = w;
            }
    }
};
template <bool BASE16> struct EpiResidual {
    static constexpr bool PERM = true, AFTER_DRAIN = false;
    const void* base; f16_t* out; const float* gate; int gstride; float coef;
    __device__ __forceinline__ void operator()(const f32x4 (&acc)[2][2][4][2], const Unit& u, int wr, int wc, int fr, int fq) const {
        const int row0 = u.pm * BM + wr * 64 + fr, col0 = u.pn * BM + wc * 32 + 8 * fq;
        const float* gp = gate + (size_t)(u.pm / (NT / BM)) * gstride + col0;
        f32x4 gv[2][2];
#pragma unroll
        for (int bj = 0; bj < 2; ++bj)
#pragma unroll
            for (int n = 0; n < 2; ++n) gv[bj][n] = *(const f32x4*)(gp + bj * HALF + n * 4) * coef;
#pragma unroll
        for (int ai = 0; ai < 2; ++ai)
#pragma unroll
            for (int m = 0; m < 4; ++m) { const size_t off = (size_t)(row0 + ai * HALF + m * 16) * DM + col0;
#pragma unroll
                for (int bj = 0; bj < 2; ++bj) { f32x4 b0, b1;
                    if (BASE16) { const u32x4 bw = *(const u32x4*)((const f16_t*)base + off + bj * HALF); b0 = (f32x4){hlo(bw.x), hhi(bw.x), hlo(bw.y), hhi(bw.y)}; b1 = (f32x4){hlo(bw.z), hhi(bw.z), hlo(bw.w), hhi(bw.w)}; }
                    else { const float* bp = (const float*)base + off + bj * HALF; b0 = *(const f32x4*)bp; b1 = *(const f32x4*)(bp + 4); }
                    const f32x4 v0 = b0 + gv[bj][0] * acc[ai][bj][m][0], v1 = b1 + gv[bj][1] * acc[ai][bj][m][1];
                    u32x4 w; w.x = pkh(v0[0], v0[1]); w.y = pkh(v0[2], v0[3]); w.z = pkh(v1[0], v1[1]); w.w = pkh(v1[2], v1[3]);
                    *(u32x4*)(out + off + bj * HALF) = w; } }
    }
};
struct EpiInProj {
    static constexpr bool PERM = true, AFTER_DRAIN = false;
    f16_t* C16; f16_t* Z16; float* AB32; float* QN32; float* KC32; f16_t* KV16; float* GR32;
    __device__ __forceinline__ void operator()(const f32x4 (&acc)[2][2][4][2], const Unit& u, int wr, int wc, int fr, int fq) const {
        const int row0 = u.pm * BM + wr * 64 + fr;
#pragma unroll
        for (int bj = 0; bj < 2; ++bj) {
            const int c0 = u.pn * BM + bj * HALF + wc * 32 + 8 * fq;
            int kind; size_t ld; int cc; void* basep;
            if (c0 < 1536)      { kind = 0; basep = C16;  ld = 1536; cc = c0; }
            else if (c0 < 2048) { kind = 0; basep = Z16;  ld = 512;  cc = c0 - 1536; }
            else if (c0 < 2056) { kind = 1; basep = AB32; ld = 8;    cc = 0; }
            else if (c0 < 2568) { kind = 1; basep = QN32; ld = 512;  cc = c0 - 2056; }
            else if (c0 < 2696) { kind = 1; basep = KC32; ld = 128;  cc = c0 - 2568; }
            else if (c0 < 3336) { kind = 0; basep = KV16; ld = 640;  cc = c0 - 2696; }
            else if (c0 < 3360) { kind = 1; basep = GR32; ld = 24;   cc = c0 - 3336; }
            else continue;
#pragma unroll
            for (int ai = 0; ai < 2; ++ai)
#pragma unroll
                for (int m = 0; m < 4; ++m) {
                    const size_t row = (size_t)(row0 + ai * HALF + m * 16);
                    const f32x4 v0 = acc[ai][bj][m][0], v1 = acc[ai][bj][m][1];
                    if (kind == 0) { u32x4 w; w.x = pkh(v0[0], v0[1]); w.y = pkh(v0[2], v0[3]); w.z = pkh(v1[0], v1[1]); w.w = pkh(v1[2], v1[3]);
                        *(u32x4*)((f16_t*)basep + row * ld + cc) = w; }
                    else { float* p = (float*)basep + row * ld + cc; *(f32x4*)p = v0; *(f32x4*)(p + 4) = v1; }
                }
        }
    }
};
}

#define GAS __attribute__((address_space(1)))
#define LAS __attribute__((address_space(3)))
typedef GAS unsigned gu32;
#define RLX_AGENT __ATOMIC_RELAXED, __HIP_MEMORY_SCOPE_AGENT
#define XB_TMO      128
#define XB_XCNT(j)  (256  + 64 * (j))
#define XB_XSUB(j)  (1280 + 64 * (j))
#define XB_XGEN(j)  (2304 + 64 * (j))
#define XB_TOP      3328
#define XB_TOPGEN   3392
#define XCD_BAR_WORDS 3456
#define XB_SPIN_CAP (1u << 18)

__device__ __forceinline__ unsigned xb_ld(unsigned* p)              { return __hip_atomic_load(p, __ATOMIC_RELAXED, __HIP_MEMORY_SCOPE_AGENT); }
__device__ __forceinline__ unsigned xb_add(unsigned* p, unsigned v) { return __hip_atomic_fetch_add(p, v, __ATOMIC_RELAXED, __HIP_MEMORY_SCOPE_AGENT); }
__device__ __forceinline__ unsigned xb_xcc_id() { return (unsigned)__builtin_amdgcn_s_getreg((3 << 11) | 20) & 0xFu; }
#define XB_SPIN(cond, bar) do { unsigned _sp = 0; while (cond) { __builtin_amdgcn_s_sleep(1); \
    if ((++_sp & 255u) == 0u) { if (xb_ld(&(bar)[XB_TMO])) break; if (_sp > XB_SPIN_CAP) { atomicAdd(&(bar)[XB_TMO], 1u); break; } } } } while (0)

struct XcdBarrier {
    unsigned* bar; unsigned x;
    volatile LAS unsigned* st;
};

__device__ __forceinline__ XcdBarrier xcd_barrier_post(unsigned* bar, volatile LAS unsigned* st) {
    XcdBarrier b; b.bar = bar; b.x = xb_xcc_id(); b.st = st;
    if (threadIdx.x == 0) (void)xb_add(&bar[XB_XCNT(b.x)], 1u);
    return b;
}
__device__ __forceinline__ void xcd_barrier_complete(unsigned* bar, unsigned x, unsigned& nloc, unsigned& nx) {
    const unsigned G = gridDim.x * gridDim.y * gridDim.z;
    unsigned sum, cnt, mine, sp = 0u;
    for (;;) {
        sum = 0u; cnt = 0u; mine = 0u;
#pragma unroll
        for (unsigned j = 0; j < 16; ++j) { const unsigned c = xb_ld(&bar[XB_XCNT(j)]); sum += c; cnt += (c > 0u) ? 1u : 0u; mine = (j == x) ? c : mine; }
        if (sum == G) break;
        __builtin_amdgcn_s_sleep(1);
        if ((++sp & 255u) == 0u) { if (xb_ld(&bar[XB_TMO])) break; if (sp > XB_SPIN_CAP) { atomicAdd(&bar[XB_TMO], 1u); break; } }
    }
    nloc = mine > 0u ? mine : 1u; nx = cnt > 0u ? cnt : 1u;
}

__device__ __forceinline__ void xcd_barrier(const XcdBarrier& b) {
    asm volatile("s_waitcnt vmcnt(0)" ::: "memory");
    __syncthreads();
    if (threadIdx.x == 0) {
        unsigned* bar = b.bar;
        __builtin_amdgcn_s_waitcnt(0);
        unsigned nloc = b.st[0], nx = b.st[1];
        if (nloc == 0u) { xcd_barrier_complete(bar, b.x, nloc, nx); b.st[0] = nloc; b.st[1] = nx; }
        const unsigned old = xb_add(&bar[XB_XSUB(b.x)], 1u);
        const unsigned gen = old / nloc;
        if (old + 1u == (gen + 1u) * nloc) {
            __builtin_amdgcn_fence(__ATOMIC_RELEASE, "agent");
            asm volatile("s_waitcnt vmcnt(0)" ::: "memory");
            const unsigned og = xb_add(&bar[XB_TOP], 1u);
            const unsigned tg = og / nx;
            if (og + 1u == (tg + 1u) * nx) xb_add(&bar[XB_TOPGEN], 1u);
            else XB_SPIN(xb_ld(&bar[XB_TOPGEN]) == tg, bar);
            __builtin_amdgcn_fence(__ATOMIC_ACQUIRE, "agent");
            xb_add(&bar[XB_XGEN(b.x)], 1u);
            asm volatile("s_waitcnt vmcnt(0)" ::: "memory");
        } else {
            XB_SPIN(xb_ld(&bar[XB_XGEN(b.x)]) == gen, bar);
            __builtin_amdgcn_fence(__ATOMIC_ACQUIRE, "agent");
            asm volatile("s_waitcnt vmcnt(0)" ::: "memory");
        }
    }
    __syncthreads();
}

__device__ __forceinline__ void xcd_barrier_fast(const XcdBarrier& b) {
    asm volatile("s_waitcnt vmcnt(0)" ::: "memory");
    __syncthreads();
    if (threadIdx.x == 0) {
        unsigned* bar = b.bar;
        __builtin_amdgcn_s_waitcnt(0);
        unsigned nloc = b.st[0], nx = b.st[1];
        const unsigned old = xb_add(&bar[XB_XSUB(b.x)], 1u);
        const unsigned gen = old / nloc;
        if (old + 1u == (gen + 1u) * nloc) {
            __builtin_amdgcn_fence(__ATOMIC_RELEASE, "agent");
            asm volatile("s_waitcnt vmcnt(0)" ::: "memory");
            const unsigned og = xb_add(&bar[XB_TOP], 1u);
            const unsigned tg = og / nx;
            if (og + 1u == (tg + 1u) * nx) xb_add(&bar[XB_TOPGEN], 1u);
            else XB_SPIN(xb_ld(&bar[XB_TOPGEN]) == tg, bar);
            __builtin_amdgcn_fence(__ATOMIC_ACQUIRE, "agent");
            xb_add(&bar[XB_XGEN(b.x)], 1u);
            asm volatile("s_waitcnt vmcnt(0)" ::: "memory");
        } else {
            XB_SPIN(xb_ld(&bar[XB_XGEN(b.x)]) == gen, bar);
            __builtin_amdgcn_fence(__ATOMIC_ACQUIRE, "agent");
            asm volatile("s_waitcnt vmcnt(0)" ::: "memory");
        }
    }
    __syncthreads();
}

constexpr int NWAVES = 8, NTHR = 512;
constexpr int RING_BYTES = 147456, LDSCTL_OFF = RING_BYTES, LDS_BYTES = 148480;
constexpr int CW_BAR = 4096;
constexpr size_t CTL_ZERO_BYTES = 64 * 1024;

struct Params {
    const float *x, *c; const int* positions; const float *ada_w, *ada_b, *norm_g, *ffn_w_in, *ffn_w_out, *mix_w_in, *conv_w, *a_log, *dt_bias, *gdn_ng,
                *pe_k, *w1_k, *w2_k, *pe_v, *w1_v, *w2_v, *nsa_ng, *mix_w_out, *final_g;
    float* out; unsigned char* ws;
};
struct Ctx { LAS unsigned char* lds; int tid, lane, wave, bid, G, gw, NGW; };
__device__ __forceinline__ const __attribute__((address_space(4))) Params* kargs() {
    const __attribute__((address_space(4))) Params* q = (const __attribute__((address_space(4))) Params*)__builtin_amdgcn_kernarg_segment_ptr();
    asm volatile("" : "+s"(q)); return q;
}
#define PA(f) (kargs()->f)
#define WSP(T, off) ((T*)(PA(ws) + (off)))

__device__ __forceinline__ void phase_mod(const Ctx& C, const float* c, const float* ada_w, const float* ada_b, float* mod) {
    LAS float* cond = (LAS float*)C.lds; LAS float* part = (LAS float*)(C.lds + 16384);
    for (int i = C.tid; i < NB * DM; i += NTHR) cond[i] = siluf(c[i]);
    __syncthreads();
    for (int item = C.bid; item < 2 * 9216 / 64; item += C.G) {
        const int col = item * 64 + C.lane, l = col / 9216, j = col % 9216;
        const float* w = ada_w + (size_t)l * DM * 9216 + j; const int k0 = C.wave * 128;
        float a0 = 0.f, a1 = 0.f, a2 = 0.f, a3 = 0.f;
#pragma unroll 32
        for (int k = k0; k < k0 + 128; ++k) { const float wv = w[(size_t)k * 9216]; a0 += cond[k] * wv; a1 += cond[DM + k] * wv; a2 += cond[2 * DM + k] * wv; a3 += cond[3 * DM + k] * wv; }
        part[(C.wave * 4 + 0) * 64 + C.lane] = a0; part[(C.wave * 4 + 1) * 64 + C.lane] = a1; part[(C.wave * 4 + 2) * 64 + C.lane] = a2; part[(C.wave * 4 + 3) * 64 + C.lane] = a3;
        __syncthreads();
        if (C.wave < 4) { float s = ada_b[l * 9216 + j];
#pragma unroll
            for (int w8 = 0; w8 < 8; ++w8) s += part[(w8 * 4 + C.wave) * 64 + C.lane];
            mod[((size_t)l * NB + C.wave) * 9216 + j] = s; }
        __syncthreads();
    }
}
__device__ __forceinline__ void wconv_item(const float* W, int K, int N, f16_t* WT, int k0, int n0, int r0, LAS float* scr, int lane) {
    float wv[32];
#pragma unroll
    for (int i = 0; i < 32; ++i) wv[i] = W[(size_t)(k0 + 2 * i + (lane >> 5)) * N + n0 + (lane & 31)];
#pragma unroll
    for (int i = 0; i < 32; ++i) scr[(2 * i + (lane >> 5)) * 33 + (lane & 31)] = wv[i];
    __builtin_amdgcn_wave_barrier();
    const int c = lane & 7;
#pragma unroll
    for (int j = 0; j < 4; ++j) { const int n = (lane >> 3) + 8 * j; const LAS float* s = scr + (8 * c) * 33 + n;
        u32x4_t o; o.x = pkh(s[0 * 33], s[1 * 33]); o.y = pkh(s[2 * 33], s[3 * 33]); o.z = pkh(s[4 * 33], s[5 * 33]); o.w = pkh(s[6 * 33], s[7 * 33]);
        *(u32x4_t*)(WT + (size_t)(r0 + n) * K + k0 + 8 * c) = o; }
    __builtin_amdgcn_wave_barrier();
}
__device__ __forceinline__ void phase_wconv(const Ctx& C, f16_t* WT1, f16_t* WT2, f16_t* WTIN, f16_t* WTOUT) {
    LAS float* scr = (LAS float*)(C.lds + 32768) + C.wave * (64 * 33);
    constexpr int I1 = 16 * 176, I2 = 44 * 32, I3 = 16 * 105, I4 = 16 * 32, T1 = 4 * I1, T2 = 4 * I2, T3 = 2 * I3, T4 = 2 * I4;
    for (int it = C.gw; it < T1 + T2 + T3 + T4; it += C.NGW) {
        int r = it;
        if (r < T1) { const int mi = r / I1, q = r % I1, kb = q / 176, nb = q % 176, n0 = 32 * nb, half = n0 / FF, jj = n0 % FF;
            wconv_item(PA(ffn_w_in) + (size_t)mi * DM * 2 * FF, DM, 2 * FF, WT1 + (size_t)mi * 2 * FF * DM, 64 * kb, n0, 256 * (jj / 128) + 128 * half + (jj % 128), scr, C.lane); continue; }
        r -= T1;
        if (r < T2) { const int mi = r / I2, q = r % I2, kb = q / 32, nb = q % 32;
            wconv_item(PA(ffn_w_out) + (size_t)mi * FF * DM, FF, DM, WT2 + (size_t)mi * DM * FF, 64 * kb, 32 * nb, 32 * nb, scr, C.lane); continue; }
        r -= T2;
        if (r < T3) { const int mi = r / I3, q = r % I3, kb = q / 105, nb = q % 105;
            wconv_item(PA(mix_w_in) + (size_t)mi * DM * NIN, DM, NIN, WTIN + (size_t)mi * NINP * DM, 64 * kb, 32 * nb, 32 * nb, scr, C.lane); continue; }
        r -= T3;
        { const int mi = r / I4, q = r % I4, kb = q / 32, nb = q % 32;
            wconv_item(PA(mix_w_out) + (size_t)mi * DM * DM, DM, DM, WTOUT + (size_t)mi * DM * DM, 64 * kb, 32 * nb, 32 * nb, scr, C.lane); }
    }
    constexpr int PADV = (NINP - NIN) * DM * 2 / 16;
    for (int i = C.bid * NTHR + C.tid; i < 2 * PADV; i += C.G * NTHR) { const int l = i / PADV, q = i % PADV;
        ((u32x4_t*)(WTIN + ((size_t)l * NINP + NIN) * DM))[q] = (u32x4_t){0u, 0u, 0u, 0u}; }
}
template <bool X16> __device__ __forceinline__ void phase_norm(const Ctx& C, const void* x, const float* g, const float* shift, const float* scale, f16_t* hn) {
    for (int m = C.gw; m < MR; m += C.NGW) {
        const int b = m / NT;
        f32x4_t v[4]; float s = 0.f;
        if (X16) { const u32x2_t* xr = (const u32x2_t*)((const f16_t*)x + (size_t)m * DM) + C.lane;
#pragma unroll
            for (int j = 0; j < 4; ++j) { const u32x2_t w = xr[64 * j]; v[j] = (f32x4_t){hlo(w.x), hhi(w.x), hlo(w.y), hhi(w.y)}; } }
        else { const f32x4_t* xr = (const f32x4_t*)((const float*)x + (size_t)m * DM) + C.lane;
#pragma unroll
            for (int j = 0; j < 4; ++j) v[j] = xr[64 * j]; }
#pragma unroll
        for (int j = 0; j < 4; ++j) s += v[j].x * v[j].x + v[j].y * v[j].y + v[j].z * v[j].z + v[j].w * v[j].w;
        const float rstd = rsqrtf(wave_sum(s, C.lane) * (1.f / DM) + EPS);
        u32x2_t* o = (u32x2_t*)(hn + (size_t)m * DM) + C.lane;
#pragma unroll
        for (int j = 0; j < 4; ++j) {
            const f32x4_t gg = ((const f32x4_t*)g)[C.lane + 64 * j], sh = ((const f32x4_t*)(shift + (size_t)b * 9216))[C.lane + 64 * j], sc = ((const f32x4_t*)(scale + (size_t)b * 9216))[C.lane + 64 * j];
            const f32x4_t h = v[j] * rstd * gg * (sc + 1.f) + sh;
            u32x2_t w; w.x = pkh(h.x, h.y); w.y = pkh(h.z, h.w); o[64 * j] = w;
        }
    }
}
__device__ __forceinline__ void phase_final_norm(const Ctx& C, const f16_t* x16, float* out, const float* g) {
    for (int m = C.gw; m < MR; m += C.NGW) {
        const u32x2_t* xr = (const u32x2_t*)(x16 + (size_t)m * DM) + C.lane;
        f32x4_t v[4]; float s = 0.f;
#pragma unroll
        for (int j = 0; j < 4; ++j) { const u32x2_t w = xr[64 * j]; v[j] = (f32x4_t){hlo(w.x), hhi(w.x), hlo(w.y), hhi(w.y)}; s += v[j].x * v[j].x + v[j].y * v[j].y + v[j].z * v[j].z + v[j].w * v[j].w; }
        const float rstd = rsqrtf(wave_sum(s, C.lane) * (1.f / DM) + EPS);
        f32x4_t* o = (f32x4_t*)(out + (size_t)m * DM) + C.lane;
#pragma unroll
        for (int j = 0; j < 4; ++j) o[64 * j] = v[j] * rstd * ((const f32x4_t*)g)[C.lane + 64 * j];
    }
}
__device__ __forceinline__ void phase_gdn_prep(const Ctx& C, const f16_t* C16, const float* convw, const float* AB32, const float* a_log, const float* dt_bias,
                                               f16_t* GQ, f16_t* GK, f16_t* GV, float* Gg, float* Gb) {
    const int lane = C.lane;
    for (int it = C.gw; it < (MR / 8) * 12; it += C.NGW) {
        const int hs = it % 12, m0 = (it / 12) * 8, b = m0 / NT, t0 = m0 % NT; const int c = hs * 128 + 2 * lane;
        unsigned xv[11];
#pragma unroll
        for (int i = 0; i < 11; ++i) xv[i] = (t0 - 3 + i >= 0) ? *(const unsigned*)(C16 + (size_t)(m0 - 3 + i) * 1536 + c) : 0u;
        float w0[4], w1[4];
#pragma unroll
        for (int i = 0; i < 4; ++i) { w0[i] = convw[i * 1536 + c]; w1[i] = convw[i * 1536 + c + 1]; }
        const int which = hs >> 2, h = hs & 3;
        f16_t* dst = (which == 0 ? GQ : which == 1 ? GK : GV) + ((size_t)(b * GH + h) * NT + t0) * GD + 2 * lane;
#pragma unroll
        for (int j = 0; j < 8; ++j) {
            float y0 = 0.f, y1 = 0.f;
#pragma unroll
            for (int i = 0; i < 4; ++i) { y0 += hlo(xv[j + i]) * w0[i]; y1 += hhi(xv[j + i]) * w1[i]; }
            y0 = siluf(y0); y1 = siluf(y1);
            if (which < 2) { const float ss = wave_sum(y0 * y0 + y1 * y1, lane); float r = rsqrtf(ss + EPS); if (which == 0) r *= 0.08838834764831845f; y0 *= r; y1 *= r; }
            *(unsigned*)(dst + (size_t)j * GD) = pkh(y0, y1);
        }
        if (hs == 8 && lane < 32) { const int j = lane >> 2, hd = lane & 3; const size_t m = (size_t)m0 + j;
            const float braw = AB32[m * 8 + hd], araw = AB32[m * 8 + 4 + hd];
            const float xx = araw + dt_bias[hd]; const float sp = (xx > 20.f) ? xx : log1pf(__expf(xx));
            Gg[(size_t)(b * GH + hd) * NT + t0 + j] = -__expf(a_log[hd]) * sp;
            Gb[(size_t)(b * GH + hd) * NT + t0 + j] = sigmf(braw);
        }
    }
}
typedef _Float16 h8_t __attribute__((ext_vector_type(8)));
typedef _Float16 h4_t __attribute__((ext_vector_type(4)));
typedef float f32x16_t __attribute__((ext_vector_type(16)));
__device__ __forceinline__ h8_t ldfrag_perm(const f16_t* p16, int h) {
    const h4_t a = *(const h4_t*)(p16 + 4 * h), b = *(const h4_t*)(p16 + 8 + 4 * h);
    return (h8_t){a[0], a[1], a[2], a[3], b[0], b[1], b[2], b[3]};
}
__device__ __forceinline__ h8_t acc2frag(const f32x16_t& x, int s) {
    u32x4_t w; w.x = pkh(x[8 * s + 0], x[8 * s + 1]); w.y = pkh(x[8 * s + 2], x[8 * s + 3]); w.z = pkh(x[8 * s + 4], x[8 * s + 5]); w.w = pkh(x[8 * s + 6], x[8 * s + 7]);
    return __builtin_bit_cast(h8_t, w);
}
__device__ __forceinline__ int crow16(int reg, int h) { return (reg & 3) + 8 * (reg >> 2) + 4 * h; }

__device__ __forceinline__ void phase_gdn_chunk(const Ctx& C, f16_t* GQ, f16_t* GK, f16_t* GV, const float* Gg, const float* Gb, f16_t* UIMG, f16_t* ATT, float* DL) {
    const int hb = C.tid >> 8, th = C.tid & 255, lane = C.lane, hw = C.wave & 3, r = lane & 31, h = lane >> 5;
    LAS unsigned char* base = C.lds + hb * 65536;
    LAS f16_t* Kt = (LAS f16_t*)base;
    LAS f16_t* Qt = (LAS f16_t*)(base + 17408);
    LAS float* Lm = (LAS float*)(base + 34816);
    LAS float* gcs = (LAS float*)(base + 51200);
    for (int u = C.bid * 2 + hb; u < NB * GH * 64; u += C.G * 2) {
        const int bh = u >> 6, n = u & 63; const size_t row0 = (size_t)bh * NT + 64 * n;
        if (hw == 0) {
            float g = Gg[row0 + lane];
#pragma unroll
            for (int o = 1; o < 64; o <<= 1) { const float t = lshf(g, lane - o); if (lane >= o) g += t; }
            const float glast = lshf(g, 63);
            gcs[lane] = g; gcs[64 + lane] = __expf(g); gcs[128 + lane] = Gb[row0 + lane]; gcs[192 + lane] = __expf(glast - g);
            if (lane == 63) DL[u] = __expf(g);
        }
#pragma unroll
        for (int q = 0; q < 4; ++q) { const int idx = th + 256 * q, row = idx >> 4, ch = idx & 15;
            *(LAS u32x4_t*)(Kt + row * 136 + ch * 8) = *(const u32x4_t*)(GK + (row0 + row) * GD + ch * 8);
            *(LAS u32x4_t*)(Qt + row * 136 + ch * 8) = *(const u32x4_t*)(GQ + (row0 + row) * GD + ch * 8); }
        __syncthreads();
        { const int ti = hw >> 1, tj = hw & 1;
          f32x16_t kk = {}, qk = {};
          if (ti >= tj) {
#pragma unroll
              for (int s = 0; s < 8; ++s) {
                  const h8_t bk = *(const LAS h8_t*)(Kt + (32 * tj + r) * 136 + 16 * s + 8 * h);
                  const h8_t ak = *(const LAS h8_t*)(Kt + (32 * ti + r) * 136 + 16 * s + 8 * h);
                  const h8_t aq = *(const LAS h8_t*)(Qt + (32 * ti + r) * 136 + 16 * s + 8 * h);
                  kk = __builtin_amdgcn_mfma_f32_32x32x16_f16(ak, bk, kk, 0, 0, 0);
                  qk = __builtin_amdgcn_mfma_f32_32x32x16_f16(aq, bk, qk, 0, 0, 0);
              }
          }
          const int sidx = 32 * tj + r; const float gs = gcs[sidx];
          f16_t* att = ATT + (size_t)u * 4096;
#pragma unroll
          for (int reg = 0; reg < 16; ++reg) { const int c = 32 * ti + crow16(reg, h);
              const float dec = (sidx <= c) ? __expf(gcs[c] - gs) : 0.f;
              Lm[c * 64 + sidx] = (sidx < c) ? gcs[128 + c] * kk[reg] * dec : 0.f;
              att[c * 64 + sidx] = f2h(qk[reg] * dec); }
        }
        __syncthreads();
        float sol[64];
        { const bool isu = th < 128; const int col = th & 127;
#pragma unroll
          for (int c = 0; c < 64; ++c) { const float bc = gcs[128 + c];
              sol[c] = isu ? bc * h2f(GV[(row0 + c) * GD + col]) : bc * gcs[64 + c] * h2f(Kt[c * 136 + col]); }
#pragma unroll
          for (int c = 1; c < 64; ++c) { float a0 = 0.f, a1 = 0.f;
#pragma unroll
              for (int s4 = 0; s4 < (c + 3) / 4; ++s4) { const f32x4_t lv = *(const LAS f32x4_t*)(Lm + c * 64 + 4 * s4);
                  if (4 * s4 + 0 < c) a0 += lv.x * sol[4 * s4 + 0];
                  if (4 * s4 + 1 < c) a1 += lv.y * sol[4 * s4 + 1];
                  if (4 * s4 + 2 < c) a0 += lv.z * sol[4 * s4 + 2];
                  if (4 * s4 + 3 < c) a1 += lv.w * sol[4 * s4 + 3]; }
              sol[c] -= a0 + a1; }
        }
        __syncthreads();
        if (th < 128) {
            const int w = th >> 5, rr = th & 31; f16_t* up = UIMG + (size_t)u * 8192 + w * 2048;
#pragma unroll
            for (int tile = 0; tile < 2; ++tile)
#pragma unroll
                for (int hh = 0; hh < 2; ++hh) { u32x4_t o0, o1;
#define SOLV(reg) sol[32 * tile + ((reg) & 3) + 8 * ((reg) >> 2) + 4 * hh]
                    o0.x = pkh(SOLV(0), SOLV(1)); o0.y = pkh(SOLV(2), SOLV(3)); o0.z = pkh(SOLV(4), SOLV(5)); o0.w = pkh(SOLV(6), SOLV(7));
                    o1.x = pkh(SOLV(8), SOLV(9)); o1.y = pkh(SOLV(10), SOLV(11)); o1.z = pkh(SOLV(12), SOLV(13)); o1.w = pkh(SOLV(14), SOLV(15));
#undef SOLV
                    u32x4_t* dst = (u32x4_t*)(up + tile * 1024 + (rr + 32 * hh) * 16); dst[0] = o0; dst[1] = o1; }
        } else { const int col = th - 128;
#pragma unroll
            for (int c = 0; c < 64; ++c) GV[(row0 + c) * GD + col] = f2h(sol[c]); }
#pragma unroll
        for (int q = 0; q < 4; ++q) { const int idx = th + 256 * q, row = idx >> 4, ch = idx & 15; const float e = gcs[64 + row];
            const h8_t v = *(const LAS h8_t*)(Qt + row * 136 + ch * 8); u32x4_t o;
            o.x = pkh((float)v[0] * e, (float)v[1] * e); o.y = pkh((float)v[2] * e, (float)v[3] * e); o.z = pkh((float)v[4] * e, (float)v[5] * e); o.w = pkh((float)v[6] * e, (float)v[7] * e);
            *(u32x4_t*)(GQ + (row0 + row) * GD + ch * 8) = o; }
        { const int dk = th & 127, ch = th >> 7; f16_t* kd = GK + row0 * GD + dk * 64 + 32 * ch;
#pragma unroll
          for (int q = 0; q < 4; ++q) { float v[8];
#pragma unroll
              for (int e = 0; e < 8; ++e) { const int c = 32 * ch + 8 * q + e; v[e] = h2f(Kt[c * 136 + dk]) * gcs[192 + c]; }
              u32x4_t o; o.x = pkh(v[0], v[1]); o.y = pkh(v[2], v[3]); o.z = pkh(v[4], v[5]); o.w = pkh(v[6], v[7]);
              *(u32x4_t*)(kd + 8 * q) = o; } }
        __syncthreads();
    }
}

constexpr int SC_W = 0, SC_Q = 16384, SC_K = 32768, SC_A = 49152, SC_U = 57344, SC_BUF = 73728;
__device__ __forceinline__ h8_t lds_fragx(const LAS unsigned char* base, int rowoff, int xs, int c) {
    const h4_t a = *(const LAS h4_t*)(base + rowoff + ((c << 4) ^ xs)), b = *(const LAS h4_t*)(base + rowoff + (((c + 1) << 4) ^ xs));
    return (h8_t){a[0], a[1], a[2], a[3], b[0], b[1], b[2], b[3]};
}
__device__ __forceinline__ void scan_stage(const Ctx& C, LAS unsigned char* buf, const f16_t* Wg, const f16_t* Qg, const f16_t* Kg, const f16_t* Ag, const f16_t* Ug) {
    const int L = C.tid - 256;
    u32x4_t w[4], q[4], k[4], a[2], u[4];
#pragma unroll
    for (int i = 0; i < 4; ++i) { const int x = L + 256 * i; w[i] = ((const u32x4_t*)Wg)[x]; q[i] = ((const u32x4_t*)Qg)[x]; k[i] = ((const u32x4_t*)Kg)[x]; u[i] = ((const u32x4_t*)Ug)[x]; }
#pragma unroll
    for (int i = 0; i < 2; ++i) a[i] = ((const u32x4_t*)Ag)[L + 256 * i];
#pragma unroll
    for (int i = 0; i < 4; ++i) { const int x = L + 256 * i;
        { const int R = x >> 4, c = x & 15; *(LAS u32x4_t*)(buf + SC_W + R * 256 + ((c ^ (R & 15)) << 4)) = w[i]; *(LAS u32x4_t*)(buf + SC_Q + R * 256 + ((c ^ (R & 15)) << 4)) = q[i]; }
        { const int R = x >> 3, c = x & 7; *(LAS u32x4_t*)(buf + SC_K + R * 128 + ((c ^ ((R >> 1) & 7)) << 4)) = k[i]; }
        *(LAS u32x4_t*)(buf + SC_U + x * 16) = u[i]; }
#pragma unroll
    for (int i = 0; i < 2; ++i) { const int x = L + 256 * i, R = x >> 3, c = x & 7; *(LAS u32x4_t*)(buf + SC_A + R * 128 + ((c ^ ((R >> 1) & 7)) << 4)) = a[i]; }
}
__device__ __forceinline__ void phase_gdn_scan(const Ctx& C, int bh, const f16_t* QG, const f16_t* KDT, const f16_t* W, const f16_t* UIMG, const f16_t* ATT, const float* DL, f16_t* OG16) {
    const int lane = C.lane, r = lane & 31, h = lane >> 5, w = C.wave, b = bh / GH, hh = bh % GH;
    f32x16_t S[4];
#pragma unroll
    for (int T = 0; T < 4; ++T) S[T] = (f32x16_t){};
    __syncthreads();
    if (w >= 4) { const size_t row0 = (size_t)bh * NT; scan_stage(C, C.lds, W + row0 * GD, QG + row0 * GD, KDT + row0 * GD, ATT + (size_t)(bh * 64) * 4096, UIMG + (size_t)(bh * 64) * 8192); }
    __syncthreads();
#pragma unroll 1
    for (int n = 0; n < 64; ++n) {
        LAS unsigned char* cur = C.lds + (n & 1) * SC_BUF;
        if (w >= 4) {
            if (n + 1 < 64) { const size_t row0 = (size_t)bh * NT + 64 * (n + 1); const int u = bh * 64 + n + 1;
                scan_stage(C, C.lds + ((n + 1) & 1) * SC_BUF, W + row0 * GD, QG + row0 * GD, KDT + row0 * GD, ATT + (size_t)u * 4096, UIMG + (size_t)u * 8192); }
        } else {
            const int u = bh * 64 + n;
            const float dl = DL[u];
            int x256 = (r & 15) << 4, x128 = ((r >> 1) & 7) << 4, ro256 = r * 256 + 8 * h, ro128 = r * 128 + 8 * h;
            asm volatile("" : "+v"(x256), "+v"(x128), "+v"(ro256), "+v"(ro128));
            h8_t sf[4][2];
#pragma unroll
            for (int T = 0; T < 4; ++T) { sf[T][0] = acc2frag(S[T], 0); sf[T][1] = acc2frag(S[T], 1); }
            f32x16_t ws[2], qs[2];
#pragma unroll
            for (int ct = 0; ct < 2; ++ct) { ws[ct] = (f32x16_t){}; qs[ct] = (f32x16_t){};
#pragma unroll
                for (int T = 0; T < 4; ++T)
#pragma unroll
                    for (int s = 0; s < 2; ++s) {
                        ws[ct] = __builtin_amdgcn_mfma_f32_32x32x16_f16(lds_fragx(cur + SC_W + ct * 8192, ro256, x256, 4 * T + 2 * s), sf[T][s], ws[ct], 0, 0, 0);
                        qs[ct] = __builtin_amdgcn_mfma_f32_32x32x16_f16(lds_fragx(cur + SC_Q + ct * 8192, ro256, x256, 4 * T + 2 * s), sf[T][s], qs[ct], 0, 0, 0);
                        __builtin_amdgcn_sched_barrier(0);
                    } }
            h8_t vf[2][2];
#pragma unroll
            for (int ct = 0; ct < 2; ++ct) { const LAS h8_t* up = (const LAS h8_t*)(cur + SC_U + (w * 2048 + ct * 1024 + lane * 16) * 2); const h8_t u0 = up[0], u1 = up[1];
                f32x16_t vn;
#pragma unroll
                for (int e = 0; e < 8; ++e) { vn[e] = (float)u0[e] - ws[ct][e]; vn[8 + e] = (float)u1[e] - ws[ct][8 + e]; }
                vf[ct][0] = acc2frag(vn, 0); vf[ct][1] = acc2frag(vn, 1); }
#pragma unroll
            for (int ct = 0; ct < 2; ++ct)
#pragma unroll
                for (int c2 = 0; c2 < 2; ++c2)
#pragma unroll
                    for (int s = 0; s < 2; ++s)
                    { qs[ct] = __builtin_amdgcn_mfma_f32_32x32x16_f16(lds_fragx(cur + SC_A + ct * 4096, ro128, x128, 4 * c2 + 2 * s), vf[c2][s], qs[ct], 0, 0, 0); __builtin_amdgcn_sched_barrier(0); }
            { f16_t* op = OG16 + ((size_t)b * NT + 64 * n) * GW + hh * GD + 32 * w + r;
#pragma unroll
              for (int ct = 0; ct < 2; ++ct)
#pragma unroll
                  for (int reg = 0; reg < 16; ++reg) op[(size_t)(32 * ct + crow16(reg, h)) * GW] = f2h(qs[ct][reg]); }
#pragma unroll
            for (int T = 0; T < 4; ++T) { S[T] = S[T] * dl;
#pragma unroll
                for (int c2 = 0; c2 < 2; ++c2)
#pragma unroll
                    for (int s = 0; s < 2; ++s)
                    { S[T] = __builtin_amdgcn_mfma_f32_32x32x16_f16(lds_fragx(cur + SC_K + T * 4096, ro128, x128, 4 * c2 + 2 * s), vf[c2][s], S[T], 0, 0, 0); __builtin_amdgcn_sched_barrier(0); } }
        }
        __syncthreads();
    }
}
__device__ __forceinline__ void phase_gdn_out16(const Ctx& C, const f16_t* OG16, const f16_t* Z16, const float* ng, f16_t* Y) {
    const int lane = C.lane, hd = lane >> 4, c0 = (lane & 15) * 8;
    const f32x4_t ga = *(const f32x4_t*)(ng + c0), gb = *(const f32x4_t*)(ng + c0 + 4);
    const float gv[8] = {ga.x, ga.y, ga.z, ga.w, gb.x, gb.y, gb.z, gb.w};
    for (int m0 = C.gw * 4; m0 < MR; m0 += C.NGW * 4) {
        u32x4_t ov[4], zv[4];
#pragma unroll
        for (int i = 0; i < 4; ++i) { ov[i] = *(const u32x4_t*)(OG16 + (size_t)(m0 + i) * GW + lane * 8); zv[i] = *(const u32x4_t*)(Z16 + (size_t)(m0 + i) * GW + lane * 8); }
#pragma unroll
        for (int i = 0; i < 4; ++i) { const unsigned ou[4] = {ov[i].x, ov[i].y, ov[i].z, ov[i].w}, zu[4] = {zv[i].x, zv[i].y, zv[i].z, zv[i].w};
            float o[8], z[8], ss = 0.f;
#pragma unroll
            for (int e = 0; e < 4; ++e) { o[2 * e] = hlo(ou[e]); o[2 * e + 1] = hhi(ou[e]); z[2 * e] = hlo(zu[e]); z[2 * e + 1] = hhi(zu[e]); ss += o[2 * e] * o[2 * e] + o[2 * e + 1] * o[2 * e + 1]; }
            ss += lshx(ss, lane, 1); ss += lshx(ss, lane, 2); ss += lshx(ss, lane, 4); ss += lshx(ss, lane, 8);
            const float rr = rsqrtf(ss * (1.f / GD) + EPS);
            u32x4_t w; w.x = pkh(o[0] * rr * gv[0] * siluf(z[0]), o[1] * rr * gv[1] * siluf(z[1])); w.y = pkh(o[2] * rr * gv[2] * siluf(z[2]), o[3] * rr * gv[3] * siluf(z[3]));
            w.z = pkh(o[4] * rr * gv[4] * siluf(z[4]), o[5] * rr * gv[5] * siluf(z[5])); w.w = pkh(o[6] * rr * gv[6] * siluf(z[6]), o[7] * rr * gv[7] * siluf(z[7]));
            *(u32x4_t*)(Y + (size_t)(m0 + i) * DM + hd * GD + c0) = w; }
    }
}
constexpr float QSCALE = 0.125f * 1.4426950408889634f;
__device__ __forceinline__ void phase_nsa_prep(const Ctx& C, const int* positions, const float* QN32, const float* KC32, const f16_t* KV16,
                                               f16_t* Q16, f16_t* KCR, f16_t* KSR, f16_t* KWR, f16_t* VC16) {
    const int lane = C.lane, oct = lane & 7, seg = lane >> 4, g = (lane >> 3) & 1;
    const float invf = powf(500000.0f, -(float)oct * 0.125f);
    const int coff = (seg == 1) ? 128 : (seg == 2) ? 384 : 0;
    for (int m0 = C.gw * 4; m0 < MR; m0 += C.NGW * 4) {
        f32x4_t qa[4], qb[4], ka[4], kb[4]; u32x4_t kh[4]; float pos[4];
#pragma unroll
        for (int j = 0; j < 4; ++j) { const size_t m = (size_t)m0 + j; pos[j] = (float)positions[m];
            const f32x4_t* src = (const f32x4_t*)(QN32 + m * 512 + lane * 8); qa[j] = src[0]; qb[j] = src[1];
            if (seg == 0) { const f32x4_t* ks = (const f32x4_t*)(KC32 + m * 128 + (lane & 15) * 8); ka[j] = ks[0]; kb[j] = ks[1]; }
            else kh[j] = *(const u32x4_t*)(KV16 + m * 640 + coff + (lane & 15) * 8); }
#pragma unroll
        for (int j = 0; j < 4; ++j) { const int m = m0 + j, b = m / NT, t = m % NT;
            const float ang = pos[j] * invf; const float cs = cosf(ang), sn = sinf(ang);
            float cv[8], sv[8];
#pragma unroll
            for (int e = 0; e < 8; ++e) { cv[e] = lshf(cs, e); sv[e] = lshf(sn, e); }
            { const float v[8] = {qa[j].x, qa[j].y, qa[j].z, qa[j].w, qb[j].x, qb[j].y, qb[j].z, qb[j].w}; float o[8];
#pragma unroll
              for (int e = 0; e < 8; ++e) { const float pv = lshx(v[e], lane, 1); o[e] = (oct == 0) ? (v[e] * cv[e] - pv * sv[e]) : (oct == 1) ? (v[e] * cv[e] + pv * sv[e]) : v[e]; o[e] *= QSCALE; }
              u32x4_t w; w.x = pkh(o[0], o[1]); w.y = pkh(o[2], o[3]); w.z = pkh(o[4], o[5]); w.w = pkh(o[6], o[7]);
              *(u32x4_t*)(Q16 + (size_t)m * 512 + lane * 8) = w; }
            { float v[8];
              if (seg == 0) { v[0] = ka[j].x; v[1] = ka[j].y; v[2] = ka[j].z; v[3] = ka[j].w; v[4] = kb[j].x; v[5] = kb[j].y; v[6] = kb[j].z; v[7] = kb[j].w; }
              else { const unsigned ku[4] = {kh[j].x, kh[j].y, kh[j].z, kh[j].w};
#pragma unroll
                  for (int e = 0; e < 4; ++e) { v[2 * e] = hlo(ku[e]); v[2 * e + 1] = hhi(ku[e]); } }
              float o[8];
#pragma unroll
              for (int e = 0; e < 8; ++e) { const float pv = lshx(v[e], lane, 1); o[e] = (seg == 3) ? v[e] : (oct == 0) ? (v[e] * cv[e] - pv * sv[e]) : (oct == 1) ? (v[e] * cv[e] + pv * sv[e]) : v[e]; }
              u32x4_t w; w.x = pkh(o[0], o[1]); w.y = pkh(o[2], o[3]); w.z = pkh(o[4], o[5]); w.w = pkh(o[6], o[7]);
              f16_t* dst = (seg == 0 ? KCR : seg == 1 ? KSR : seg == 2 ? KWR : VC16) + ((size_t)(b * NG + g) * NT + t) * HD + oct * 8;
              *(u32x4_t*)dst = w; }
        }
    }
}
__device__ __forceinline__ void phase_nsa_vtrans(const Ctx& C, const f16_t* KV16, f16_t* VST, f16_t* VWT) {
    const int lane = C.lane;
    for (int it = C.gw; it < NB * NG * (NT / 64) * 2; it += C.NGW) {
        const int which = it & 1, tile = (it >> 1) % (NT / 64), bg = (it >> 1) / (NT / 64), b = bg / NG, g = bg % NG;
        const f16_t* src = KV16 + ((size_t)b * NT + tile * 64 + lane) * 640 + (which ? 512 : 256) + g * 64;
        f16_t* dst = (which ? VWT : VST) + (size_t)bg * HD * NT + tile * 64 + lane;
#pragma unroll
        for (int c8 = 0; c8 < 8; ++c8) { const u32x4_t w = *(const u32x4_t*)(src + c8 * 8); const unsigned ws[4] = {w.x, w.y, w.z, w.w};
#pragma unroll
            for (int i = 0; i < 4; ++i) { dst[(size_t)(c8 * 8 + 2 * i) * NT] = (f16_t)(ws[i] & 0xffffu); dst[(size_t)(c8 * 8 + 2 * i + 1) * NT] = (f16_t)(ws[i] >> 16); } }
    }
}

__device__ __forceinline__ void phase_cmp_weights(const Ctx& C, f16_t* W1C, f16_t* W2C, float* C1) {
    LAS float* scr = (LAS float*)(C.lds + 32768) + C.wave * (64 * 33);
    constexpr int I1 = 32 * 4;
    for (int it = C.gw; it < 4 * I1; it += C.NGW) { const int mi = it / I1, q = it % I1, kb = q / 4, nb = q % 4, l = mi >> 1, w = mi & 1;
        wconv_item((w ? PA(w1_v) : PA(w1_k)) + (size_t)l * 2048 * 128, 2048, 128, W1C + (size_t)mi * 128 * 2048, 64 * kb, 32 * nb, 32 * nb, scr, C.lane); }
    for (int i = C.bid * NTHR + C.tid; i < 4 * 64 * 128; i += C.G * NTHR) { const int mi = i / 8192, d = (i % 8192) / 128, hd = i % 128, l = mi >> 1, w = mi & 1;
        W2C[i] = f2h(((w ? PA(w2_v) : PA(w2_k)) + (size_t)l * 128 * 64)[hd * 64 + d]); }
    for (int i = C.NGW - 1 - C.gw; i < 4 * 128; i += C.NGW) { const int mi = i / 128, j = i % 128, l = mi >> 1, w = mi & 1;
        const float* pe = (w ? PA(pe_v) : PA(pe_k)) + (size_t)l * 2048; const float* w1 = (w ? PA(w1_v) : PA(w1_k)) + (size_t)l * 2048 * 128;
        float a = 0.f;
#pragma unroll
        for (int q = 0; q < 32; ++q) { const int k = C.lane + 64 * q; a += pe[k] * w1[(size_t)k * 128 + j]; }
        a = wave_sum(a, C.lane);
        if (C.lane == 0) C1[i] = a; }
}

__device__ __forceinline__ void phase_compress_mfma(const Ctx& C, int lastfirst, const f16_t* KCR, const f16_t* VC16, const f16_t* W1C, const f16_t* W2C, const float* C1, f16_t* KCMP16, f16_t* VCMPT) {
    const int lane = C.lane, r = lane & 31, h = lane >> 5, ht = C.wave & 3, hb = C.wave >> 2;
    (void)lastfirst;
    LAS float* part = (LAS float*)C.lds + hb * 8192;
    const int gb = (C.G - 1 - C.bid) * 2 + hb;
    for (int grp = gb; grp < 2 * NB * NG * 8; grp += C.G * 2) {
        const int rt = grp & 7, bg = (grp >> 3) % (NB * NG), which = grp / (8 * NB * NG);
        const f16_t* src = (which ? VC16 : KCR) + (size_t)bg * NT * HD + (size_t)(32 * rt + r) * 1024 + 8 * h;
        const f16_t* w1 = W1C + (size_t)which * 128 * 2048 + (size_t)(32 * ht + r) * 2048 + 8 * h;
        f32x16_t acc = (f32x16_t){};
#pragma unroll 16
        for (int ks = 0; ks < 128; ++ks) acc = __builtin_amdgcn_mfma_f32_32x32x16_f16(*(const h8_t*)(w1 + 16 * ks), *(const h8_t*)(src + 16 * ks), acc, 0, 0, 0);
#pragma unroll
        for (int reg = 0; reg < 16; ++reg) acc[reg] = siluf(acc[reg] + C1[which * 128 + 32 * ht + crow16(reg, h)]);
        const h8_t hf0 = acc2frag(acc, 0), hf1 = acc2frag(acc, 1);
        const f16_t* w2 = W2C + (size_t)which * 64 * 128;
#pragma unroll
        for (int dt = 0; dt < 2; ++dt) { f32x16_t o = (f32x16_t){};
            o = __builtin_amdgcn_mfma_f32_32x32x16_f16(ldfrag_perm(w2 + (32 * dt + r) * 128 + 32 * ht, h), hf0, o, 0, 0, 0);
            o = __builtin_amdgcn_mfma_f32_32x32x16_f16(ldfrag_perm(w2 + (32 * dt + r) * 128 + 32 * ht + 16, h), hf1, o, 0, 0, 0);
            LAS f32x4_t* pp = (LAS f32x4_t*)(part + ((ht * 2 + dt) * 64 + lane) * 16);
            pp[0] = (f32x4_t){o[0], o[1], o[2], o[3]}; pp[1] = (f32x4_t){o[4], o[5], o[6], o[7]}; pp[2] = (f32x4_t){o[8], o[9], o[10], o[11]}; pp[3] = (f32x4_t){o[12], o[13], o[14], o[15]}; }
        __syncthreads();
        { const int dt = ht >> 1, s = ht & 1;
          float v[8];
#pragma unroll
          for (int e = 0; e < 8; ++e) v[e] = 0.f;
#pragma unroll
          for (int k = 0; k < 4; ++k) { const LAS f32x4_t* pp = (const LAS f32x4_t*)(part + ((k * 2 + dt) * 64 + lane) * 16 + 8 * s); const f32x4_t a = pp[0], b2 = pp[1];
              v[0] += a.x; v[1] += a.y; v[2] += a.z; v[3] += a.w; v[4] += b2.x; v[5] += b2.y; v[6] += b2.z; v[7] += b2.w; }
          const int n = 32 * rt + r; const bool live = n < NCMP;
          if (which == 0) {
#pragma unroll
              for (int q = 0; q < 2; ++q) { u32x2_t w; w.x = live ? pkh(v[4 * q], v[4 * q + 1]) : 0u; w.y = live ? pkh(v[4 * q + 2], v[4 * q + 3]) : 0u;
                  *(u32x2_t*)(KCMP16 + ((size_t)bg * 256 + n) * HD + 32 * dt + 16 * s + 8 * q + 4 * h) = w; }
          } else {
#pragma unroll
              for (int e = 0; e < 8; ++e) VCMPT[((size_t)bg * HD + 32 * dt + crow16(8 * s + e, h)) * 256 + n] = live ? f2h(v[e]) : (f16_t)0;
          } }
        __syncthreads();
    }
}

struct AttnState { f32x16_t o[2]; float m, l; };
template <int MODE> __device__ __forceinline__ void nsa_tile(AttnState& st, const f16_t* Kp, const f16_t* Vtp, int key0, const h8_t (&qf)[4], bool rowsel, int tlo, int thi, int r, int h) {
    f32x16_t p[2];
#pragma unroll
    for (int kt = 0; kt < 2; ++kt) { p[kt] = (f32x16_t){};
#pragma unroll
        for (int s = 0; s < 4; ++s) p[kt] = __builtin_amdgcn_mfma_f32_32x32x16_f16(*(const h8_t*)(Kp + (size_t)(key0 + 32 * kt + r) * HD + 16 * s + 8 * h), qf[s], p[kt], 0, 0, 0); }
    float tm = -INFINITY;
#pragma unroll
    for (int kt = 0; kt < 2; ++kt)
#pragma unroll
        for (int reg = 0; reg < 16; ++reg) {
            if (MODE != 0) { const int key = key0 + 32 * kt + crow16(reg, h); const bool ok = (MODE == 1) ? (rowsel && key <= thi) : (key >= tlo && key <= thi); if (!ok) p[kt][reg] = -INFINITY; }
            tm = fmaxf(tm, p[kt][reg]); }
    tm = fmaxf(tm, lshx(tm, r + 32 * h, 32));
    if (__any(tm > st.m + 8.f)) {
        const float mn = fmaxf(st.m, tm); const float al = (mn == -INFINITY) ? 1.f : exp2f(st.m - mn);
        st.o[0] = st.o[0] * al; st.o[1] = st.o[1] * al; st.l *= al; st.m = mn;
    }
    float ps = 0.f;
#pragma unroll
    for (int kt = 0; kt < 2; ++kt)
#pragma unroll
        for (int reg = 0; reg < 16; ++reg) { const float e = (p[kt][reg] == -INFINITY) ? 0.f : exp2f(p[kt][reg] - st.m); p[kt][reg] = e; ps += e; }
    st.l += ps;
#pragma unroll
    for (int kt = 0; kt < 2; ++kt)
#pragma unroll
        for (int s = 0; s < 2; ++s) { const h8_t pf = acc2frag(p[kt], s);
#pragma unroll
            for (int dt = 0; dt < 2; ++dt) st.o[dt] = __builtin_amdgcn_mfma_f32_32x32x16_f16(ldfrag_perm(Vtp + (size_t)(32 * dt + r) * NT + key0 + 32 * kt + 16 * s, h), pf, st.o[dt], 0, 0, 0); }
}

template <int MODE> __device__ __forceinline__ void nsa_tile_lds(AttnState& st, const LAS unsigned char* kb, const LAS unsigned char* vb, int key0, const h8_t (&qf)[4], bool rowsel, int tlo, int thi, int r, int h, int ro, int xs) {
    f32x16_t p[2];
    const int hx = (h << 4) ^ xs;
#pragma unroll
    for (int kt = 0; kt < 2; ++kt) { p[kt] = (f32x16_t){};
#pragma unroll
        for (int s = 0; s < 4; ++s) p[kt] = __builtin_amdgcn_mfma_f32_32x32x16_f16(*(const LAS h8_t*)(kb + kt * 4096 + ro + ((s << 5) ^ hx)), qf[s], p[kt], 0, 0, 0); }
    float tm = -INFINITY;
#pragma unroll
    for (int kt = 0; kt < 2; ++kt)
#pragma unroll
        for (int reg = 0; reg < 16; ++reg) {
            if (MODE == 1 || MODE == 2) { const int key = key0 + 32 * kt + crow16(reg, h); const bool ok = (MODE == 1) ? (rowsel && key <= thi) : (key >= tlo && key <= thi); if (!ok) p[kt][reg] = -INFINITY; }
            tm = fmaxf(tm, p[kt][reg]); }
    if (MODE == 3) tm = rowsel ? tm : -INFINITY;
    tm = fmaxf(tm, lshx(tm, r + 32 * h, 32));
    if (__any(tm > st.m + 8.f)) {
        const float mn = fmaxf(st.m, tm); const float al = (mn == -INFINITY) ? 1.f : exp2f(st.m - mn);
        st.o[0] = st.o[0] * al; st.o[1] = st.o[1] * al; st.l *= al; st.m = mn;
    }
    float ps = 0.f; const float me = (MODE == 3 && !rowsel) ? INFINITY : ((st.m == -INFINITY) ? 0.f : st.m);
#pragma unroll
    for (int kt = 0; kt < 2; ++kt)
#pragma unroll
        for (int reg = 0; reg < 16; ++reg) { const float e = __builtin_amdgcn_exp2f(p[kt][reg] - me); p[kt][reg] = e; ps += e; }
    st.l += ps;
    const int rov = ro + 8 * h;
#pragma unroll
    for (int kt = 0; kt < 2; ++kt)
#pragma unroll
        for (int s = 0; s < 2; ++s) { const h8_t pf = acc2frag(p[kt], s);
#pragma unroll
            for (int dt = 0; dt < 2; ++dt) st.o[dt] = __builtin_amdgcn_mfma_f32_32x32x16_f16(lds_fragx(vb + dt * 4096, rov, xs, 4 * kt + 2 * s), pf, st.o[dt], 0, 0, 0); }
}

__device__ __forceinline__ void nsa_unit(int q, LAS float* wl, int lane, const f16_t* Q16, const f16_t* KCMP16, const f16_t* VCMPT, const f16_t* KSR, const f16_t* VST, const f16_t* KWR, const f16_t* VWT,
                                         const float* GR32, const float* ng, f16_t* Y) {
    asm volatile("" : "+v"(lane));
    const int r = lane & 31, h = lane >> 5, tau = r & 7, a = r >> 3;
    const int cur = 63 - (q >> 6), qq = q & 63, b = qq >> 4, g = (qq >> 3) & 1, t0 = 64 * cur + 8 * (qq & 7), bg = b * NG + g, tr = t0 + tau, hq = 4 * g + a;
    const size_t mrow = (size_t)b * NT + tr;
    LAS float* impL = wl; LAS unsigned* maskL = (LAS unsigned*)(wl + 512);
    h8_t qf[4];
#pragma unroll
    for (int s = 0; s < 4; ++s) qf[s] = *(const h8_t*)(Q16 + mrow * 512 + hq * HD + 16 * s + 8 * h);
    const float* gr = GR32 + mrow * 24 + hq * 3;
    const float g0 = sigmf(gr[0]), g1 = sigmf(gr[1]), g2 = sigmf(gr[2]);
    LAS float* finL = wl + 640 + lane * 33;
    {
        const int nvr = (tr >= 31) ? (tr - 31) / 16 + 1 : 0;
        const int nvmax = (t0 + 7 >= 31) ? (t0 + 7 - 31) / 16 + 1 : 0; const int ntl = (nvmax + 31) >> 5;
        const f16_t* kc = KCMP16 + (size_t)bg * 256 * HD; const f16_t* vt = VCMPT + (size_t)bg * HD * 256;
        float mx = -INFINITY, sum = 0.f;
#pragma unroll 1
        for (int nt = 0; nt < ntl; ++nt) { f32x16_t sc = (f32x16_t){};
#pragma unroll
            for (int s = 0; s < 4; ++s) sc = __builtin_amdgcn_mfma_f32_32x32x16_f16(*(const h8_t*)(kc + (size_t)(32 * nt + r) * HD + 16 * s + 8 * h), qf[s], sc, 0, 0, 0);
#pragma unroll
            for (int reg = 0; reg < 16; ++reg) if (32 * nt + crow16(reg, h) < nvr) mx = fmaxf(mx, sc[reg]); }
        mx = fmaxf(mx, lshx(mx, lane, 32));
#pragma unroll 1
        for (int nt = 0; nt < ntl; ++nt) { f32x16_t sc = (f32x16_t){};
#pragma unroll
            for (int s = 0; s < 4; ++s) sc = __builtin_amdgcn_mfma_f32_32x32x16_f16(*(const h8_t*)(kc + (size_t)(32 * nt + r) * HD + 16 * s + 8 * h), qf[s], sc, 0, 0, 0);
#pragma unroll
            for (int reg = 0; reg < 16; ++reg) if (32 * nt + crow16(reg, h) < nvr) sum += exp2f(sc[reg] - mx); }
        sum += lshx(sum, lane, 32);
        const float inv = 1.f / fmaxf(sum, 1e-30f);
        if (a == 0) {
#pragma unroll
            for (int gi = 0; gi < 32; ++gi) { const int j = 2 * gi + h; const bool valid = j <= cur, forced = (j == 0) || (j == cur) || (j == cur - 1);
                impL[tau * 64 + j] = forced ? INFINITY : (valid ? 0.f : -INFINITY); }
        }
        f32x16_t oc[2]; oc[0] = (f32x16_t){}; oc[1] = (f32x16_t){};
        float carry = 0.f;
#pragma unroll 1
        for (int nt = 0; nt < ntl; ++nt) { f32x16_t sc = (f32x16_t){};
#pragma unroll
            for (int s = 0; s < 4; ++s) sc = __builtin_amdgcn_mfma_f32_32x32x16_f16(*(const h8_t*)(kc + (size_t)(32 * nt + r) * HD + 16 * s + 8 * h), qf[s], sc, 0, 0, 0);
#pragma unroll
            for (int reg = 0; reg < 16; ++reg) sc[reg] = (32 * nt + crow16(reg, h) < nvr) ? exp2f(sc[reg] - mx) * inv : 0.f;
#pragma unroll
            for (int s = 0; s < 2; ++s) { const h8_t pf = acc2frag(sc, s);
#pragma unroll
                for (int dt = 0; dt < 2; ++dt) oc[dt] = __builtin_amdgcn_mfma_f32_32x32x16_f16(ldfrag_perm(vt + (size_t)(32 * dt + r) * 256 + 32 * nt + 16 * s, h), pf, oc[dt], 0, 0, 0); }
#pragma unroll
            for (int qd = 0; qd < 4; ++qd) {
                const float G = (sc[4 * qd] + sc[4 * qd + 1]) + (sc[4 * qd + 2] + sc[4 * qd + 3]);
                const float ol = lshx(sc[4 * qd + 3], lane, 32);
                const float ol2 = lshx(qd == 0 ? carry : sc[4 * qd - 1], lane, 32);
                float v = G + ((h == 1) ? ol : ol2);
                v += lshx(v, lane, 8); v += lshx(v, lane, 16);
                const int j = 2 * (4 * nt + qd) + h; const bool valid = j <= cur, forced = (j == 0) || (j == cur) || (j == cur - 1);
                if (a == 0) impL[tau * 64 + j] = forced ? INFINITY : (valid ? v : -INFINITY); }
            carry = sc[15];
        }
#pragma unroll
        for (int dt = 0; dt < 2; ++dt)
#pragma unroll
            for (int reg = 0; reg < 16; ++reg) finL[16 * dt + reg] = oc[dt][reg] * g0;
        __builtin_amdgcn_wave_barrier();
        { const int tk = lane >> 3, part = lane & 7; float mine[8]; int rank[8];
#pragma unroll
          for (int e = 0; e < 8; ++e) { mine[e] = impL[tk * 64 + 8 * part + e]; rank[e] = 0; }
          for (int j4 = 0; j4 < 16; ++j4) { const f32x4_t o4 = *(const LAS f32x4_t*)(impL + tk * 64 + 4 * j4); const float ov[4] = {o4.x, o4.y, o4.z, o4.w};
#pragma unroll
              for (int c = 0; c < 4; ++c) { const int jj = 4 * j4 + c;
#pragma unroll
                  for (int e = 0; e < 8; ++e) rank[e] += (ov[c] > mine[e] || (ov[c] == mine[e] && jj < 8 * part + e)) ? 1 : 0; } }
          unsigned bits = 0;
#pragma unroll
          for (int e = 0; e < 8; ++e) bits |= ((rank[e] < NSEL) && (8 * part + e <= cur)) ? (1u << e) : 0u;
          unsigned lo = (part < 4) ? (bits << (8 * part)) : 0u, hi = (part >= 4) ? (bits << (8 * (part - 4))) : 0u;
#pragma unroll
          for (int o = 1; o < 8; o <<= 1) { lo |= lshx(lo, lane, o); hi |= lshx(hi, lane, o); }
          if (part == 0) { maskL[2 * tk] = lo; maskL[2 * tk + 1] = hi; } }
        __builtin_amdgcn_wave_barrier();
    }
    {
        unsigned ulo = 0, uhi = 0;
#pragma unroll
        for (int e = 0; e < 8; ++e) { ulo |= maskL[2 * e]; uhi |= maskL[2 * e + 1]; }
        ulo = __builtin_amdgcn_readfirstlane(ulo); uhi = __builtin_amdgcn_readfirstlane(uhi);
        const unsigned mlo = maskL[2 * tau], mhi = maskL[2 * tau + 1];
        const unsigned long long rowmask = ((unsigned long long)mhi << 32) | mlo; unsigned long long um = ((unsigned long long)uhi << 32) | ulo;
        AttnState st; st.o[0] = (f32x16_t){}; st.o[1] = (f32x16_t){}; st.m = -INFINITY; st.l = 0.f;
        const f16_t* Kp = KSR + (size_t)bg * NT * HD; const f16_t* Vp = VST + (size_t)bg * HD * NT;
        while (um) { const int j = __builtin_ctzll(um); um &= um - 1;
            nsa_tile<1>(st, Kp, Vp, 64 * j, qf, (rowmask >> j) & 1ull, 0, tr, r, h); }
        const float lt = st.l + lshx(st.l, lane, 32); const float sc1 = g1 / fmaxf(lt, 1e-30f);
#pragma unroll
        for (int dt = 0; dt < 2; ++dt)
#pragma unroll
            for (int reg = 0; reg < 16; ++reg) finL[16 * dt + reg] += st.o[dt][reg] * sc1;
    }
    f32x16_t fin[2];
    {
        AttnState st; st.o[0] = (f32x16_t){}; st.o[1] = (f32x16_t){}; st.m = -INFINITY; st.l = 0.f;
        const f16_t* Kp = KWR + (size_t)bg * NT * HD; const f16_t* Vp = VWT + (size_t)bg * HD * NT;
        const int lo = max(tr - WIN + 1, 0), j0 = max(t0 - WIN + 1, 0) >> 6;
        for (int j = j0; j <= cur; ++j) {
            if (j <= j0 + 1 || j == cur) nsa_tile<2>(st, Kp, Vp, 64 * j, qf, true, lo, tr, r, h);
            else nsa_tile<0>(st, Kp, Vp, 64 * j, qf, true, lo, tr, r, h); }
        const float lt = st.l + lshx(st.l, lane, 32); const float sc2 = g2 / fmaxf(lt, 1e-30f);
        fin[0] = st.o[0] * sc2; fin[1] = st.o[1] * sc2;
#pragma unroll
        for (int dt = 0; dt < 2; ++dt)
#pragma unroll
            for (int reg = 0; reg < 16; ++reg) fin[dt][reg] += finL[16 * dt + reg];
    }
    float ss = 0.f;
#pragma unroll
    for (int dt = 0; dt < 2; ++dt)
#pragma unroll
        for (int reg = 0; reg < 16; ++reg) ss += fin[dt][reg] * fin[dt][reg];
    ss += lshx(ss, lane, 32);
    const float rs = rsqrtf(ss * (1.f / HD) + EPS);
    f16_t* yp = Y + mrow * DM + 512 + hq * HD;
#pragma unroll
    for (int dt = 0; dt < 2; ++dt)
#pragma unroll
        for (int qd = 0; qd < 4; ++qd) { const int d = 32 * dt + 8 * qd + 4 * h; const f32x4_t gv = *(const f32x4_t*)(ng + d);
            u32x2_t w; w.x = pkh(fin[dt][4 * qd] * rs * gv.x, fin[dt][4 * qd + 1] * rs * gv.y); w.y = pkh(fin[dt][4 * qd + 2] * rs * gv.z, fin[dt][4 * qd + 3] * rs * gv.w);
            *(u32x2_t*)(yp + d) = w; }
}
__device__ __forceinline__ void nsa_block_unit(int q, LAS unsigned char* lds, int tid, LAS float* wl, int lane, int wave, const f16_t* Q16, const f16_t* KCMP16, const f16_t* VCMPT, const f16_t* KSR, const f16_t* VST, const f16_t* KWR, const f16_t* VWT,
                                         const float* GR32, const float* ng, f16_t* Y) {
    asm volatile("" : "+v"(lane), "+v"(tid));
    const int r = lane & 31, h = lane >> 5, tau = r & 7, a = r >> 3;
    const int cur = 63 - (q >> 3), qq = q & 7, b = qq >> 1, g = qq & 1, t0 = 64 * cur + 8 * wave, bg = b * NG + g, tr = t0 + tau, hq = 4 * g + a;
    const size_t mrow = (size_t)b * NT + tr;
    LAS unsigned* impK = (LAS unsigned*)wl; LAS unsigned* maskL = (LAS unsigned*)(wl + 512);
    h8_t qf[4];
#pragma unroll
    for (int s = 0; s < 4; ++s) qf[s] = *(const h8_t*)(Q16 + mrow * 512 + hq * HD + 16 * s + 8 * h);
    const float* gr = GR32 + mrow * 24 + hq * 3;
    const float g0 = sigmf(gr[0]), g1 = sigmf(gr[1]), g2 = sigmf(gr[2]);
    LAS float* finL = wl + 640 + lane * 33;
    {
        const int nvr = (tr >= 31) ? (tr - 31) / 16 + 1 : 0;
        const int nvmax = (t0 + 7 >= 31) ? (t0 + 7 - 31) / 16 + 1 : 0; const int ntl = (nvmax + 31) >> 5;
        const f16_t* kc = KCMP16 + (size_t)bg * 256 * HD; const f16_t* vt = VCMPT + (size_t)bg * HD * 256;
        LAS unsigned char* cb = lds + 90112;
        const int ntb = min(8, ((64 * cur + 63 >= 31 ? (64 * cur + 63 - 31) / 16 + 1 : 0) + 31) >> 5);
        u32x4_t stg[4];
#pragma unroll
        for (int i = 0; i < 4; ++i) { const int x = tid + 512 * i; if ((x >> 8) < ntb) stg[i] = ((const u32x4_t*)kc)[x]; }
        __syncthreads();
#pragma unroll
        for (int i = 0; i < 4; ++i) { const int x = tid + 512 * i, R = x >> 3, c = x & 7; if ((x >> 8) < ntb) *(LAS u32x4_t*)(cb + R * 128 + ((c ^ ((R >> 1) & 7)) << 4)) = stg[i]; }
        __syncthreads();
        const int ro = r * 128, hx = (h << 4) ^ (((r >> 1) & 7) << 4);
        f32x16_t sc[8]; float mx = -INFINITY;
#pragma unroll
        for (int nt = 0; nt < 8; ++nt) { sc[nt] = (f32x16_t){};
            if (nt < ntl) {
#pragma unroll
                for (int s = 0; s < 4; ++s) sc[nt] = __builtin_amdgcn_mfma_f32_32x32x16_f16(*(const LAS h8_t*)(cb + nt * 4096 + ro + ((s << 5) ^ hx)), qf[s], sc[nt], 0, 0, 0);
            } }
#pragma unroll
        for (int i = 0; i < 4; ++i) { const int x = tid + 512 * i, d = x >> 5, c = x & 31; if ((c >> 2) < ntb) stg[i] = *(const u32x4_t*)(vt + (size_t)d * 256 + c * 8); }
        __syncthreads();
#pragma unroll
        for (int i = 0; i < 4; ++i) { const int x = tid + 512 * i, d = x >> 5, c = x & 31; if ((c >> 2) < ntb) *(LAS u32x4_t*)(cb + d * 512 + ((c ^ (d & 15)) << 4)) = stg[i]; }
        __syncthreads();
#pragma unroll
        for (int nt = 0; nt < 8; ++nt)
#pragma unroll
            for (int reg = 0; reg < 16; ++reg) { const bool ok = (nt < ntl) && (32 * nt + crow16(reg, h) < nvr); sc[nt][reg] = ok ? sc[nt][reg] : -INFINITY; mx = fmaxf(mx, sc[nt][reg]); }
        mx = fmaxf(mx, lshx(mx, lane, 32));
        const float mxe = (mx == -INFINITY) ? 0.f : mx;
        float sum = 0.f;
#pragma unroll
        for (int nt = 0; nt < 8; ++nt)
#pragma unroll
            for (int reg = 0; reg < 16; ++reg) { const float e = __builtin_amdgcn_exp2f(sc[nt][reg] - mxe); sc[nt][reg] = e; sum += e; }
        sum += lshx(sum, lane, 32);
        const float inv = 1.f / fmaxf(sum, 1e-30f);
        f32x16_t oc[2]; oc[0] = (f32x16_t){}; oc[1] = (f32x16_t){};
        float carry = 0.f;
#pragma unroll
        for (int nt = 0; nt < 8; ++nt) {
#pragma unroll
            for (int reg = 0; reg < 16; ++reg) sc[nt][reg] *= inv;
            if (nt < ntl) {
#pragma unroll
                for (int s = 0; s < 2; ++s) { const h8_t pf = acc2frag(sc[nt], s);
#pragma unroll
                    for (int dt = 0; dt < 2; ++dt) oc[dt] = __builtin_amdgcn_mfma_f32_32x32x16_f16(lds_fragx(cb + dt * 16384, r * 512 + 8 * h, (r & 15) << 4, 4 * nt + 2 * s), pf, oc[dt], 0, 0, 0); }
            }
            if (cur >= NSEL) {
#pragma unroll
            for (int qd = 0; qd < 4; ++qd) {
                const float G = (sc[nt][4 * qd] + sc[nt][4 * qd + 1]) + (sc[nt][4 * qd + 2] + sc[nt][4 * qd + 3]);
                const float ol = lshx(sc[nt][4 * qd + 3], lane, 32);
                const float ol2 = lshx(qd == 0 ? carry : sc[nt][4 * qd - 1], lane, 32);
                float v = G + ((h == 1) ? ol : ol2);
                v += lshx(v, lane, 8); v += lshx(v, lane, 16);
                const int j = 2 * (4 * nt + qd) + h; const bool valid = j <= cur, forced = (j == 0) || (j == cur) || (j == cur - 1);
                if (a == 0) impK[tau * 64 + j] = forced ? (0xFFFFFFC0u | (unsigned)(63 - j)) : (valid ? ((__float_as_uint(v) & 0xFFFFFFC0u) | (unsigned)(63 - j)) : 0u); }
            carry = sc[nt][15];
            }
        }
#pragma unroll
        for (int dt = 0; dt < 2; ++dt)
#pragma unroll
            for (int reg = 0; reg < 16; ++reg) finL[16 * dt + reg] = oc[dt][reg] * g0;
        __builtin_amdgcn_wave_barrier();
        if (cur >= NSEL) { const int tk = lane >> 3, part = lane & 7; unsigned mine[8]; int rank[8];
#pragma unroll
          for (int e = 0; e < 8; ++e) { mine[e] = impK[tk * 64 + 8 * part + e]; rank[e] = 0; }
          for (int j4 = 0; j4 < 16; ++j4) { const u32x4_t o4 = *(const LAS u32x4_t*)(impK + tk * 64 + 4 * j4); const unsigned ov[4] = {o4.x, o4.y, o4.z, o4.w};
#pragma unroll
              for (int c = 0; c < 4; ++c)
#pragma unroll
                  for (int e = 0; e < 8; ++e) rank[e] += (ov[c] > mine[e]) ? 1 : 0; }
          unsigned bits = 0;
#pragma unroll
          for (int e = 0; e < 8; ++e) bits |= ((rank[e] < NSEL) && (8 * part + e <= cur)) ? (1u << e) : 0u;
          unsigned lo = (part < 4) ? (bits << (8 * part)) : 0u, hi = (part >= 4) ? (bits << (8 * (part - 4))) : 0u;
#pragma unroll
          for (int o = 1; o < 8; o <<= 1) { lo |= lshx(lo, lane, o); hi |= lshx(hi, lane, o); }
          if (part == 0) { maskL[2 * tk] = lo; maskL[2 * tk + 1] = hi; } }
        else if (lane < 8) { maskL[2 * lane] = (2u << cur) - 1u; maskL[2 * lane + 1] = 0u; }
        __builtin_amdgcn_wave_barrier();
    }
    f32x16_t fin[2];
    {
        h8_t qf[4];
        { const f16_t* qp = Q16 + mrow * 512 + hq * HD + 8 * h; asm volatile("" : "+v"(qp));
#pragma unroll
          for (int s = 0; s < 4; ++s) qf[s] = *(const h8_t*)(qp + 16 * s); }
        unsigned ulo = 0, uhi = 0;
#pragma unroll
        for (int e = 0; e < 8; ++e) { ulo |= maskL[2 * e]; uhi |= maskL[2 * e + 1]; }
        ulo = __builtin_amdgcn_readfirstlane(ulo); uhi = __builtin_amdgcn_readfirstlane(uhi);
        const unsigned mlo = maskL[2 * tau], mhi = maskL[2 * tau + 1];
        const unsigned long long rowmask = ((unsigned long long)mhi << 32) | mlo; const unsigned long long um = ((unsigned long long)uhi << 32) | ulo;
        AttnState st; st.o[0] = (f32x16_t){}; st.o[1] = (f32x16_t){}; st.m = -INFINITY; st.l = 0.f;
        const f16_t* Ks = KSR + (size_t)bg * NT * HD; const f16_t* Vs = VST + (size_t)bg * HD * NT;
        const f16_t* Kw = KWR + (size_t)bg * NT * HD; const f16_t* Vw = VWT + (size_t)bg * HD * NT;
        const int lo = max(tr - WIN + 1, 0), j0 = max(64 * cur - WIN + 1, 0) >> 6, nsel = cur + 1, ntile = nsel + (cur - j0 + 1);
        const int srow = tid >> 3, sch = tid & 7, soff = srow * 128 + ((sch ^ ((srow >> 1) & 7)) << 4);
        const int ro = r * 128, xs = ((r >> 1) & 7) << 4;
        LAS unsigned char* tb = lds + 90112;
        u32x4_t kA, vA, kB, vB;
#define NSA_TILE_LOAD(KR, VR, idx) do { const int ii_ = (idx); if (ii_ < ntile) { const bool nw_ = ii_ >= nsel; const int jn_ = nw_ ? (j0 + ii_ - nsel) : ii_; const f16_t* kp_ = nw_ ? Kw : Ks; const f16_t* vp_ = nw_ ? Vw : Vs; \
            KR = *(const u32x4_t*)(kp_ + (size_t)(64 * jn_ + srow) * HD + sch * 8); VR = *(const u32x4_t*)(vp_ + (size_t)srow * NT + 64 * jn_ + sch * 8); } } while (0)
        kA = (u32x4_t){0u, 0u, 0u, 0u}; vA = kA; kB = kA; vB = kA;
        NSA_TILE_LOAD(kB, vB, 0); NSA_TILE_LOAD(kA, vA, 1);
        __syncthreads();
        *(LAS u32x4_t*)(tb + soff) = kB; *(LAS u32x4_t*)(tb + 8192 + soff) = vB;
        NSA_TILE_LOAD(kB, vB, 2);
        __syncthreads();
#define NSA_STEP(i, KR, VR) do { \
            const bool isw = (i) >= nsel; const int j = isw ? (j0 + (i) - nsel) : (i); \
            if ((i) == nsel) {                                        \
                const float lt = st.l + lshx(st.l, lane, 32); const float sc1 = g1 / fmaxf(lt, 1e-30f); \
                _Pragma("unroll") for (int dt = 0; dt < 2; ++dt) _Pragma("unroll") for (int reg = 0; reg < 16; ++reg) finL[16 * dt + reg] += st.o[dt][reg] * sc1; \
                st.o[0] = (f32x16_t){}; st.o[1] = (f32x16_t){}; st.m = -INFINITY; st.l = 0.f; \
            } \
            const LAS unsigned char* kb = tb + ((i) & 1) * 16384; const LAS unsigned char* vb = kb + 8192; \
            if (!isw) { if ((um >> j) & 1ull) { if (j == cur) nsa_tile_lds<1>(st, kb, vb, 64 * j, qf, (rowmask >> j) & 1ull, 0, tr, r, h, ro, xs); else nsa_tile_lds<3>(st, kb, vb, 64 * j, qf, (rowmask >> j) & 1ull, 0, tr, r, h, ro, xs); } } \
            else if (j <= j0 + 2 || j == cur) nsa_tile_lds<2>(st, kb, vb, 64 * j, qf, true, lo, tr, r, h, ro, xs); \
            else nsa_tile_lds<0>(st, kb, vb, 64 * j, qf, true, lo, tr, r, h, ro, xs); \
            if ((i) + 1 < ntile) { LAS unsigned char* nb = tb + (((i) + 1) & 1) * 16384; *(LAS u32x4_t*)(nb + soff) = KR; *(LAS u32x4_t*)(nb + 8192 + soff) = VR; } \
            NSA_TILE_LOAD(KR, VR, (i) + 3);                            \
            __syncthreads(); } while (0)
#pragma unroll 1
        for (int i = 0; i < ntile; i += 2) { NSA_STEP(i, kA, vA); if (i + 1 < ntile) NSA_STEP(i + 1, kB, vB); }
#undef NSA_STEP
#undef NSA_TILE_LOAD
        const float lt = st.l + lshx(st.l, lane, 32); const float sc2 = g2 / fmaxf(lt, 1e-30f);
        fin[0] = st.o[0] * sc2; fin[1] = st.o[1] * sc2;
#pragma unroll
        for (int dt = 0; dt < 2; ++dt)
#pragma unroll
            for (int reg = 0; reg < 16; ++reg) fin[dt][reg] += finL[16 * dt + reg];
    }
    float ss = 0.f;
#pragma unroll
    for (int dt = 0; dt < 2; ++dt)
#pragma unroll
        for (int reg = 0; reg < 16; ++reg) ss += fin[dt][reg] * fin[dt][reg];
    ss += lshx(ss, lane, 32);
    const float rs = rsqrtf(ss * (1.f / HD) + EPS);
    f16_t* yp = Y + mrow * DM + 512 + hq * HD;
#pragma unroll
    for (int dt = 0; dt < 2; ++dt)
#pragma unroll
        for (int qd = 0; qd < 4; ++qd) { const int d = 32 * dt + 8 * qd + 4 * h; const f32x4_t gv = *(const f32x4_t*)(ng + d);
            u32x2_t w; w.x = pkh(fin[dt][4 * qd] * rs * gv.x, fin[dt][4 * qd + 1] * rs * gv.y); w.y = pkh(fin[dt][4 * qd + 2] * rs * gv.z, fin[dt][4 * qd + 3] * rs * gv.w);
            *(u32x2_t*)(yp + d) = w; }
}
__device__ __forceinline__ void phase_nsa_blk(const Ctx& C, unsigned* counter, const f16_t* Q16, const f16_t* KCMP16, const f16_t* VCMPT, const f16_t* KSR, const f16_t* VST, const f16_t* KWR, const f16_t* VWT,
                                              const float* GR32, const float* ng, f16_t* Y) {
    LAS float* wl = (LAS float*)C.lds + C.wave * 2752;
    LAS unsigned* qw = (LAS unsigned*)(C.lds + 122880);
    for (;;) {
        __syncthreads();
        if (C.tid == 0) *qw = __hip_atomic_fetch_add(counter, 1u, __ATOMIC_RELAXED, __HIP_MEMORY_SCOPE_AGENT);
        __syncthreads();
        const unsigned q = (unsigned)__builtin_amdgcn_readfirstlane(*qw);
        if (q >= (unsigned)(NB * NG * NT / 64)) break;
        nsa_block_unit((int)q, C.lds, C.tid, wl, C.lane, C.wave, Q16, KCMP16, VCMPT, KSR, VST, KWR, VWT, GR32, ng, Y);
    }
}
__device__ __forceinline__ void phase_nsa(const Ctx& C, unsigned* counter, const f16_t* Q16, const f16_t* KCMP16, const f16_t* VCMPT, const f16_t* KSR, const f16_t* VST, const f16_t* KWR, const f16_t* VWT,
                                          const float* GR32, const float* ng, f16_t* Y) {
    LAS float* wl = (LAS float*)C.lds + C.wave * 2752;
    for (;;) {
        unsigned q = 0;
        if (C.lane == 0) q = __hip_atomic_fetch_add(counter, 1u, __ATOMIC_RELAXED, __HIP_MEMORY_SCOPE_AGENT);
        q = __builtin_amdgcn_readfirstlane(q);
        if (q >= (unsigned)(NB * NG * NT / 8)) break;
        nsa_unit((int)q, wl, C.lane, Q16, KCMP16, VCMPT, KSR, VST, KWR, VWT, GR32, ng, Y);
    }
}

__device__ __forceinline__ int my_tid(int wave_s) { return wave_s * 64 + (int)__builtin_amdgcn_mbcnt_hi(~0u, __builtin_amdgcn_mbcnt_lo(~0u, 0u)); }
template <class Epi> __device__ __forceinline__ void run_gemm(LAS unsigned char* lds, int wave_s, const f16_t* A, const f16_t* Bt, int N, int K, const Epi& E) {
    int bid = blockIdx.x, G = gridDim.x; asm volatile("" : "+s"(bid), "+s"(G));
    pg8::Gemm g{A, Bt, MR, N, K, 0}; pg8::StaticOrder S; S.init(MR, N, G, bid);
    pg8::gemm_phase<Epi, pg8::StaticOrder, true, true>(lds, g, S, E, my_tid(wave_s));
}
__device__ __forceinline__ Ctx make_ctx(LAS unsigned char* lds, int wave_s) {
    Ctx C; C.lds = lds; int t = my_tid(wave_s); asm volatile("" : "+v"(t));
    C.tid = t; C.lane = t & 63; C.wave = __builtin_amdgcn_readfirstlane(t >> 6);
    int bid = blockIdx.x, G = gridDim.x; asm volatile("" : "+s"(bid), "+s"(G));
    C.bid = bid; C.G = G; C.gw = C.bid * NWAVES + C.wave; C.NGW = C.G * NWAVES; return C;
}
#define MK_BAR(b_) XcdBarrier b_; b_.bar = WSP(unsigned, WS_CTL) + CW_BAR; { unsigned x_ = xb_xcc_id(); asm volatile("" : "+s"(x_)); b_.x = x_; } b_.st = (volatile LAS unsigned*)(lds + LDSCTL_OFF + 64)
#define GRID_BAR_FIRST() do { MK_BAR(b_); xcd_barrier(b_); } while (0)
#define GRID_BAR() do { MK_BAR(b_); xcd_barrier_fast(b_); } while (0)
#define HNP ((f16_t*)PA(out))
#define X16P WSP(f16_t, WS_X16)
#define MODL(l) (WSP(float, WS_MOD) + (size_t)(l) * NB * 9216)
template <int l> __device__ __forceinline__ void layer_body(LAS unsigned char* lds, const int wave_s) {
        { Ctx C = make_ctx(lds, wave_s); if (l == 0) phase_norm<false>(C, PA(x), PA(norm_g) + (size_t)(l * 3 + 0) * DM, MODL(l) + 0 * DM, MODL(l) + 1 * DM, HNP); else phase_norm<true>(C, X16P, PA(norm_g) + (size_t)(l * 3 + 0) * DM, MODL(l) + 0 * DM, MODL(l) + 1 * DM, HNP); }
        { Ctx C = make_ctx(lds, wave_s); if (l == 0) phase_norm<false>(C, PA(x), PA(norm_g) + (size_t)(l * 3 + 0) * DM, MODL(l) + 0 * DM, MODL(l) + 1 * DM, HNP); else phase_norm<true>(C, X16P, PA(norm_g) + (size_t)(l * 3 + 0) * DM, MODL(l) + 0 * DM, MODL(l) + 1 * DM, HNP); }
        GRID_BAR();
        run_gemm(lds, wave_s, HNP, WSP(f16_t, WS_WT1) + (size_t)(l * 2 + 0) * 2 * FF * DM, 2 * FF, DM, pg8::EpiSwiglu{WSP(f16_t, WS_ACT)});
        GRID_BAR();
        run_gemm(lds, wave_s, WSP(f16_t, WS_ACT), WSP(f16_t, WS_WT2) + (size_t)(l * 2 + 0) * DM * FF, DM, FF, pg8::EpiResidual<l != 0>{l == 0 ? (const void*)PA(x) : (const void*)X16P, X16P, MODL(l) + 2 * DM, 9216, 0.5f});
        GRID_BAR();
        { Ctx C = make_ctx(lds, wave_s); phase_norm<true>(C, X16P, PA(norm_g) + (size_t)(l * 3 + 1) * DM, MODL(l) + 3 * DM, MODL(l) + 4 * DM, HNP); }
        { Ctx C = make_ctx(lds, wave_s); phase_norm<true>(C, X16P, PA(norm_g) + (size_t)(l * 3 + 1) * DM, MODL(l) + 3 * DM, MODL(l) + 4 * DM, HNP); }
        GRID_BAR();
        run_gemm(lds, wave_s, HNP, WSP(f16_t, WS_WTIN) + (size_t)l * NINP * DM, NINP, DM,
                 pg8::EpiInProj{WSP(f16_t, WS_C16), WSP(f16_t, WS_Z16), WSP(float, WS_AB32), WSP(float, WS_QN32), WSP(float, WS_KC32), WSP(f16_t, WS_KV16), WSP(float, WS_GR32)});
        GRID_BAR();
        { Ctx C = make_ctx(lds, wave_s); phase_gdn_prep(C, WSP(f16_t, WS_C16), PA(conv_w) + (size_t)l * 4 * 1536, WSP(float, WS_AB32), PA(a_log) + l * 4, PA(dt_bias) + l * 4,
                                                WSP(f16_t, WS_GQ), WSP(f16_t, WS_GK), WSP(f16_t, WS_GV), WSP(float, WS_GG), WSP(float, WS_GB)); }
        { Ctx C = make_ctx(lds, wave_s); phase_nsa_prep(C, PA(positions), WSP(float, WS_QN32), WSP(float, WS_KC32), WSP(f16_t, WS_KV16), WSP(f16_t, WS_Q16), WSP(f16_t, WS_KCR), WSP(f16_t, WS_KSR), WSP(f16_t, WS_KWR),
                                                WSP(f16_t, WS_VC16)); }
        GRID_BAR();
        { Ctx C = make_ctx(lds, wave_s); phase_compress_mfma(C, 0, WSP(f16_t, WS_KCR), WSP(f16_t, WS_VC16), WSP(f16_t, WS_W1C) + (size_t)l * 2 * 128 * 2048, WSP(f16_t, WS_W2C) + (size_t)l * 2 * 64 * 128,
                                                     WSP(float, WS_C1) + l * 256, WSP(f16_t, WS_KCMP16), WSP(f16_t, WS_VCMPT)); }
        { Ctx C = make_ctx(lds, wave_s); phase_nsa_vtrans(C, WSP(f16_t, WS_KV16), WSP(f16_t, WS_VST), WSP(f16_t, WS_VWT)); }
        { Ctx C = make_ctx(lds, wave_s); phase_gdn_chunk(C, WSP(f16_t, WS_GQ), WSP(f16_t, WS_GK), WSP(f16_t, WS_GV), WSP(float, WS_GG), WSP(float, WS_GB), WSP(f16_t, WS_UIMG), WSP(f16_t, WS_ATT), WSP(float, WS_DL)); }
        GRID_BAR();
        { Ctx C = make_ctx(lds, wave_s); if (C.bid < NB * GH) phase_gdn_scan(C, C.bid, WSP(f16_t, WS_GQ), WSP(f16_t, WS_GK), WSP(f16_t, WS_GV), WSP(f16_t, WS_UIMG), WSP(f16_t, WS_ATT), WSP(float, WS_DL), WSP(f16_t, WS_OG16)); }
        { Ctx C = make_ctx(lds, wave_s); phase_nsa_blk(C, WSP(unsigned, WS_CTL) + CW_NSA + 64 * l, WSP(f16_t, WS_Q16), WSP(f16_t, WS_KCMP16), WSP(f16_t, WS_VCMPT), WSP(f16_t, WS_KSR), WSP(f16_t, WS_VST), WSP(f16_t, WS_KWR), WSP(f16_t, WS_VWT),
                                           WSP(float, WS_GR32), PA(nsa_ng) + l * HD, HNP); }
        GRID_BAR();
        { Ctx C = make_ctx(lds, wave_s); phase_gdn_out16(C, WSP(f16_t, WS_OG16), WSP(f16_t, WS_Z16), PA(gdn_ng) + l * GD, HNP); }
        GRID_BAR();
        run_gemm(lds, wave_s, HNP, WSP(f16_t, WS_WTOUT) + (size_t)l * DM * DM, DM, DM, pg8::EpiResidual<true>{X16P, X16P, MODL(l) + 5 * DM, 9216, 1.0f});
        GRID_BAR();
        { Ctx C = make_ctx(lds, wave_s); phase_norm<true>(C, X16P, PA(norm_g) + (size_t)(l * 3 + 2) * DM, MODL(l) + 6 * DM, MODL(l) + 7 * DM, HNP); }
        { Ctx C = make_ctx(lds, wave_s); phase_norm<true>(C, X16P, PA(norm_g) + (size_t)(l * 3 + 2) * DM, MODL(l) + 6 * DM, MODL(l) + 7 * DM, HNP); }
        GRID_BAR();
        run_gemm(lds, wave_s, HNP, WSP(f16_t, WS_WT1) + (size_t)(l * 2 + 1) * 2 * FF * DM, 2 * FF, DM, pg8::EpiSwiglu{WSP(f16_t, WS_ACT)});
        GRID_BAR();
        run_gemm(lds, wave_s, WSP(f16_t, WS_ACT), WSP(f16_t, WS_WT2) + (size_t)(l * 2 + 1) * DM * FF, DM, FF, pg8::EpiResidual<true>{X16P, X16P, MODL(l) + 8 * DM, 9216, 0.5f});
        GRID_BAR();
}
__global__ void __launch_bounds__(NTHR, 2) mega_fwd(Params p_unused) {
    extern __shared__ __attribute__((aligned(16))) unsigned char lds_raw[];
    LAS unsigned char* lds = (LAS unsigned char*)lds_raw;
    const int wave_s = __builtin_amdgcn_readfirstlane(threadIdx.x >> 6);
    for (int u = threadIdx.x; u < (LDS_BYTES - LDSCTL_OFF) / 4; u += NTHR) ((LAS unsigned*)(lds + LDSCTL_OFF))[u] = 0u;
    __syncthreads();
    (void)xcd_barrier_post(WSP(unsigned, WS_CTL) + CW_BAR, (volatile LAS unsigned*)(lds + LDSCTL_OFF + 64));
    { Ctx C = make_ctx(lds, wave_s); phase_mod(C, PA(c), PA(ada_w), PA(ada_b), WSP(float, WS_MOD)); }
    { Ctx C = make_ctx(lds, wave_s); phase_wconv(C, WSP(f16_t, WS_WT1), WSP(f16_t, WS_WT2), WSP(f16_t, WS_WTIN), WSP(f16_t, WS_WTOUT)); }
    { Ctx C = make_ctx(lds, wave_s); phase_cmp_weights(C, WSP(f16_t, WS_W1C), WSP(f16_t, WS_W2C), WSP(float, WS_C1)); }
    GRID_BAR_FIRST();
    layer_body<0>(lds, wave_s);
    layer_body<1>(lds, wave_s);
    { Ctx C = make_ctx(lds, wave_s); phase_final_norm(C, X16P, PA(out), PA(final_g)); }
}

extern "C" void kernel_launch(void* const* d_in, const int* in_sizes, int n_in, void* d_out, int out_size, void* d_ws, size_t ws_size, hipStream_t stream) {
    static int grid = 0;
    if (grid == 0) {
        if (n_in != 22 || out_size != MR * DM || ws_size < WS_END + 4096) { fprintf(stderr, "kernel_launch: unexpected shapes (n_in %d out %d ws %zu)\n", n_in, out_size, ws_size); grid = -1; return; }
        int dev = 0, cus = 0, per_cu = 0;
        if (hipGetDevice(&dev) != hipSuccess || hipDeviceGetAttribute(&cus, hipDeviceAttributeMultiprocessorCount, dev) != hipSuccess) { grid = -1; return; }
        if (hipFuncSetAttribute((const void*)mega_fwd, hipFuncAttributeMaxDynamicSharedMemorySize, LDS_BYTES) != hipSuccess) { fprintf(stderr, "kernel_launch: hipFuncSetAttribute failed\n"); grid = -1; return; }
        if (hipOccupancyMaxActiveBlocksPerMultiprocessor(&per_cu, (const void*)mega_fwd, NTHR, LDS_BYTES) != hipSuccess || per_cu < 1) { fprintf(stderr, "kernel_launch: occupancy query says %d\n", per_cu); (void)hipGetLastError(); grid = -1; return; }
        grid = cus;
    }
    if (grid < 0) return;
    (void)hipMemsetAsync((char*)d_ws + WS_CTL, 0, CTL_ZERO_BYTES, stream);
    Params p{};
    p.x = (const float*)d_in[0]; p.c = (const float*)d_in[1]; p.positions = (const int*)d_in[2]; p.ada_w = (const float*)d_in[3]; p.ada_b = (const float*)d_in[4];
    p.norm_g = (const float*)d_in[5]; p.ffn_w_in = (const float*)d_in[6]; p.ffn_w_out = (const float*)d_in[7]; p.mix_w_in = (const float*)d_in[8]; p.conv_w = (const float*)d_in[9];
    p.a_log = (const float*)d_in[10]; p.dt_bias = (const float*)d_in[11]; p.gdn_ng = (const float*)d_in[12]; p.pe_k = (const float*)d_in[13]; p.w1_k = (const float*)d_in[14];
    p.w2_k = (const float*)d_in[15]; p.pe_v = (const float*)d_in[16]; p.w1_v = (const float*)d_in[17]; p.w2_v = (const float*)d_in[18]; p.nsa_ng = (const float*)d_in[19];
    p.mix_w_out = (const float*)d_in[20]; p.final_g = (const float*)d_in[21]; p.out = (float*)d_out; p.ws = (unsigned char*)d_ws;
    hipLaunchKernelGGL(mega_fwd, dim3(grid), dim3(NTHR), LDS_BYTES, stream, p);
}
```
